# Optimizing an MI355X kernel written in HIP

```python
import jax
import jax.numpy as jnp
from jax import lax
import numpy as np

D_MODEL = 2048
BATCH = 8
SEQ = 2048
DEPTH = 1

RWKV_WIDTH = 1024
RWKV_HEAD_DIM = 64
RWKV_HEADS = RWKV_WIDTH // RWKV_HEAD_DIM
DECAY_LORA = 64
ICLR_LORA = 64
GN_EPS = 64e-5

MOBA_WIDTH = 1024
MOBA_HEAD_DIM = 64
MOBA_HEADS = MOBA_WIDTH // MOBA_HEAD_DIM
MOBA_BLOCK = 256
MOBA_TOPK = 3
QUERY_CHUNK = 16

RMS_EPS = 1e-6
NEG_INF = -1e30

IN_SPLITS = (RWKV_WIDTH, RWKV_WIDTH, RWKV_WIDTH, RWKV_WIDTH, DECAY_LORA, ICLR_LORA,
             MOBA_WIDTH, MOBA_WIDTH, MOBA_WIDTH, MOBA_WIDTH, D_MODEL, D_MODEL)
IN_COLS = 4 * RWKV_WIDTH + DECAY_LORA + ICLR_LORA + 4 * MOBA_WIDTH + 2 * D_MODEL

kernel_name = "hybrid_rwkv7_moba_gated_block"


def rms_norm(x, g):
    xf = x.astype(jnp.float32)
    xf = xf * lax.rsqrt(jnp.mean(xf * xf, axis=-1, keepdims=True) + RMS_EPS)
    return (xf * g.astype(jnp.float32)).astype(x.dtype)


def token_shift(p, mu):
    prev = jnp.pad(p, ((0, 0), (1, 0), (0, 0)))[:, :-1]
    return p + (prev - p) * mu


def rwkv7_mix(p_r, p_k, p_v, p_wd, p_ad, mu_r, mu_k, mu_v, mu_w, mu_a, w0, w_decay_up,
              a0, w_iclr_up, k_k, k_a, r_k, gn_w, gn_b):
    B, S, _ = p_r.shape
    H, N = RWKV_HEADS, RWKV_HEAD_DIM
    f32 = jnp.float32
    r = token_shift(p_r, mu_r)
    k = token_shift(p_k, mu_k)
    v = token_shift(p_v, mu_v)
    xw = token_shift(p_wd, mu_w)
    xa = token_shift(p_ad, mu_a)
    w = -jax.nn.softplus(-(w0 + jnp.tanh(xw) @ w_decay_up)) - 0.5
    decay = jnp.exp(-jnp.exp(w.astype(f32)))
    a = jax.nn.sigmoid(a0 + xa @ w_iclr_up)
    kk = (k * k_k).reshape(B, S, H, N).astype(f32)
    kk = kk / jnp.maximum(jnp.sqrt(jnp.sum(kk * kk, axis=-1, keepdims=True)), 1e-12)
    k = k * (1.0 + (a - 1.0) * k_a)

    def heads(t):
        return t.reshape(B, S, H, N).astype(f32)

    rh, kh, vh, wh, ah = heads(r), heads(k), heads(v), heads(decay), heads(a)
    bh = kk * ah
    xs = tuple(jnp.moveaxis(t, 1, 0) for t in (rh, wh, kh, vh, kk, bh))

    def step(state, inp):
        r_t, w_t, k_t, v_t, kk_t, b_t = inp
        sa = jnp.einsum('bhvk,bhk->bhv', state, -kk_t)
        state = (state * w_t[:, :, None, :]
                 + sa[..., None] * b_t[:, :, None, :]
                 + v_t[..., None] * k_t[:, :, None, :])
        y_t = jnp.einsum('bhvk,bhk->bhv', state, r_t)
        return state, y_t

    state0 = jnp.zeros((B, H, N, N), f32)
    _, y = lax.scan(step, state0, xs)
    y = jnp.moveaxis(y, 0, 1)
    mean = jnp.mean(y, axis=-1, keepdims=True)
    var = jnp.mean(jnp.square(y - mean), axis=-1, keepdims=True)
    y = ((y - mean) * lax.rsqrt(var + GN_EPS)).reshape(B, S, H * N)
    y = y * gn_w.astype(f32) + gn_b.astype(f32)
    bonus = jnp.sum(rh * kh * r_k.reshape(H, N).astype(f32), axis=-1, keepdims=True) * vh
    y = y + bonus.reshape(B, S, H * N)
    return y.astype(p_r.dtype)


def moba_attention(p_q, p_k, p_v, q_norm_w, k_norm_w):
    B, S, _ = p_q.shape
    H, Dh, BLK, C = MOBA_HEADS, MOBA_HEAD_DIM, MOBA_BLOCK, QUERY_CHUNK
    nb = -(-S // BLK)
    s_pad = nb * BLK
    n_sel = min(MOBA_TOPK, nb)
    scale = Dh ** -0.5
    q = rms_norm(p_q.reshape(B, S, H, Dh), q_norm_w).transpose(0, 2, 1, 3)
    k = rms_norm(p_k.reshape(B, S, H, Dh), k_norm_w).transpose(0, 2, 1, 3)
    v = p_v.reshape(B, S, H, Dh).transpose(0, 2, 1, 3)
    pad = ((0, 0), (0, 0), (0, s_pad - S), (0, 0))
    kb = jnp.pad(k, pad).reshape(B, H, nb, BLK, Dh)
    vb = jnp.pad(v, pad).reshape(B, H, nb, BLK, Dh)

    k_mean = jnp.mean(kb, axis=3)
    q_blk = jnp.arange(S) // BLK
    gate = jnp.einsum('bhsd,bhnd->bhsn', q, k_mean).astype(jnp.float32)
    past = jnp.arange(nb)[None, :] < q_blk[:, None]
    gate = jnp.where(past, gate, NEG_INF)
    _, sel = lax.top_k(gate, n_sel)
    sel_valid = jnp.arange(n_sel)[None, :] < q_blk[:, None]

    b_ix = jnp.arange(B)[:, None, None, None]
    h_ix = jnp.arange(H)[None, :, None, None]
    key_off = jnp.arange(BLK)

    def chunk(c):
        t0 = c * C
        blk = t0 // BLK
        q_c = lax.dynamic_slice_in_dim(q, t0, C, axis=2)
        sel_c = lax.dynamic_slice_in_dim(sel, t0, C, axis=2)
        valid_c = lax.dynamic_slice_in_dim(sel_valid, t0, C, axis=0)
        k_own = lax.dynamic_index_in_dim(kb, blk, axis=2, keepdims=False)
        v_own = lax.dynamic_index_in_dim(vb, blk, axis=2, keepdims=False)
        s_own = jnp.einsum('bhcd,bhjd->bhcj', q_c, k_own).astype(jnp.float32) * scale
        q_pos = t0 + jnp.arange(C)
        k_pos = blk * BLK + key_off
        s_own = jnp.where(k_pos[None, :] <= q_pos[:, None], s_own, NEG_INF)
        k_g = kb[b_ix, h_ix, sel_c]
        v_g = vb[b_ix, h_ix, sel_c]
        s_g = jnp.einsum('bhcd,bhckjd->bhckj', q_c, k_g).astype(jnp.float32) * scale
        s_g = jnp.where(valid_c[:, :, None], s_g, NEG_INF)
        logits = jnp.concatenate([s_own, s_g.reshape(B, H, C, n_sel * BLK)], axis=-1)
        probs = jax.nn.softmax(logits, axis=-1).astype(v.dtype)
        p_own = probs[..., :BLK]
        p_g = probs[..., BLK:].reshape(B, H, C, n_sel, BLK)
        return (jnp.einsum('bhcj,bhjd->bhcd', p_own, v_own)
                + jnp.einsum('bhckj,bhckjd->bhcd', p_g, v_g))

    o = lax.map(chunk, jnp.arange(S // C))
    return o.transpose(1, 0, 3, 2, 4).reshape(B, S, H * Dh)


def setup_inputs(seed: int = 0) -> dict:
    key = jax.random.key(seed)
    ks = jax.random.split(key, 24)
    f32 = jnp.float32
    L = DEPTH

    def nrm(k, shape, scale):
        return jax.random.normal(k, shape, f32) * scale

    n = jnp.arange(RWKV_WIDTH, dtype=f32) / (RWKV_WIDTH - 1)
    decay_speed = -7.0 + 5.0 * n ** 0.85
    return {
        "x": nrm(ks[0], (BATCH, SEQ, D_MODEL), 1.0),
        "norm_w": 1.0 + nrm(ks[1], (L, D_MODEL), 0.02),
        "w_in": nrm(ks[2], (L, D_MODEL, IN_COLS), D_MODEL ** -0.5),
        "mu_r": jax.random.uniform(ks[3], (L, RWKV_WIDTH), f32, 0.1, 0.9),
        "mu_k": jax.random.uniform(ks[4], (L, RWKV_WIDTH), f32, 0.1, 0.9),
        "mu_v": jax.random.uniform(ks[5], (L, RWKV_WIDTH), f32, 0.1, 0.9),
        "mu_w": jax.random.uniform(ks[6], (L, DECAY_LORA), f32, 0.1, 0.9),
        "mu_a": jax.random.uniform(ks[7], (L, ICLR_LORA), f32, 0.1, 0.9),
        "w0": decay_speed[None, :] + 0.5 + nrm(ks[8], (L, RWKV_WIDTH), 0.05),
        "w_decay_up": nrm(ks[9], (L, DECAY_LORA, RWKV_WIDTH), 0.5 * DECAY_LORA ** -0.5),
        "a0": nrm(ks[10], (L, RWKV_WIDTH), 0.1),
        "w_iclr_up": nrm(ks[11], (L, ICLR_LORA, RWKV_WIDTH), 0.5 * ICLR_LORA ** -0.5),
        "k_k": 0.85 + nrm(ks[12], (L, RWKV_WIDTH), 0.02),
        "k_a": 1.0 + nrm(ks[13], (L, RWKV_WIDTH), 0.02),
        "r_k": nrm(ks[14], (L, RWKV_WIDTH), 0.1),
        "gn_w": 1.0 + nrm(ks[15], (L, RWKV_WIDTH), 0.02),
        "gn_b": nrm(ks[16], (L, RWKV_WIDTH), 0.02),
        "q_norm_w": 1.0 + nrm(ks[17], (L, MOBA_HEAD_DIM), 0.02),
        "k_norm_w": 1.0 + nrm(ks[18], (L, MOBA_HEAD_DIM), 0.02),
        "w_proj_rwkv": nrm(ks[19], (L, RWKV_WIDTH, D_MODEL), RWKV_WIDTH ** -0.5),
        "w_proj_moba": nrm(ks[20], (L, MOBA_WIDTH, D_MODEL), MOBA_WIDTH ** -0.5),
        "w_out": nrm(ks[21], (L, D_MODEL, D_MODEL), D_MODEL ** -0.5),
    }


def reference(x, norm_w, w_in, mu_r, mu_k, mu_v, mu_w, mu_a, w0, w_decay_up, a0, w_iclr_up,
              k_k, k_a, r_k, gn_w, gn_b, q_norm_w, k_norm_w, w_proj_rwkv, w_proj_moba, w_out):
    split_at = [int(i) for i in np.cumsum(IN_SPLITS)[:-1]]
    B, S, _ = x.shape
    for layer in range(DEPTH):
        h = rms_norm(x, norm_w[layer])
        p = h @ w_in[layer]
        (p_r, p_k, p_v, z_a, p_wd, p_ad,
         p_q, p_kq, p_vq, z_b, g_a, g_b) = jnp.split(p, split_at, axis=-1)
        y_a = rwkv7_mix(p_r, p_k, p_v, p_wd, p_ad, mu_r[layer], mu_k[layer], mu_v[layer],
                        mu_w[layer], mu_a[layer], w0[layer], w_decay_up[layer], a0[layer],
                        w_iclr_up[layer], k_k[layer], k_a[layer], r_k[layer], gn_w[layer],
                        gn_b[layer])
        y_a = y_a * jax.nn.silu(z_a)
        y_b = moba_attention(p_q, p_kq, p_vq, q_norm_w[layer], k_norm_w[layer])
        y_b = y_b * jax.nn.silu(z_b)
        merged = (jax.nn.sigmoid(g_a) * (y_a @ w_proj_rwkv[layer])
                  + jax.nn.sigmoid(g_b) * (y_b @ w_proj_moba[layer]))
        x = x + merged @ w_out[layer]
    return x
```

```cpp
#include <hip/hip_runtime.h>
#include <cstdio>
#include <cstdint>
namespace pg8 {
#define PG8_LAS __attribute__((address_space(3)))
typedef unsigned short bf16_t;
typedef short bf16x8 __attribute__((ext_vector_type(8)));
typedef float f32x4 __attribute__((ext_vector_type(4)));
typedef unsigned u32x4 __attribute__((ext_vector_type(4)));
constexpr int BM = 256, BK = 64, HALF = 128, HTB = HALF * BK * 2  , STAGE_BYTES = 8 * HTB, NXCD = 8, WGM = 8;

__host__ __device__ __forceinline__ int lds_byte(int r, int c) { const int st = (r >> 4) * 2 + (c >> 5), rr = r & 15, cc = c & 31, ob = rr * 64 + cc * 2; return st * 1024 + (ob ^ (((ob >> 9) & 1) << 5)); }
__host__ __device__ __forceinline__ void stage_rc(int b, int& R, int& C) { const int st = b / 1024, sb = b % 1024, swz = sb ^ (((sb >> 9) & 1) << 5); R = (st >> 1) * 16 + swz / 64; C = (st & 1) * 32 + (swz % 64) / 2; }
__host__ __device__ __forceinline__ int perm32(int rho) { const int n = rho >> 4, i = rho & 15; return 8 * (i >> 2) + 4 * n + (i & 3); }

struct Unit { int pm, pn; };
struct Gemm { const bf16_t* A; const bf16_t* Bt; int M, N, K; };

struct StaticOrder {
    int nM, nN, nwg, G, c;
    __host__ __device__ void init(int M, int N, int G_, int c_) { nM = M / BM; nN = N / BM; nwg = nM * nN; G = G_; c = c_; }
    __host__ __device__ bool next(int i, Unit& u) const {
        const long L = (long)i * G + c; if (L >= nwg) return false;
        int wgid = (int)L; { const int q = nwg / NXCD, r = nwg % NXCD, xcd = wgid % NXCD, off = wgid / NXCD; wgid = (xcd < r ? xcd * (q + 1) : r * (q + 1) + (xcd - r) * q) + off; }
        const int nig = WGM * nN, gid = wgid / nig, fm = gid * WGM, gsz = (nM - fm) < WGM ? (nM - fm) : WGM;
        u.pm = fm + ((wgid % nig) % gsz); u.pn = (wgid % nig) / gsz; return true;
    }
    __device__ __forceinline__ void a_ready(const Unit&) const {}
    __device__ __forceinline__ void done(const Unit&) const {}
};

__device__ __forceinline__ unsigned cvt_pk_bf16(float lo, float hi) { unsigned r; asm volatile("v_cvt_pk_bf16_f32 %0, %1, %2" : "=v"(r) : "v"(lo), "v"(hi)); return r; }
typedef float f32x2 __attribute__((ext_vector_type(2)));
typedef __bf16 epi_bf16x2 __attribute__((ext_vector_type(2)));
__device__ __forceinline__ unsigned cvt2(float lo, float hi) { f32x2 v = {lo, hi}; epi_bf16x2 b = __builtin_convertvector(v, epi_bf16x2); return __builtin_bit_cast(unsigned, b); }
__device__ __forceinline__ float bf_lo(unsigned w) { return __builtin_bit_cast(float, w << 16); }
__device__ __forceinline__ float bf_hi(unsigned w) { return __builtin_bit_cast(float, w & 0xffff0000u); }
__device__ __forceinline__ float fast_sigmoid(float x) { return __builtin_amdgcn_rcpf(1.0f + __builtin_amdgcn_exp2f(-1.4426950408889634f * x)); }
template <int ACT> __device__ __forceinline__ float act_f(float x) { if (ACT == 1) return x * fast_sigmoid(x); if (ACT == 2) return fast_sigmoid(x); return x; }

struct EpiIn {
    static constexpr bool PERM = true, AFTER_DRAIN = false;
    bf16_t *RKV, *ZA, *QKVB, *ZB, *G, *LORA;
    template <int ACT, int NBJ> __device__ __forceinline__ void put(const f32x4 (&acc)[2][2][4][2], bf16_t* base, int ldc, int row0, int col0) const {
#pragma unroll
        for (int ai = 0; ai < 2; ++ai)
#pragma unroll
            for (int m = 0; m < 4; ++m) { bf16_t* rowp = base + (size_t)(row0 + ai * HALF + m * 16) * ldc + col0;
#pragma unroll
                for (int bj = 0; bj < NBJ; ++bj) { const f32x4 v0 = acc[ai][bj][m][0], v1 = acc[ai][bj][m][1]; u32x4 w;
                    w.x = cvt2(act_f<ACT>(v0[0]), act_f<ACT>(v0[1])); w.y = cvt2(act_f<ACT>(v0[2]), act_f<ACT>(v0[3]));
                    w.z = cvt2(act_f<ACT>(v1[0]), act_f<ACT>(v1[1])); w.w = cvt2(act_f<ACT>(v1[2]), act_f<ACT>(v1[3]));
                    *(u32x4*)(rowp + bj * HALF) = w; } }
    }
    __device__ __forceinline__ void operator()(const f32x4 (&acc)[2][2][4][2], const Unit& u, int wr, int wc, int fr, int fq) const {
        const int row0 = u.pm * BM + wr * 64 + fr, cw = wc * 32 + 8 * fq, pn = u.pn;
        if (pn < 12) put<0, 2>(acc, RKV, 3072, row0, pn * 256 + cw);
        else if (pn < 16) put<1, 2>(acc, ZA, 1024, row0, (pn - 12) * 256 + cw);
        else if (pn < 28) put<0, 2>(acc, QKVB, 3072, row0, (pn - 16) * 256 + cw);
        else if (pn < 32) put<1, 2>(acc, ZB, 1024, row0, (pn - 28) * 256 + cw);
        else if (pn < 48) put<2, 2>(acc, G, 4096, row0, (pn - 32) * 256 + cw);
        else put<0, 1>(acc, LORA, 128, row0, cw);
    }
};
template <int PASS> struct EpiMerge {
    static constexpr bool PERM = true, AFTER_DRAIN = false;
    const bf16_t* G; bf16_t* O;
    __device__ __forceinline__ void operator()(const f32x4 (&acc)[2][2][4][2], const Unit& u, int wr, int wc, int fr, int fq) const {
        const int row0 = u.pm * BM + wr * 64 + fr, col0 = u.pn * BM + wc * 32 + 8 * fq;
#pragma unroll
        for (int ai = 0; ai < 2; ++ai)
#pragma unroll
            for (int m = 0; m < 4; ++m) { const size_t r = (size_t)(row0 + ai * HALF + m * 16);
#pragma unroll
                for (int bj = 0; bj < 2; ++bj) { const f32x4 v0 = acc[ai][bj][m][0], v1 = acc[ai][bj][m][1];
                    const u32x4 g = *(const u32x4*)(G + r * 4096 + PASS * 2048 + col0 + bj * HALF); bf16_t* op = O + r * 2048 + col0 + bj * HALF;
                    float o0 = v0[0] * bf_lo(g.x), o1 = v0[1] * bf_hi(g.x), o2 = v0[2] * bf_lo(g.y), o3 = v0[3] * bf_hi(g.y), o4 = v1[0] * bf_lo(g.z), o5 = v1[1] * bf_hi(g.z), o6 = v1[2] * bf_lo(g.w), o7 = v1[3] * bf_hi(g.w);
                    if (PASS == 1) { const u32x4 t = *(const u32x4*)op; o0 += bf_lo(t.x); o1 += bf_hi(t.x); o2 += bf_lo(t.y); o3 += bf_hi(t.y); o4 += bf_lo(t.z); o5 += bf_hi(t.z); o6 += bf_lo(t.w); o7 += bf_hi(t.w); }
                    u32x4 w; w.x = cvt2(o0, o1); w.y = cvt2(o2, o3); w.z = cvt2(o4, o5); w.w = cvt2(o6, o7);
                    *(u32x4*)op = w; } }
    }
};
struct EpiOut {
    static constexpr bool PERM = false, AFTER_DRAIN = false;
    const float* X; float* O;
    __device__ __forceinline__ void operator()(const f32x4 (&acc)[2][2][4][2], const Unit& u, int wr, int wc, int fr, int fq) const {
        const int row0 = u.pm * BM + wr * 64 + fr, col0 = u.pn * BM + wc * 32 + 4 * fq;
#pragma unroll
        for (int ai = 0; ai < 2; ++ai)
#pragma unroll
            for (int m = 0; m < 4; ++m) { const size_t off = (size_t)(row0 + ai * HALF + m * 16) * 2048 + col0;
#pragma unroll
                for (int bj = 0; bj < 2; ++bj)
#pragma unroll
                    for (int n = 0; n < 2; ++n) *(f32x4*)(O + off + bj * HALF + n * 16) = *(const f32x4*)(X + off + bj * HALF + n * 16) + acc[ai][bj][m][n]; }
    }
};
template <class Epi, class Sched, bool ALIGN_EPI = false, bool SP2 = false>
__device__ __forceinline__ void gemm_phase(PG8_LAS unsigned char* lds, const Gemm g, const Sched& S, const Epi& E) {
    const int tid = threadIdx.x, wid = __builtin_amdgcn_readfirstlane(tid >> 6), lane = tid & 63, wr = wid >> 2, wc = wid & 3, fr = lane & 15, fq = lane >> 4;
    const int K = g.K, nt = K / BK;
    unsigned voffA[2], voffB[2];
#pragma unroll
    for (int i = 0; i < 2; ++i) { int R, C; stage_rc(tid * 16 + i * 8192, R, C); const int Rb = Epi::PERM ? ((R & ~31) + perm32(R & 31)) : R;
        voffA[i] = (unsigned)(R * K + C) * 2u; voffB[i] = (unsigned)(Rb * K + C) * 2u; }
    const size_t kstep = (size_t)(BK * 2);
    const size_t hstep = (size_t)HALF * K * 2;
    const size_t tstep = 2 * hstep;
    const unsigned ldsw = (unsigned)wid * 1024u;
    const int aoff = lds_byte(wr * 64 + fr, fq * 8), boff = lds_byte(wc * 32 + fr, fq * 8);
#define PG8_SA(b, h) (((b) * 2 + (h)) * HTB)
#define PG8_SB(b, h) ((4 + (b) * 2 + (h)) * HTB)
#define PG8_STAGE(bufoff, gbase, voff) do { _Pragma("unroll") for (int _i = 0; _i < 2; ++_i) \
        __builtin_amdgcn_global_load_lds((const unsigned*)((const char*)(gbase) + (voff)[_i]), (PG8_LAS unsigned*)(lds + (bufoff) + ldsw + _i * 8192), 16, 0, 0); } while (0)
#define PG8_LDA(dst, b, h) do { _Pragma("unroll") for (int m = 0; m < 4; ++m) _Pragma("unroll") for (int k = 0; k < 2; ++k) dst[m][k] = *(const PG8_LAS bf16x8*)(lds + PG8_SA(b, h) + aoff + m * 2048 + k * 1024); } while (0)
#define PG8_LDB(dst, b, h) do { _Pragma("unroll") for (int n = 0; n < 2; ++n) _Pragma("unroll") for (int k = 0; k < 2; ++k) dst[n][k] = *(const PG8_LAS bf16x8*)(lds + PG8_SB(b, h) + boff + n * 2048 + k * 1024); } while (0)
#define PG8_MMA(ai, bj, At, Bt) do { __builtin_amdgcn_s_setprio(1); _Pragma("unroll") for (int m = 0; m < 4; ++m) _Pragma("unroll") for (int n = 0; n < 2; ++n) _Pragma("unroll") for (int k = 0; k < 2; ++k) \
        acc[ai][bj][m][n] = __builtin_amdgcn_mfma_f32_16x16x32_bf16(Bt[n][k], At[m][k], acc[ai][bj][m][n], 0, 0, 0); __builtin_amdgcn_s_setprio(0); } while (0)
#define PG8_WAIT_V(n) asm volatile("s_waitcnt vmcnt(" #n ")" ::: "memory")
#define PG8_WAIT_L(n) asm volatile("s_waitcnt lgkmcnt(" #n ")" ::: "memory")
#define PG8_BAR __builtin_amdgcn_s_barrier()
#define PG8_SCHED __builtin_amdgcn_sched_barrier(0)
    Unit cur, nxt; int ui = 0;
    if (!S.next(0, cur)) return;
    f32x4 acc[2][2][4][2];
#pragma unroll
    for (int a = 0; a < 2; ++a)
#pragma unroll
        for (int b = 0; b < 2; ++b)
#pragma unroll
            for (int m = 0; m < 4; ++m)
#pragma unroll
                for (int n = 0; n < 2; ++n) acc[a][b][m][n] = (f32x4){0.f, 0.f, 0.f, 0.f};
    bf16x8 At[4][2], B0[2][2], B1[2][2];
    const char* cA = (const char*)g.A + (size_t)cur.pm * tstep; const char* cB = (const char*)g.Bt + (size_t)cur.pn * tstep;
    S.a_ready(cur);
    if constexpr (SP2) {
        PG8_STAGE(PG8_SB(0, 0), cB, voffB); PG8_STAGE(PG8_SB(0, 1), cB + hstep, voffB); PG8_STAGE(PG8_SA(0, 0), cA, voffA); PG8_STAGE(PG8_SA(0, 1), cA + hstep, voffA);
        if (wr == 1) PG8_BAR;
        PG8_WAIT_V(2); PG8_BAR;
        PG8_STAGE(PG8_SB(1, 0), cB + kstep, voffB); PG8_STAGE(PG8_SA(1, 0), cA + kstep, voffA); PG8_STAGE(PG8_SB(1, 1), cB + hstep + kstep, voffB);
        PG8_WAIT_V(6); PG8_BAR;
    } else {
        PG8_STAGE(PG8_SB(0, 0), cB, voffB); PG8_STAGE(PG8_SA(0, 0), cA, voffA); PG8_STAGE(PG8_SB(0, 1), cB + hstep, voffB); PG8_STAGE(PG8_SA(0, 1), cA + hstep, voffA);
        if (wr == 1) PG8_BAR;
        PG8_WAIT_V(4); PG8_BAR;
        PG8_STAGE(PG8_SB(1, 0), cB + kstep, voffB); PG8_STAGE(PG8_SA(1, 0), cA + kstep, voffA); PG8_STAGE(PG8_SB(1, 1), cB + hstep + kstep, voffB);
        PG8_WAIT_V(6); PG8_BAR;
    }
    for (;;) {
        const bool has_next = S.next(ui + 1, nxt);
        const char* nA = has_next ? (const char*)g.A + (size_t)nxt.pm * tstep : cA; const char* nB = has_next ? (const char*)g.Bt + (size_t)nxt.pn * tstep : cB;
        for (int t = 0; t < nt; t += 2) {
            const bool last = (t == nt - 2);
            const char* a1 = cA + (size_t)(t + 1) * kstep;
            const char* a2 = last ? nA : cA + (size_t)(t + 2) * kstep; const char* b2 = last ? nB : cB + (size_t)(t + 2) * kstep;
            const char* a3 = a2 + kstep; const char* b3 = b2 + kstep;
            if (last && has_next) S.a_ready(nxt);
            if constexpr (SP2) {
            PG8_LDB(B0, 0, 0); PG8_LDB(B1, 0, 1); PG8_SCHED; PG8_LDA(At, 0, 0); PG8_STAGE(PG8_SA(1, 1), a1 + hstep, voffA);
            PG8_WAIT_V(8); PG8_WAIT_L(0); PG8_BAR; PG8_MMA(0, 0, At, B0); PG8_MMA(0, 1, At, B1); PG8_BAR; PG8_SCHED;
            PG8_LDA(At, 0, 1); PG8_STAGE(PG8_SB(0, 0), b2, voffB); PG8_STAGE(PG8_SB(0, 1), b2 + hstep, voffB); PG8_STAGE(PG8_SA(0, 0), a2, voffA);
            PG8_WAIT_V(8); PG8_WAIT_L(0); PG8_BAR; PG8_MMA(1, 0, At, B0); PG8_MMA(1, 1, At, B1); PG8_BAR; PG8_SCHED;
            PG8_LDB(B0, 1, 0); PG8_LDB(B1, 1, 1); PG8_SCHED; PG8_LDA(At, 1, 0); PG8_STAGE(PG8_SA(0, 1), a2 + hstep, voffA);
            PG8_WAIT_V(8); PG8_WAIT_L(0); PG8_BAR; PG8_MMA(0, 0, At, B0); PG8_MMA(0, 1, At, B1); PG8_BAR; PG8_SCHED;
            PG8_LDA(At, 1, 1); PG8_STAGE(PG8_SB(1, 0), b3, voffB); PG8_STAGE(PG8_SB(1, 1), b3 + hstep, voffB); PG8_STAGE(PG8_SA(1, 0), a3, voffA);
            PG8_WAIT_V(8); PG8_WAIT_L(0); PG8_BAR; PG8_MMA(1, 0, At, B0); PG8_MMA(1, 1, At, B1); PG8_BAR; PG8_SCHED;
            } else {
            PG8_LDB(B0, 0, 0); PG8_SCHED; PG8_LDA(At, 0, 0); PG8_STAGE(PG8_SA(1, 1), a1 + hstep, voffA);
            PG8_WAIT_L(8); PG8_BAR; PG8_WAIT_L(0); PG8_MMA(0, 0, At, B0); PG8_BAR; PG8_SCHED;
            PG8_LDB(B1, 0, 1); PG8_STAGE(PG8_SB(0, 0), b2, voffB);
            PG8_BAR; PG8_WAIT_L(0); PG8_MMA(0, 1, At, B1); PG8_BAR;
            PG8_LDA(At, 0, 1); PG8_STAGE(PG8_SA(0, 0), a2, voffA);
            PG8_BAR; PG8_WAIT_L(0); PG8_MMA(1, 0, At, B0); PG8_BAR; PG8_SCHED;
            PG8_STAGE(PG8_SB(0, 1), b2 + hstep, voffB);
            PG8_WAIT_V(6); PG8_BAR; PG8_MMA(1, 1, At, B1); PG8_BAR;
            PG8_LDB(B0, 1, 0); PG8_SCHED; PG8_LDA(At, 1, 0); PG8_STAGE(PG8_SA(0, 1), a2 + hstep, voffA);
            PG8_WAIT_L(8); PG8_BAR; PG8_WAIT_L(0); PG8_MMA(0, 0, At, B0); PG8_BAR; PG8_SCHED;
            PG8_LDB(B1, 1, 1); PG8_STAGE(PG8_SB(1, 0), b3, voffB);
            PG8_BAR; PG8_WAIT_L(0); PG8_MMA(0, 1, At, B1); PG8_BAR;
            PG8_LDA(At, 1, 1); PG8_STAGE(PG8_SA(1, 0), a3, voffA);
            PG8_BAR; PG8_WAIT_L(0); PG8_MMA(1, 0, At, B0); PG8_BAR; PG8_SCHED;
            PG8_STAGE(PG8_SB(1, 1), b3 + hstep, voffB);
            PG8_WAIT_V(6); PG8_BAR; PG8_MMA(1, 1, At, B1); PG8_BAR;
            }
        }
        if constexpr (ALIGN_EPI) { if (wr == 0) PG8_BAR; }
        if constexpr (!Epi::AFTER_DRAIN) { E(acc, cur, wr, wc, fr, fq); S.done(cur); }
        if (!has_next) break;
#pragma unroll
        for (int a = 0; a < 2; ++a)
#pragma unroll
            for (int b = 0; b < 2; ++b)
#pragma unroll
                for (int m = 0; m < 4; ++m)
#pragma unroll
                    for (int n = 0; n < 2; ++n) acc[a][b][m][n] = (f32x4){0.f, 0.f, 0.f, 0.f};
        cur = nxt; cA = nA; cB = nB; ++ui;
        if constexpr (ALIGN_EPI) { if (wr == 1) PG8_BAR; }
    }
    PG8_WAIT_V(0);
    if constexpr (!ALIGN_EPI) { if (wr == 0) PG8_BAR; }
    PG8_BAR;
    if constexpr (Epi::AFTER_DRAIN) { E.fused(acc, cur, wr, wc, fr, fq, lds, wid, lane); S.done(cur); }
#undef PG8_SA
#undef PG8_SB
#undef PG8_STAGE
#undef PG8_LDA
#undef PG8_LDB
#undef PG8_MMA
#undef PG8_WAIT_V
#undef PG8_WAIT_L
#undef PG8_BAR
#undef PG8_SCHED
}
}
#define GAS __attribute__((address_space(1)))
#define LAS __attribute__((address_space(3)))
typedef unsigned short bf16;
typedef unsigned v4u __attribute__((ext_vector_type(4)));
typedef float f32x4 __attribute__((ext_vector_type(4)));
typedef short bf16x8 __attribute__((ext_vector_type(8)));
typedef GAS unsigned gu32;
typedef GAS unsigned long long gu64;
#define RLX_AGENT __ATOMIC_RELAXED, __HIP_MEMORY_SCOPE_AGENT
#define LDS_WAIT() asm volatile("s_waitcnt lgkmcnt(0)" ::: "memory")
#define VM_WAIT() asm volatile("s_waitcnt vmcnt(0)" ::: "memory")
__device__ __forceinline__ unsigned long long rt() { return __builtin_amdgcn_s_memrealtime(); }
__device__ __forceinline__ unsigned f2bf(float f) { unsigned u = __builtin_bit_cast(unsigned, f); return (u + 0x7fffu + ((u >> 16) & 1u)) >> 16; }
__device__ __forceinline__ unsigned pk2(float lo, float hi) { return f2bf(lo) | (f2bf(hi) << 16); }

#define XB_TMO      128
#define XB_XCNT(j)  (256  + 64 * (j))
#define XB_XSUB(j)  (1280 + 64 * (j))
#define XB_XGEN(j)  (2304 + 64 * (j))
#define XB_TOP      3328
#define XB_TOPGEN   3392
#define XCD_BAR_WORDS 3456
#define XB_SPIN_CAP (1u << 18)

__device__ __forceinline__ unsigned xb_ld(unsigned* p)              { return __hip_atomic_load(p, __ATOMIC_RELAXED, __HIP_MEMORY_SCOPE_AGENT); }
__device__ __forceinline__ unsigned xb_add(unsigned* p, unsigned v) { return __hip_atomic_fetch_add(p, v, __ATOMIC_RELAXED, __HIP_MEMORY_SCOPE_AGENT); }
__device__ __forceinline__ unsigned xb_xcc_id() { return (unsigned)__builtin_amdgcn_s_getreg((3 << 11) | 20) & 0xFu; }
#define XB_SPIN(cond, bar) do { unsigned _sp = 0; while (cond) { __builtin_amdgcn_s_sleep(1); \
    if ((++_sp & 255u) == 0u) { if (xb_ld(&(bar)[XB_TMO])) break; if (_sp > XB_SPIN_CAP) { atomicAdd(&(bar)[XB_TMO], 1u); break; } } } } while (0)

struct XcdBarrier {
    unsigned* bar; unsigned x;
    volatile LAS unsigned* st;
};

__device__ __forceinline__ XcdBarrier xcd_barrier_post(unsigned* bar, volatile LAS unsigned* st) {
    XcdBarrier b; b.bar = bar; b.x = xb_xcc_id(); b.st = st;
    if (threadIdx.x == 0) (void)xb_add(&bar[XB_XCNT(b.x)], 1u);
    return b;
}
__device__ __forceinline__ void xcd_barrier_complete(unsigned* bar, unsigned x, unsigned& nloc, unsigned& nx) {
    const unsigned G = gridDim.x * gridDim.y * gridDim.z;
    unsigned sum, cnt, mine, sp = 0u;
    for (;;) {
        sum = 0u; cnt = 0u; mine = 0u;
#pragma unroll
        for (unsigned j = 0; j < 16; ++j) { const unsigned c = xb_ld(&bar[XB_XCNT(j)]); sum += c; cnt += (c > 0u) ? 1u : 0u; mine = (j == x) ? c : mine; }
        if (sum == G) break;
        __builtin_amdgcn_s_sleep(1);
        if ((++sp & 255u) == 0u) { if (xb_ld(&bar[XB_TMO])) break; if (sp > XB_SPIN_CAP) { atomicAdd(&bar[XB_TMO], 1u); break; } }
    }
    nloc = mine > 0u ? mine : 1u; nx = cnt > 0u ? cnt : 1u;
}

__device__ __forceinline__ void xcd_barrier(const XcdBarrier& b) {
    asm volatile("s_waitcnt vmcnt(0)" ::: "memory");
    __syncthreads();
    if (threadIdx.x == 0) {
        unsigned* bar = b.bar;
        __builtin_amdgcn_s_waitcnt(0);
        unsigned nloc = b.st[0], nx = b.st[1];
        if (nloc == 0u) { xcd_barrier_complete(bar, b.x, nloc, nx); b.st[0] = nloc; b.st[1] = nx; }
        const unsigned old = xb_add(&bar[XB_XSUB(b.x)], 1u);
        const unsigned gen = old / nloc;
        if (old + 1u == (gen + 1u) * nloc) {
            __builtin_amdgcn_fence(__ATOMIC_RELEASE, "agent");
            asm volatile("s_waitcnt vmcnt(0)" ::: "memory");
            const unsigned og = xb_add(&bar[XB_TOP], 1u);
            const unsigned tg = og / nx;
            if (og + 1u == (tg + 1u) * nx) xb_add(&bar[XB_TOPGEN], 1u);
            else XB_SPIN(xb_ld(&bar[XB_TOPGEN]) == tg, bar);
            __builtin_amdgcn_fence(__ATOMIC_ACQUIRE, "agent");
            xb_add(&bar[XB_XGEN(b.x)], 1u);
            asm volatile("s_waitcnt vmcnt(0)" ::: "memory");
        } else {
            XB_SPIN(xb_ld(&bar[XB_XGEN(b.x)]) == gen, bar);
            __builtin_amdgcn_fence(__ATOMIC_ACQUIRE, "agent");
            asm volatile("s_waitcnt vmcnt(0)" ::: "memory");
        }
    }
    __syncthreads();
}
constexpr int NWAVES = 8;
#ifndef MK_N_LAUNCHES
#define MK_N_LAUNCHES 0
#endif
constexpr int BATCH = 8, SEQ = 2048, DM = 2048, T = BATCH * SEQ, NH = 16, HD = 64, WID = 1024;
constexpr int NIN = 12544;
constexpr float RMS_EPS = 1e-6f, GN_EPS = 64e-5f;
constexpr size_t MiB = 1u << 20;
constexpr size_t WS_CTL = 0, CTL_ZERO_BYTES = 64 * 1024;
constexpr size_t WS_KMEAN = 1 * MiB;
constexpr size_t WS_WINT = 2 * MiB;
constexpr size_t WS_WAT = 52 * MiB, WS_WBT = 56 * MiB, WS_WOT = 60 * MiB;
constexpr size_t WS_XN = 68 * MiB;
constexpr size_t WS_YA = 68 * MiB, WS_YB = 100 * MiB;
constexpr size_t WS_RKV = 132 * MiB;
constexpr size_t WS_MERGED = 132 * MiB;
constexpr size_t WS_ZA = 228 * MiB, WS_QKVB = 260 * MiB, WS_ZB = 356 * MiB, WS_LORA = 388 * MiB;
constexpr size_t WS_LW = 392 * MiB, WS_AA = 424 * MiB, WS_END = 456 * MiB;
constexpr int CW_BAR = 4096;
constexpr int RING_BYTES = 131072, LDSCTL_OFF = RING_BYTES, MISC_OFF = LDSCTL_OFF + 320, LDS_BYTES = 147456;

__device__ __forceinline__ float bf2f(bf16 v) { return __builtin_bit_cast(float, (unsigned)v << 16); }
__device__ __forceinline__ float blo(unsigned w) { return __builtin_bit_cast(float, w << 16); }
__device__ __forceinline__ float bhi(unsigned w) { return __builtin_bit_cast(float, w & 0xffff0000u); }
__device__ __forceinline__ void unpack8(const v4u w, float* f) { f[0] = blo(w.x); f[1] = bhi(w.x); f[2] = blo(w.y); f[3] = bhi(w.y); f[4] = blo(w.z); f[5] = bhi(w.z); f[6] = blo(w.w); f[7] = bhi(w.w); }
__device__ __forceinline__ v4u pack8(const float* f) { v4u w; w.x = pk2(f[0], f[1]); w.y = pk2(f[2], f[3]); w.z = pk2(f[4], f[5]); w.w = pk2(f[6], f[7]); return w; }
__device__ __forceinline__ float wave_sum(float v) {
#pragma unroll
    for (int o = 1; o < 64; o <<= 1) v += __shfl_xor(v, o);
    return v;
}
__device__ __forceinline__ float wave_max(float v) {
#pragma unroll
    for (int o = 1; o < 64; o <<= 1) v = fmaxf(v, __shfl_xor(v, o));
    return v;
}
__device__ __forceinline__ float dpp_f(float x, int ctrl_unused) { return x; }
#define DPP_ADD(x, CTRL) ((x) + __builtin_bit_cast(float, __builtin_amdgcn_update_dpp(0, __builtin_bit_cast(int, (x)), (CTRL), 0xF, 0xF, true)))
__device__ __forceinline__ float red8(float x) {
    x = DPP_ADD(x, 0xB1);
    x = DPP_ADD(x, 0x4E);
    x = DPP_ADD(x, 0x141);
    return x;
}

struct Frame {
    LAS unsigned char* lds; volatile LAS unsigned* MISC; gu32* ctl;
    int tid, lane, wave, vcu, G;
    const float* in[22]; float* out; unsigned char* ws;
};
#define IN_X 0
#define IN_NORMW 1
#define IN_WIN 2
#define IN_MUR 3
#define IN_MUK 4
#define IN_MUV 5
#define IN_MUW 6
#define IN_MUA 7
#define IN_W0 8
#define IN_WDUP 9
#define IN_A0 10
#define IN_WAUP 11
#define IN_KK 12
#define IN_KA 13
#define IN_RK 14
#define IN_GNW 15
#define IN_GNB 16
#define IN_QNW 17
#define IN_KNW 18
#define IN_WPR 19
#define IN_WPM 20
#define IN_WOUT 21

__device__ __forceinline__ void transpose_item(const float* W, int ldw, int k0, int srcn0, bf16* WT, int K, int dstn0, LAS float* scr, int lane) {
    if (srcn0 >= 0) {
#pragma unroll 8
        for (int i = 0; i < 32; ++i) { const int kk = 2 * i + (lane >> 5); scr[kk * 33 + (lane & 31)] = W[(size_t)(k0 + kk) * ldw + srcn0 + (lane & 31)]; }
    } else {
#pragma unroll 8
        for (int i = 0; i < 32; ++i) { const int kk = 2 * i + (lane >> 5); scr[kk * 33 + (lane & 31)] = 0.f; }
    }
    LDS_WAIT(); asm volatile("" ::: "memory");
    const int c = lane & 7;
#pragma unroll
    for (int j = 0; j < 4; ++j) { const int n = (lane >> 3) + 8 * j; const LAS float* s = scr + (8 * c) * 33 + n;
        v4u o; o.x = pk2(s[0 * 33], s[1 * 33]); o.y = pk2(s[2 * 33], s[3 * 33]); o.z = pk2(s[4 * 33], s[5 * 33]); o.w = pk2(s[6 * 33], s[7 * 33]);
        *(GAS v4u*)(WT + (size_t)(dstn0 + n) * K + k0 + 8 * c) = o; }
    LDS_WAIT(); asm volatile("" ::: "memory");
}
__device__ __forceinline__ int win_src_col(int d) { return d < 4096 ? d : d < 8192 ? 4224 + (d - 4096) : d < 12288 ? 8320 + (d - 8192) : d < 12416 ? 4096 + (d - 12288) : -1; }
__device__ __forceinline__ void rms_row_to_bf16(Frame& F, const float* xrow, const float* g, bf16* orow) {
    const GAS f32x4* xr = (const GAS f32x4*)xrow + F.lane; const GAS f32x4* gr = (const GAS f32x4*)g + F.lane;
    f32x4 v[8]; float s = 0.f;
#pragma unroll
    for (int j = 0; j < 8; ++j) { v[j] = xr[64 * j]; s += (v[j].x * v[j].x + v[j].y * v[j].y) + (v[j].z * v[j].z + v[j].w * v[j].w); }
    const float rstd = 1.f / sqrtf(wave_sum(s) * (1.f / DM) + RMS_EPS);
    GAS unsigned long long* o8 = (GAS unsigned long long*)orow + F.lane;
#pragma unroll
    for (int j = 0; j < 8; ++j) { const f32x4 gg = gr[64 * j]; o8[64 * j] = (unsigned long long)pk2(v[j].x * rstd * gg.x, v[j].y * rstd * gg.y) | ((unsigned long long)pk2(v[j].z * rstd * gg.z, v[j].w * rstd * gg.w) << 32); }
}
__device__ __forceinline__ void p0_prologue(Frame& F) {
    LAS float* scr = (LAS float*)(F.lds + F.wave * 16384);
    const int gw = F.vcu * NWAVES + F.wave, NGW = F.G * NWAVES;
    bf16* WINT = (bf16*)(F.ws + WS_WINT); bf16* WAT = (bf16*)(F.ws + WS_WAT); bf16* WBT = (bf16*)(F.ws + WS_WBT); bf16* WOT = (bf16*)(F.ws + WS_WOT);
    constexpr int I_IN = (DM / 64) * (NIN / 32), I_A = (WID / 64) * (DM / 32), I_O = (DM / 64) * (DM / 32), NITEMS = I_IN + 2 * I_A + I_O;
    for (int it = gw; it < NITEMS; it += NGW) {
        int r = it;
        if (r < I_IN) { const int nblk = NIN / 32, kb = r / nblk, nb = r % nblk; transpose_item(F.in[IN_WIN], 12416, 64 * kb, win_src_col(32 * nb), WINT, DM, 32 * nb, scr, F.lane); continue; } r -= I_IN;
        if (r < I_A) { const int nblk = DM / 32, kb = r / nblk, nb = r % nblk; transpose_item(F.in[IN_WPR], DM, 64 * kb, 32 * nb, WAT, WID, 32 * nb, scr, F.lane); continue; } r -= I_A;
        if (r < I_A) { const int nblk = DM / 32, kb = r / nblk, nb = r % nblk; transpose_item(F.in[IN_WPM], DM, 64 * kb, 32 * nb, WBT, WID, 32 * nb, scr, F.lane); continue; } r -= I_A;
        { const int nblk = DM / 32, kb = r / nblk, nb = r % nblk; transpose_item(F.in[IN_WOUT], DM, 64 * kb, 32 * nb, WOT, DM, 32 * nb, scr, F.lane); }
    }
    bf16* XN = (bf16*)(F.ws + WS_XN);
    for (int m = gw; m < T; m += NGW) rms_row_to_bf16(F, F.in[IN_X] + (size_t)m * DM, F.in[IN_NORMW], XN + (size_t)m * DM);
}

__device__ __forceinline__ float softplus_f(float z) { return fmaxf(z, 0.f) + log1pf(expf(-fabsf(z))); }
__device__ __forceinline__ void p_lora(Frame& F) {
    LAS float* sxw = (LAS float*)F.lds; LAS float* sxa = sxw + 16 * 64;
    const bf16* LORA = (const bf16*)(F.ws + WS_LORA); bf16* LW = (bf16*)(F.ws + WS_LW); bf16* AA = (bf16*)(F.ws + WS_AA);
    const float* Wd = F.in[IN_WDUP]; const float* Wa = F.in[IN_WAUP];
    for (int u = F.vcu; u < T / 16; u += F.G) {
        const int t0 = u * 16;
#pragma unroll
        for (int r = 0; r < 4; ++r) { const int idx = F.tid + 512 * r, which = idx >> 10, tok = (idx >> 6) & 15, i = idx & 63, t = t0 + tok;
            const float cur = bf2f(LORA[(size_t)t * 128 + which * 64 + i]); const float prev = (t & (SEQ - 1)) ? bf2f(LORA[(size_t)(t - 1) * 128 + which * 64 + i]) : 0.f;
            const float mu = which ? F.in[IN_MUA][i] : F.in[IN_MUW][i]; float x = cur + (prev - cur) * mu; if (!which) x = tanhf(x);
            (which ? sxa : sxw)[tok * 64 + i] = x; }
        __syncthreads();
        float aD[2][16], aA[2][16];
#pragma unroll
        for (int q = 0; q < 2; ++q)
#pragma unroll
            for (int k = 0; k < 16; ++k) { aD[q][k] = 0.f; aA[q][k] = 0.f; }
        for (int i = 0; i < 64; ++i) {
            const float wd0 = Wd[i * 1024 + F.tid], wd1 = Wd[i * 1024 + F.tid + 512], wa0 = Wa[i * 1024 + F.tid], wa1 = Wa[i * 1024 + F.tid + 512];
#pragma unroll
            for (int k = 0; k < 16; ++k) { const float xd = sxw[k * 64 + i], xa = sxa[k * 64 + i]; aD[0][k] += xd * wd0; aD[1][k] += xd * wd1; aA[0][k] += xa * wa0; aA[1][k] += xa * wa1; }
        }
#pragma unroll
        for (int q = 0; q < 2; ++q) { const int ch = F.tid + 512 * q; const float w0 = F.in[IN_W0][ch], a0 = F.in[IN_A0][ch];
#pragma unroll
            for (int k = 0; k < 16; ++k) { const float wlog = -softplus_f(-(w0 + aD[q][k])) - 0.5f; LW[(size_t)(t0 + k) * 1024 + ch] = (bf16)f2bf(-expf(wlog));
                AA[(size_t)(t0 + k) * 1024 + ch] = (bf16)f2bf(1.f / (1.f + expf(-(a0 + aA[q][k])))); } }
        __syncthreads();
    }
}

__device__ __forceinline__ void p_scan(Frame& F) {
    LAS float* L = (LAS float*)F.lds;
    LAS float* Lr = L, *Lw = L + 4096, *Lk = L + 2 * 4096, *Ln = L + 3 * 4096, *Lb = L + 4 * 4096, *Lv = L + 5 * 4096, *Ly = L + 6 * 4096, *Lbon = L + 7 * 4096, *Lpar = L + 7 * 4096 + 64;
    const bf16* RKV = (const bf16*)(F.ws + WS_RKV); const bf16* LW = (const bf16*)(F.ws + WS_LW); const bf16* AA = (const bf16*)(F.ws + WS_AA); const bf16* ZA = (const bf16*)(F.ws + WS_ZA);
    bf16* YA = (bf16*)(F.ws + WS_YA);
    const int i = F.tid >> 3, p = F.tid & 7;
    for (int u = F.vcu; u < BATCH * NH; u += F.G) {
        const int b = u >> 4, h = u & 15;
        __syncthreads();
        { const int a = F.wave, d = F.lane;
          const float* pp = a == 0 ? F.in[IN_MUR] : a == 1 ? F.in[IN_MUK] : a == 2 ? F.in[IN_MUV] : a == 3 ? F.in[IN_KK] : a == 4 ? F.in[IN_KA] : a == 5 ? F.in[IN_RK] : a == 6 ? F.in[IN_GNW] : F.in[IN_GNB];
          Lpar[a * 64 + d] = pp[h * 64 + d]; }
        __syncthreads();
        float S[8];
#pragma unroll
        for (int j = 0; j < 8; ++j) S[j] = 0.f;
        for (int c = 0; c < SEQ / 64; ++c) {
            const int t = c * 64 + i; const size_t row = (size_t)b * SEQ + t;
            {
                const bf16* rp = RKV + row * 3072 + h * 64 + 8 * p;
                float cr[8], ck[8], cv[8], qr[8], qk[8], qv[8], lw[8], aa[8];
                unpack8(*(const GAS v4u*)rp, cr); unpack8(*(const GAS v4u*)(rp + 1024), ck); unpack8(*(const GAS v4u*)(rp + 2048), cv);
                if (t > 0) { unpack8(*(const GAS v4u*)(rp - 3072), qr); unpack8(*(const GAS v4u*)(rp - 3072 + 1024), qk); unpack8(*(const GAS v4u*)(rp - 3072 + 2048), qv); }
                else {
#pragma unroll
                    for (int j = 0; j < 8; ++j) { qr[j] = 0.f; qk[j] = 0.f; qv[j] = 0.f; } }
                unpack8(*(const GAS v4u*)(LW + row * 1024 + h * 64 + 8 * p), lw); unpack8(*(const GAS v4u*)(AA + row * 1024 + h * 64 + 8 * p), aa);
                float r[8], k[8], v[8], kkr[8], ss = 0.f, bon = 0.f;
#pragma unroll
                for (int j = 0; j < 8; ++j) { const int d = 8 * p + j;
                    r[j] = cr[j] + (qr[j] - cr[j]) * Lpar[0 * 64 + d]; k[j] = ck[j] + (qk[j] - ck[j]) * Lpar[1 * 64 + d]; v[j] = cv[j] + (qv[j] - cv[j]) * Lpar[2 * 64 + d];
                    kkr[j] = k[j] * Lpar[3 * 64 + d]; ss += kkr[j] * kkr[j]; }
                ss = red8(ss); const float inv = 1.f / fmaxf(sqrtf(ss), 1e-12f);
#pragma unroll
                for (int j = 0; j < 8; ++j) { const int d = 8 * p + j; const float kk = kkr[j] * inv; const float kp = k[j] * (1.f + (aa[j] - 1.f) * Lpar[4 * 64 + d]);
                    bon += r[j] * kp * Lpar[5 * 64 + d];
                    Lr[i * 64 + d] = r[j]; Lw[i * 64 + d] = expf(lw[j]); Lk[i * 64 + d] = kp; Ln[i * 64 + d] = -kk; Lb[i * 64 + d] = kk * aa[j]; Lv[i * 64 + d] = v[j]; }
                bon = red8(bon); if (p == 0) Lbon[i] = bon;
            }
            __syncthreads();
            {
#pragma unroll 2
                for (int s = 0; s < 64; ++s) {
                    const LAS f32x4* pw = (const LAS f32x4*)(Lw + s * 64 + 8 * p); const LAS f32x4* pk = (const LAS f32x4*)(Lk + s * 64 + 8 * p); const LAS f32x4* pn = (const LAS f32x4*)(Ln + s * 64 + 8 * p);
                    const LAS f32x4* pb = (const LAS f32x4*)(Lb + s * 64 + 8 * p); const LAS f32x4* pr = (const LAS f32x4*)(Lr + s * 64 + 8 * p);
                    const f32x4 w0 = pw[0], w1 = pw[1], k0 = pk[0], k1 = pk[1], n0 = pn[0], n1 = pn[1], b0 = pb[0], b1 = pb[1], r0 = pr[0], r1 = pr[1]; const float vv = Lv[s * 64 + i];
                    float sa = (S[0] * n0.x + S[1] * n0.y) + (S[2] * n0.z + S[3] * n0.w) + ((S[4] * n1.x + S[5] * n1.y) + (S[6] * n1.z + S[7] * n1.w));
                    sa = red8(sa);
                    S[0] = S[0] * w0.x + (sa * b0.x + vv * k0.x); S[1] = S[1] * w0.y + (sa * b0.y + vv * k0.y); S[2] = S[2] * w0.z + (sa * b0.z + vv * k0.z); S[3] = S[3] * w0.w + (sa * b0.w + vv * k0.w);
                    S[4] = S[4] * w1.x + (sa * b1.x + vv * k1.x); S[5] = S[5] * w1.y + (sa * b1.y + vv * k1.y); S[6] = S[6] * w1.z + (sa * b1.z + vv * k1.z); S[7] = S[7] * w1.w + (sa * b1.w + vv * k1.w);
                    float y = (S[0] * r0.x + S[1] * r0.y) + (S[2] * r0.z + S[3] * r0.w) + ((S[4] * r1.x + S[5] * r1.y) + (S[6] * r1.z + S[7] * r1.w));
                    y = red8(y); if (p == 0) Ly[s * 64 + i] = y;
                }
            }
            __syncthreads();
            {
                float y[8], sm = 0.f;
#pragma unroll
                for (int j = 0; j < 8; ++j) { y[j] = Ly[i * 64 + 8 * p + j]; sm += y[j]; }
                const float mean = red8(sm) * (1.f / 64.f); float q = 0.f;
#pragma unroll
                for (int j = 0; j < 8; ++j) { y[j] -= mean; q += y[j] * y[j]; }
                const float rstd = 1.f / sqrtf(red8(q) * (1.f / 64.f) + GN_EPS); const float bon = Lbon[i];
                float za[8], o[8]; unpack8(*(const GAS v4u*)(ZA + row * 1024 + h * 64 + 8 * p), za);
#pragma unroll
                for (int j = 0; j < 8; ++j) { const int d = 8 * p + j; o[j] = (y[j] * rstd * Lpar[6 * 64 + d] + Lpar[7 * 64 + d] + bon * Lv[i * 64 + d]) * za[j]; }
                *(GAS v4u*)(YA + row * 1024 + h * 64 + 8 * p) = pack8(o);
            }
            __syncthreads();
        }
    }
}

__device__ __forceinline__ void p_qknorm(Frame& F) {
    LAS float* red = (LAS float*)F.lds;
    bf16* QKVB = (bf16*)(F.ws + WS_QKVB); float* KMEAN = (float*)(F.ws + WS_KMEAN);
    const int tok = F.tid & 255, which = F.tid >> 8;
    const float* nw = which ? F.in[IN_KNW] : F.in[IN_QNW];
    for (int u = F.vcu; u < BATCH * 8; u += F.G) {
        const int b = u >> 3, n = u & 7; const size_t row = (size_t)b * SEQ + n * 256 + tok;
        for (int h = 0; h < NH; ++h) {
            bf16* ptr = QKVB + row * 3072 + which * 1024 + h * 64; float f[64]; float ss = 0.f;
#pragma unroll
            for (int c = 0; c < 8; ++c) unpack8(*(const GAS v4u*)(ptr + 8 * c), f + 8 * c);
#pragma unroll
            for (int d = 0; d < 64; ++d) ss += f[d] * f[d];
            const float r = 1.f / sqrtf(ss * (1.f / 64.f) + RMS_EPS);
#pragma unroll
            for (int d = 0; d < 64; ++d) f[d] = f[d] * r * nw[d];
#pragma unroll
            for (int c = 0; c < 8; ++c) *(GAS v4u*)(ptr + 8 * c) = pack8(f + 8 * c);
            if (which) {
#pragma unroll
                for (int d = 0; d < 64; ++d) red[tok * 65 + d] = f[d]; }
            __syncthreads();
            if (F.tid < 64) { float s = 0.f; for (int k = 0; k < 256; ++k) s += red[k * 65 + F.tid]; KMEAN[(((size_t)b * NH + h) * 8 + n) * 64 + F.tid] = s * (1.f / 256.f); }
            __syncthreads();
        }
    }
}

__device__ __forceinline__ void p_attn(Frame& F) {
    LAS float* sq = (LAS float*)F.lds + F.wave * 128; LAS float* sp = sq + 64;
    const bf16* QKVB = (const bf16*)(F.ws + WS_QKVB); const float* KMEAN = (const float*)(F.ws + WS_KMEAN); const bf16* ZB = (const bf16*)(F.ws + WS_ZB); bf16* YB = (bf16*)(F.ws + WS_YB);
    const int gw = F.vcu * NWAVES + F.wave, NGW = F.G * NWAVES, lane = F.lane;
    for (int qi = gw; qi < BATCH * NH * SEQ; qi += NGW) {
        const int s = qi & (SEQ - 1), h = (qi >> 11) & 15, b = qi >> 15, qblk = s >> 8; const size_t row = (size_t)b * SEQ + s;
        const float qd = bf2f(QKVB[row * 3072 + h * 64 + lane]);
        asm volatile("" ::: "memory"); sq[lane] = qd; asm volatile("s_waitcnt lgkmcnt(0)" ::: "memory");
        unsigned selm = 0;
        if (qblk <= 3) selm = (1u << qblk) - 1u;
        else { float g[7];
#pragma unroll
            for (int n = 0; n < 7; ++n) g[n] = (n < qblk) ? wave_sum(qd * KMEAN[(((size_t)b * NH + h) * 8 + n) * 64 + lane]) : -1e30f;
#pragma unroll
            for (int n = 0; n < 7; ++n) { int rank = 0;
#pragma unroll
                for (int m = 0; m < 7; ++m) if (m != n) rank += (g[m] > g[n] || (g[m] == g[n] && m < n)) ? 1 : 0;
                if (n < qblk && rank < 3) selm |= 1u << n; } }
        float m = -1e30f, l = 0.f, o = 0.f;
        for (int bi = 0; bi <= qblk; ++bi) {
            const int n = qblk - bi; const bool own = (bi == 0);
            if (!own && !((selm >> n) & 1u)) continue;
            const int ntile = own ? (((s & 255) >> 6) + 1) : 4;
            for (int tt = 0; tt < ntile; ++tt) {
                const int j0 = n * 256 + tt * 64, j = j0 + lane; const bf16* kp = QKVB + ((size_t)b * SEQ + j) * 3072 + 1024 + h * 64; float sc = 0.f;
#pragma unroll
                for (int c = 0; c < 8; ++c) { float kf[8]; unpack8(*(const GAS v4u*)(kp + 8 * c), kf); const f32x4 q0 = *(const LAS f32x4*)(sq + 8 * c), q1 = *(const LAS f32x4*)(sq + 8 * c + 4);
                    sc += (kf[0] * q0.x + kf[1] * q0.y) + (kf[2] * q0.z + kf[3] * q0.w) + (kf[4] * q1.x + kf[5] * q1.y) + (kf[6] * q1.z + kf[7] * q1.w); }
                sc *= 0.125f; if (own && j > s) sc = -1e30f;
                const float mn = fmaxf(m, wave_max(sc)), alpha = expf(m - mn), pj = expf(sc - mn);
                l = l * alpha + wave_sum(pj); o *= alpha; m = mn;
                asm volatile("s_waitcnt lgkmcnt(0)" ::: "memory"); sp[lane] = pj; asm volatile("s_waitcnt lgkmcnt(0)" ::: "memory");
                const bf16* vp = QKVB + ((size_t)b * SEQ + j0) * 3072 + 2048 + h * 64 + lane;
#pragma unroll 8
                for (int jj = 0; jj < 64; ++jj) o += sp[jj] * bf2f(vp[(size_t)jj * 3072]);
            }
        }
        YB[row * 1024 + h * 64 + lane] = (bf16)f2bf(o / l * bf2f(ZB[row * 1024 + h * 64 + lane]));
    }
}

#ifndef MK_CHECK
#define MK_CHECK 0
#endif
constexpr int PER_PHASE = 9;
struct Args { const float* in[22]; float* out; unsigned char* ws; int ph_lo, ph_hi, li, pad; };
__global__ void __launch_bounds__(NWAVES * 64, 2) mk_fwd(Args args) {
    extern __shared__ __attribute__((aligned(16))) unsigned char lds[];
    Frame F;
    F.lds = (LAS unsigned char*)lds; F.MISC = (volatile LAS unsigned*)(F.lds + MISC_OFF);
    F.tid = threadIdx.x; F.lane = F.tid & 63; F.wave = __builtin_amdgcn_readfirstlane(F.tid >> 6);
    F.G = gridDim.x; { const int bx = blockIdx.x; F.vcu = (F.G % 8 == 0) ? (bx % 8) * (F.G / 8) + bx / 8 : bx; }
    F.ws = args.ws; F.out = args.out; F.ctl = (gu32*)(args.ws + WS_CTL);
#pragma unroll
    for (int i = 0; i < 22; ++i) F.in[i] = args.in[i];
    for (int u = F.tid; u < (LDS_BYTES - LDSCTL_OFF) / 4; u += NWAVES * 64) ((LAS unsigned*)(F.lds + LDSCTL_OFF))[u] = 0u;
    __syncthreads();
    XcdBarrier bar; bar.bar = (unsigned*)(F.ctl + CW_BAR); bar.x = 0; bar.st = nullptr;
    if (MK_N_LAUNCHES == 1) bar = xcd_barrier_post((unsigned*)(F.ctl + CW_BAR), F.MISC + 8);
#define GRID_BAR() do { if (MK_N_LAUNCHES == 1) xcd_barrier(bar); } while (0)
    const int lo = args.ph_lo, hi = args.ph_hi;
#define IN(k) (lo <= (k) && (k) < hi)
#define BOTH(k) (IN(k) && IN((k) + 1))
    bf16* WS16 = (bf16*)args.ws; (void)WS16;
    if (IN(0)) { p0_prologue(F); if (BOTH(0)) GRID_BAR(); }
    if (IN(1)) {
        pg8::Gemm g{(const pg8::bf16_t*)(args.ws + WS_XN), (const pg8::bf16_t*)(args.ws + WS_WINT), T, NIN, DM}; pg8::StaticOrder S; S.init(T, NIN, F.G, (int)blockIdx.x);
        pg8::EpiIn E{(pg8::bf16_t*)(args.ws + WS_RKV), (pg8::bf16_t*)(args.ws + WS_ZA), (pg8::bf16_t*)(args.ws + WS_QKVB), (pg8::bf16_t*)(args.ws + WS_ZB), (pg8::bf16_t*)args.out, (pg8::bf16_t*)(args.ws + WS_LORA)};
        pg8::gemm_phase<pg8::EpiIn, pg8::StaticOrder, true, true>(F.lds, g, S, E);
        if (BOTH(1)) GRID_BAR();
    }
    if (IN(2)) { p_lora(F); if (BOTH(2)) GRID_BAR(); }
    if (IN(3)) { p_scan(F); if (BOTH(3)) GRID_BAR(); }
    if (IN(4)) { p_qknorm(F); if (BOTH(4)) GRID_BAR(); }
    if (IN(5)) { p_attn(F); if (BOTH(5)) GRID_BAR(); }
    if (IN(6)) {
        pg8::Gemm g{(const pg8::bf16_t*)(args.ws + WS_YA), (const pg8::bf16_t*)(args.ws + WS_WAT), T, DM, WID}; pg8::StaticOrder S; S.init(T, DM, F.G, (int)blockIdx.x);
        pg8::EpiMerge<0> E{(const pg8::bf16_t*)args.out, (pg8::bf16_t*)(args.ws + WS_MERGED)};
        pg8::gemm_phase<pg8::EpiMerge<0>, pg8::StaticOrder, true, true>(F.lds, g, S, E);
        if (BOTH(6)) GRID_BAR();
    }
    if (IN(7)) {
        pg8::Gemm g{(const pg8::bf16_t*)(args.ws + WS_YB), (const pg8::bf16_t*)(args.ws + WS_WBT), T, DM, WID}; pg8::StaticOrder S; S.init(T, DM, F.G, (int)blockIdx.x);
        pg8::EpiMerge<1> E{(const pg8::bf16_t*)args.out, (pg8::bf16_t*)(args.ws + WS_MERGED)};
        pg8::gemm_phase<pg8::EpiMerge<1>, pg8::StaticOrder, true, true>(F.lds, g, S, E);
        if (BOTH(7)) GRID_BAR();
    }
    if (IN(8)) {
        pg8::Gemm g{(const pg8::bf16_t*)(args.ws + WS_MERGED), (const pg8::bf16_t*)(args.ws + WS_WOT), T, DM, DM}; pg8::StaticOrder S; S.init(T, DM, F.G, (int)blockIdx.x);
        pg8::EpiOut E{F.in[IN_X], args.out};
        pg8::gemm_phase<pg8::EpiOut, pg8::StaticOrder, true, true>(F.lds, g, S, E);
    }
#undef IN
#undef BOTH
}

#if MK_CHECK
constexpr int CW_CHK = 8192;
__device__ __forceinline__ float chk_silu(float x) { return x / (1.f + expf(-x)); }
__device__ __forceinline__ float chk_sig(float x) { return 1.f / (1.f + expf(-x)); }
__global__ void __launch_bounds__(64) mk_check(Args args, int stage) {
    __shared__ float sh[8][64];
    const int lane = threadIdx.x; unsigned char* ws = args.ws; unsigned* ctl = (unsigned*)(ws + WS_CTL);
    const bf16* WINT = (const bf16*)(ws + WS_WINT); const bf16* WAT = (const bf16*)(ws + WS_WAT); const bf16* WBT = (const bf16*)(ws + WS_WBT); const bf16* WOT = (const bf16*)(ws + WS_WOT);
    const bf16* XN = (const bf16*)(ws + WS_XN); const bf16* RKV = (const bf16*)(ws + WS_RKV); const bf16* ZA = (const bf16*)(ws + WS_ZA); const bf16* QKVB = (const bf16*)(ws + WS_QKVB);
    const bf16* ZB = (const bf16*)(ws + WS_ZB); const bf16* G = (const bf16*)args.out; const bf16* LORA = (const bf16*)(ws + WS_LORA); const bf16* LW = (const bf16*)(ws + WS_LW); const bf16* AA = (const bf16*)(ws + WS_AA);
    const bf16* YA = (const bf16*)(ws + WS_YA); const bf16* YB = (const bf16*)(ws + WS_YB); const bf16* MERGED = (const bf16*)(ws + WS_MERGED); const float* KMEAN = (const float*)(ws + WS_KMEAN);
    float ratio = 0.f; int sub = 0; unsigned fmask = 0u;
#define CHK(got, want, rel, ab, SUB) do { const float r_ = fabsf((got) - (want)) / ((rel) * fabsf(want) + (ab)); if (!(r_ <= 1.f)) fmask |= 1u << (SUB); if (!(r_ <= ratio)) { ratio = r_; sub = (SUB); } } while (0)
    if (stage == 1) {
        for (int ri = 0; ri < 4; ++ri) { const int t = ri == 0 ? 0 : ri == 1 ? 1 : ri == 2 ? 5000 : 16383; const float* xr = args.in[IN_X] + (size_t)t * DM; float s = 0.f;
            for (int j = 0; j < 32; ++j) { const float v = xr[lane * 32 + j]; s += v * v; }
            s = wave_sum(s); const float rstd = 1.f / sqrtf(s / DM + RMS_EPS); const int k = lane * 32 + ((7 * ri + lane) & 31);
            CHK(bf2f(XN[(size_t)t * DM + k]), xr[k] * rstd * args.in[IN_NORMW][k], 0.01f, 1e-3f, 1); }
        for (int q = 0; q < 4; ++q) { int n = (lane * 197 + 13 + q * 3137) % NIN; if (q == 3 && lane < 9) { int v = 4095;
                v = lane == 1 ? 4096 : lane == 2 ? 8191 : lane == 3 ? 8192 : lane == 4 ? 12287 : lane == 5 ? 12288 : lane == 6 ? 12415 : lane == 7 ? 12416 : lane == 8 ? 12543 : 4095; n = v; }
            const int k = (lane * 31 + 5 + q * 511) % DM; const int src = n < 4096 ? n : n < 8192 ? 4224 + (n - 4096) : n < 12288 ? 8320 + (n - 8192) : n < 12416 ? 4096 + (n - 12288) : -1;
            const float want = src >= 0 ? args.in[IN_WIN][(size_t)k * 12416 + src] : 0.f; CHK(bf2f(WINT[(size_t)n * DM + k]), want, 0.01f, 1e-4f, 2); }
        { const int n = (lane * 37 + 3) % DM, k = (lane * 29 + 1) % WID; CHK(bf2f(WAT[(size_t)n * WID + k]), args.in[IN_WPR][(size_t)k * DM + n], 0.01f, 1e-4f, 3);
          CHK(bf2f(WBT[(size_t)n * WID + k]), args.in[IN_WPM][(size_t)k * DM + n], 0.01f, 1e-4f, 3); const int k2 = (lane * 61 + 7) % DM; CHK(bf2f(WOT[(size_t)n * DM + k2]), args.in[IN_WOUT][(size_t)k2 * DM + n], 0.01f, 1e-4f, 3); }
    }
    if (stage == 2) {
        for (int q = 0; q < 4; ++q) { const int t = (lane * 1031 + 17 + q * 4099) % T, grp = (lane + q) % 9, c = (lane * 67 + 3 + q * 131) % 1024, c2 = (lane * 113 + 9 + q * 517) % 2048, c3 = (lane * 5 + q) % 128;
            const int n = grp == 0 ? c : grp == 1 ? 1024 + c : grp == 2 ? 2048 + c : grp == 3 ? 3072 + c : grp == 4 ? 4096 + 2048 + c : grp == 5 ? 4096 + 3072 + c : grp == 6 ? 8192 + c2 : grp == 7 ? 8192 + 2048 + c2 : 12288 + c3;
            float d = 0.f; for (int k = 0; k < DM; ++k) d += bf2f(XN[(size_t)t * DM + k]) * bf2f(WINT[(size_t)n * DM + k]);
            float got, want = d;
            if (grp <= 2) got = bf2f(RKV[(size_t)t * 3072 + grp * 1024 + c]);
            else if (grp == 3) { got = bf2f(ZA[(size_t)t * 1024 + c]); want = chk_silu(d); }
            else if (grp == 4) got = bf2f(QKVB[(size_t)t * 3072 + 2048 + c]);
            else if (grp == 5) { got = bf2f(ZB[(size_t)t * 1024 + c]); want = chk_silu(d); }
            else if (grp == 6) { got = bf2f(G[(size_t)t * 4096 + c2]); want = chk_sig(d); }
            else if (grp == 7) { got = bf2f(G[(size_t)t * 4096 + 2048 + c2]); want = chk_sig(d); }
            else got = bf2f(LORA[(size_t)t * 128 + c3]);
            CHK(got, want, 0.02f, 0.02f, 1 + grp); }
    }
    if (stage == 3) {
        for (int q = 0; q < 2; ++q) { const int t = q == 0 ? (lane < 4 ? lane * 2048 : (lane * 997 + 11) % T) : (lane * 263 + 2048 * (lane & 7)) % T, ch = (lane * 131 + 5 + 17 * q) % 1024; float sd = 0.f, sa_ = 0.f;
            for (int i = 0; i < 64; ++i) { const float cw = bf2f(LORA[(size_t)t * 128 + i]), ca = bf2f(LORA[(size_t)t * 128 + 64 + i]);
                const float pw = (t & (SEQ - 1)) ? bf2f(LORA[(size_t)(t - 1) * 128 + i]) : 0.f, pa = (t & (SEQ - 1)) ? bf2f(LORA[(size_t)(t - 1) * 128 + 64 + i]) : 0.f;
                const float xw = cw + (pw - cw) * args.in[IN_MUW][i], xa = ca + (pa - ca) * args.in[IN_MUA][i];
                sd += tanhf(xw) * args.in[IN_WDUP][i * 1024 + ch]; sa_ += xa * args.in[IN_WAUP][i * 1024 + ch]; }
            const float z = args.in[IN_W0][ch] + sd; const float wl = -log1pf(expf(-z)) - 0.5f;
            CHK(bf2f(LW[(size_t)t * 1024 + ch]), -expf(wl), 0.01f, 1e-5f, 1); CHK(bf2f(AA[(size_t)t * 1024 + ch]), chk_sig(args.in[IN_A0][ch] + sa_), 0.01f, 2e-3f, 2); }
    }
    if (stage == 4) {
        for (int pi = 0; pi < 2; ++pi) { const int b = pi ? 5 : 0, h = pi ? 9 : 0; float S[64];
#pragma unroll
            for (int j = 0; j < 64; ++j) S[j] = 0.f;
            const int d = h * 64 + lane; const float mur = args.in[IN_MUR][d], muk = args.in[IN_MUK][d], muv = args.in[IN_MUV][d], kk_ = args.in[IN_KK][d], ka = args.in[IN_KA][d], rk = args.in[IN_RK][d], gw = args.in[IN_GNW][d], gb = args.in[IN_GNB][d];
            for (int t = 0; t < 200; ++t) { const size_t row = (size_t)b * SEQ + t;
                const float cr = bf2f(RKV[row * 3072 + d]), ck = bf2f(RKV[row * 3072 + 1024 + d]), cv = bf2f(RKV[row * 3072 + 2048 + d]);
                const float pr = t ? bf2f(RKV[(row - 1) * 3072 + d]) : 0.f, pk = t ? bf2f(RKV[(row - 1) * 3072 + 1024 + d]) : 0.f, pv = t ? bf2f(RKV[(row - 1) * 3072 + 2048 + d]) : 0.f;
                const float r = cr + (pr - cr) * mur, k = ck + (pk - ck) * muk, v = cv + (pv - cv) * muv, a = bf2f(AA[row * 1024 + d]), w = expf(bf2f(LW[row * 1024 + d]));
                float kkv = k * kk_; const float nrm = fmaxf(sqrtf(wave_sum(kkv * kkv)), 1e-12f); kkv /= nrm; const float kp = k * (1.f + (a - 1.f) * ka), bb = kkv * a;
                const float bon = wave_sum(r * kp * rk);
                __syncthreads(); sh[0][lane] = r; sh[1][lane] = w; sh[2][lane] = kp; sh[3][lane] = -kkv; sh[4][lane] = bb; __syncthreads();
                float sa = 0.f;
#pragma unroll
                for (int j = 0; j < 64; ++j) sa += S[j] * sh[3][j];
                float y = 0.f;
#pragma unroll
                for (int j = 0; j < 64; ++j) { S[j] = S[j] * sh[1][j] + sa * sh[4][j] + v * sh[2][j]; y += S[j] * sh[0][j]; }
                const float mean = wave_sum(y) * (1.f / 64.f), dy = y - mean, var = wave_sum(dy * dy) * (1.f / 64.f);
                const float want = (dy / sqrtf(var + GN_EPS) * gw + gb + bon * v) * bf2f(ZA[row * 1024 + d]);
                CHK(bf2f(YA[row * 1024 + d]), want, 0.03f, 0.03f, 1 + pi * 4 + (t >= 64 ? 1 : 0) + (t == 0 ? 2 : 0)); } }
    }
    if (stage == 5) {
        for (int q = 0; q < 4; ++q) { const int t = (lane * 523 + 7 + q * 4111) % T, h = (lane + q) & 15, which = q & 1; float ss = 0.f; const float* nw = which ? args.in[IN_KNW] : args.in[IN_QNW];
            for (int dd = 0; dd < 64; ++dd) { const float v = bf2f(QKVB[(size_t)t * 3072 + which * 1024 + h * 64 + dd]) / nw[dd]; ss += v * v; }
            CHK(ss / 64.f, 1.0f, 0.02f, 0.f, 1 + which); }
        for (int q = 0; q < 2; ++q) { const int b = (lane + q * 3) & 7, h = (lane * 5 + q) & 15, n = (lane >> 3) & 7, dd = (lane * 11 + q * 29) & 63; float s = 0.f;
            for (int k = 0; k < 256; ++k) s += bf2f(QKVB[((size_t)b * SEQ + n * 256 + k) * 3072 + 1024 + h * 64 + dd]);
            CHK(KMEAN[(((size_t)b * NH + h) * 8 + n) * 64 + dd], s / 256.f, 0.02f, 2e-3f, 3); }
    }
    if (stage == 6) {
        const int l15 = lane & 15;
        const int s = l15 == 0 ? 0 : l15 == 1 ? 1 : l15 == 2 ? 63 : l15 == 3 ? 64 : l15 == 4 ? 255 : l15 == 5 ? 256 : l15 == 6 ? 300 : l15 == 7 ? 511 : l15 == 8 ? 512 : l15 == 9 ? 777 : l15 == 10 ? 1023 : l15 == 11 ? 1024 : l15 == 12 ? 1300 : l15 == 13 ? 1791 : l15 == 14 ? 1800 : 2047;
        const int b = (lane >> 4) * 2 + 1, h = (lane * 7 + 3) & 15, qblk = s >> 8; const size_t row = (size_t)b * SEQ + s;
        float qv[64], o[64];
#pragma unroll
        for (int dd = 0; dd < 64; ++dd) { qv[dd] = bf2f(QKVB[row * 3072 + h * 64 + dd]); o[dd] = 0.f; }
        float g[8]; int nsel = qblk < 3 ? qblk : 3; unsigned selm = 0;
#pragma unroll
        for (int n = 0; n < 8; ++n) { g[n] = -1e30f; if (n < qblk) { float a = 0.f;
#pragma unroll
                for (int dd = 0; dd < 64; ++dd) a += qv[dd] * KMEAN[(((size_t)b * NH + h) * 8 + n) * 64 + dd];
                g[n] = a; } }
        for (int it = 0; it < nsel; ++it) { int best = -1; float bv = -3e38f;
#pragma unroll
            for (int n = 0; n < 8; ++n) if (!((selm >> n) & 1u) && g[n] > bv) { bv = g[n]; best = n; }
            selm |= 1u << best; }
        float m = -1e30f, l = 0.f;
        for (int n = 0; n <= qblk; ++n) { if (n < qblk && !((selm >> n) & 1u)) continue;
            for (int kk2 = 0; kk2 < 256; ++kk2) { const int j = n * 256 + kk2; if (j > s) break; const size_t kr = ((size_t)b * SEQ + j) * 3072; float sc = 0.f;
#pragma unroll
                for (int dd = 0; dd < 64; ++dd) sc += qv[dd] * bf2f(QKVB[kr + 1024 + h * 64 + dd]);
                sc *= 0.125f; const float mn = fmaxf(m, sc), al = expf(m - mn), p = expf(sc - mn); l = l * al + p; m = mn;
#pragma unroll
                for (int dd = 0; dd < 64; ++dd) o[dd] = o[dd] * al + p * bf2f(QKVB[kr + 2048 + h * 64 + dd]); } }
#pragma unroll
        for (int dd = 0; dd < 64; ++dd) CHK(bf2f(YB[row * 1024 + h * 64 + dd]), o[dd] / l * bf2f(ZB[row * 1024 + h * 64 + dd]), 0.03f, 0.003f, 1 + (qblk > 3 ? 1 : 0) + (qblk == 0 ? 2 : 0));
    }
    if (stage == 7) {
        for (int q = 0; q < 4; ++q) { const int t = (lane * 1031 + 17 + q * 4099) % T, n = (lane * 113 + 9 + q * 517) % 2048; float da = 0.f, db = 0.f;
            for (int k = 0; k < WID; ++k) { da += bf2f(YA[(size_t)t * 1024 + k]) * bf2f(WAT[(size_t)n * WID + k]); db += bf2f(YB[(size_t)t * 1024 + k]) * bf2f(WBT[(size_t)n * WID + k]); }
            CHK(bf2f(MERGED[(size_t)t * 2048 + n]), bf2f(G[(size_t)t * 4096 + n]) * da + bf2f(G[(size_t)t * 4096 + 2048 + n]) * db, 0.02f, 0.01f, 1); }
    }
    if (stage == 8) {
        for (int q = 0; q < 4; ++q) { const int t = (lane * 1031 + 17 + q * 4099) % T, n = (lane * 113 + 9 + q * 517) % 2048; float d = 0.f;
            for (int k = 0; k < DM; ++k) d += bf2f(MERGED[(size_t)t * 2048 + k]) * bf2f(WOT[(size_t)n * DM + k]);
            CHK(args.out[(size_t)t * DM + n], args.in[IN_X][(size_t)t * DM + n] + d, 0.f, 0.01f, 1); }
    }
    const float wr = wave_max(ratio);
#pragma unroll
    for (int o_ = 1; o_ < 64; o_ <<= 1) fmask |= (unsigned)__shfl_xor((int)fmask, o_);
    (void)sub;
    if (threadIdx.x == 0 && blockIdx.x == 0 && stage <= 8) { if (fmask && ctl[CW_CHK] == 0u) { const int low = __ffs((int)fmask) - 1, cnt = __popc(fmask);
            ctl[CW_CHK] = (unsigned)(stage * 10 + (low > 9 ? 9 : low)); ctl[CW_CHK + 1] = (unsigned)(cnt + (wr >= 64.f ? 20 : wr >= 8.f ? 10 : 0)); } }
    if (stage == 9) { const unsigned code = ctl[CW_CHK], code2 = ctl[CW_CHK + 1];
        if (code) { for (size_t e = (size_t)blockIdx.x * 64 + lane; e < (size_t)T * DM; e += (size_t)gridDim.x * 64) args.out[e] += (float)code2;
            if (blockIdx.x == 0 && lane == 0) args.out[0] = 100.f * (float)code; } }
#undef CHK
}
#endif

extern "C" void kernel_launch(void* const* d_in, const int* in_sizes, int n_in, void* d_out, int out_size, void* d_ws, size_t ws_size, hipStream_t stream) {
    static int grid = 0;
    if (grid == 0) {
        if (n_in != 22 || in_sizes[0] != T * DM || out_size != T * DM || ws_size < WS_END) { fprintf(stderr, "kernel_launch: unexpected shapes (n_in %d, in0 %d, out %d, ws %zu)\n", n_in, n_in > 0 ? in_sizes[0] : -1, out_size, ws_size); grid = -1; return; }
        int dev = 0, cus = 0, per_cu = 0;
        if (hipGetDevice(&dev) != hipSuccess || hipDeviceGetAttribute(&cus, hipDeviceAttributeMultiprocessorCount, dev) != hipSuccess) { grid = -1; return; }
        if (hipFuncSetAttribute((const void*)mk_fwd, hipFuncAttributeMaxDynamicSharedMemorySize, LDS_BYTES) != hipSuccess) { fprintf(stderr, "kernel_launch: hipFuncSetAttribute failed\n"); grid = -1; return; }
        if (hipOccupancyMaxActiveBlocksPerMultiprocessor(&per_cu, (const void*)mk_fwd, NWAVES * 64, LDS_BYTES) != hipSuccess || per_cu < 1) { fprintf(stderr, "kernel_launch: occupancy query says %d blocks per CU\n", per_cu); per_cu = 1; }
        (void)hipGetLastError();
        grid = cus;
    }
    if (grid < 0) return;
    (void)hipMemsetAsync((char*)d_ws + WS_CTL, 0, CTL_ZERO_BYTES, stream);
    Args a{};
    for (int i = 0; i < 22; ++i) a.in[i] = (const float*)d_in[i];
    a.out = (float*)d_out; a.ws = (unsigned char*)d_ws;
    if (MK_N_LAUNCHES == 1) { a.ph_lo = 0; a.ph_hi = PER_PHASE; a.li = 0; hipLaunchKernelGGL(mk_fwd, dim3(grid), dim3(NWAVES * 64), LDS_BYTES, stream, a); }
    else for (int li = 0; li < PER_PHASE; ++li) { a.ph_lo = li; a.ph_hi = li + 1; a.li = li; hipLaunchKernelGGL(mk_fwd, dim3(grid), dim3(NWAVES * 64), LDS_BYTES, stream, a);
#if MK_CHECK
        const int stg = li <= 5 ? li + 1 : li == 7 ? 7 : li == 8 ? 8 : 0;
        if (stg) hipLaunchKernelGGL(mk_check, dim3(1), dim3(64), 0, stream, a, stg);
        if (li == 8) hipLaunchKernelGGL(mk_check, dim3(512), dim3(64), 0, stream, a, 9);
#endif
    }
}
```

```cpp
#define MK_N_LAUNCHES 1
#include <hip/hip_runtime.h>
#include <cstdio>
#include <cstdint>
#include <hip/hip_bf16.h>
#include <cmath>
__device__ __forceinline__ int mk_lane_id() { int l; asm volatile("v_mbcnt_lo_u32_b32 %0, -1, 0\n\tv_mbcnt_hi_u32_b32 %0, -1, %0" : "=v"(l)); return l; }
#ifndef MK_WGM
#define MK_WGM 4
#endif
namespace pg8 {
#define PG8_LAS __attribute__((address_space(3)))
typedef unsigned short bf16_t;
typedef short bf16x8 __attribute__((ext_vector_type(8)));
typedef float f32x4 __attribute__((ext_vector_type(4)));
typedef unsigned u32x4 __attribute__((ext_vector_type(4)));
constexpr int BM = 256, BK = 64, HALF = 128, HTB = HALF * BK * 2  , STAGE_BYTES = 8 * HTB, NXCD = 8, WGM = MK_WGM;

__host__ __device__ __forceinline__ int lds_byte(int r, int c) { const int st = (r >> 4) * 2 + (c >> 5), rr = r & 15, cc = c & 31, ob = rr * 64 + cc * 2; return st * 1024 + (ob ^ (((ob >> 9) & 1) << 5)); }
__host__ __device__ __forceinline__ void stage_rc(int b, int& R, int& C) { const int st = b / 1024, sb = b % 1024, swz = sb ^ (((sb >> 9) & 1) << 5); R = (st >> 1) * 16 + swz / 64; C = (st & 1) * 32 + (swz % 64) / 2; }
__host__ __device__ __forceinline__ int perm32(int rho) { const int n = rho >> 4, i = rho & 15; return 8 * (i >> 2) + 4 * n + (i & 3); }

struct Unit { int pm, pn; };
struct Gemm { const bf16_t* A; const bf16_t* Bt; int M, N, K; };

template <int W> struct StaticOrderT {
    int nM, nN, nwg, G, c;
    __host__ __device__ void init(int M, int N, int G_, int c_) { nM = M / BM; nN = N / BM; nwg = nM * nN; G = G_; c = c_; }
    __host__ __device__ bool next(int i, Unit& u) const {
        const long L = (long)i * G + c; if (L >= nwg) return false;
        int wgid = (int)L; { const int q = nwg / NXCD, r = nwg % NXCD, xcd = wgid % NXCD, off = wgid / NXCD; wgid = (xcd < r ? xcd * (q + 1) : r * (q + 1) + (xcd - r) * q) + off; }
        const int nig = W * nN, gid = wgid / nig, fm = gid * W, gsz = (nM - fm) < W ? (nM - fm) : W;
        u.pm = fm + ((wgid % nig) % gsz); u.pn = (wgid % nig) / gsz; return true;
    }
    __device__ __forceinline__ void a_ready(const Unit&) const {}
    __device__ __forceinline__ void done(const Unit&) const {}
};
typedef StaticOrderT<WGM> StaticOrder;

__device__ __forceinline__ unsigned cvt_pk_bf16(float lo, float hi) { unsigned r; asm volatile("v_cvt_pk_bf16_f32 %0, %1, %2" : "=v"(r) : "v"(lo), "v"(hi)); return r; }
typedef float f32x2 __attribute__((ext_vector_type(2)));
typedef __bf16 epi_bf16x2 __attribute__((ext_vector_type(2)));
__device__ __forceinline__ unsigned cvt2(float lo, float hi) { f32x2 v = {lo, hi}; epi_bf16x2 b = __builtin_convertvector(v, epi_bf16x2); return __builtin_bit_cast(unsigned, b); }
__device__ __forceinline__ float bf_lo(unsigned w) { return __builtin_bit_cast(float, w << 16); }
__device__ __forceinline__ float bf_hi(unsigned w) { return __builtin_bit_cast(float, w & 0xffff0000u); }
__device__ __forceinline__ float fast_sigmoid(float x) { return __builtin_amdgcn_rcpf(1.0f + __builtin_amdgcn_exp2f(-1.4426950408889634f * x)); }
template <int ACT> __device__ __forceinline__ float act_f(float x) { if (ACT == 1) return x * fast_sigmoid(x); if (ACT == 2) return fast_sigmoid(x); return x; }

#ifndef MK_NT
#define MK_NT 0
#endif
#ifndef MK_WT
#define MK_WT 0
#endif
template <int BIT, class V> __device__ __forceinline__ void epi_st(V* p, const V v) {
    if constexpr ((MK_WT >> BIT) & 1) asm volatile("global_store_dwordx4 %0, %1, off sc1\n\ts_nop 1" :: "v"(p), "v"(v) : "memory");
    else if constexpr ((MK_NT >> BIT) & 1) __builtin_nontemporal_store(v, p); else *p = v; }
template <int BIT, class V> __device__ __forceinline__ V epi_ld(const V* p) { if constexpr ((MK_NT >> BIT) & 1) return __builtin_nontemporal_load(p); else return *p; }
constexpr size_t T_LIN = (size_t)64 * 16 * 8 * 8 * 64;
struct EpiIn {
    static constexpr bool PERM = true, AFTER_DRAIN = false, INIT = false, MID = false;
    bf16_t *RKV, *ZA, *QKVB, *ZB, *G, *LORA;
    template <int ACT, int NBJ> __device__ __forceinline__ void put(const f32x4 (&acc)[2][2][4][2], bf16_t* base, int ldc, int row0, int col0) const {
#pragma unroll
        for (int ai = 0; ai < 2; ++ai)
#pragma unroll
            for (int m = 0; m < 4; ++m) { bf16_t* rowp = base + (size_t)(row0 + ai * HALF + m * 16) * ldc + col0;
#pragma unroll
                for (int bj = 0; bj < NBJ; ++bj) { const f32x4 v0 = acc[ai][bj][m][0], v1 = acc[ai][bj][m][1]; u32x4 w;
                    w.x = cvt2(act_f<ACT>(v0[0]), act_f<ACT>(v0[1])); w.y = cvt2(act_f<ACT>(v0[2]), act_f<ACT>(v0[3]));
                    w.z = cvt2(act_f<ACT>(v1[0]), act_f<ACT>(v1[1])); w.w = cvt2(act_f<ACT>(v1[2]), act_f<ACT>(v1[3]));
                    epi_st<0>((u32x4*)(rowp + bj * HALF), w); } }
    }
    const float* qnw; const float* knw; float* KMEAN;
    template <bool ISK> __device__ __forceinline__ void putqk(const f32x4 (&acc)[2][2][4][2], const Unit& u, int wr, int wc, int fr, int fq) const {
        const int hh = (u.pn & 3) * 4 + wc; const float* nw = ISK ? knw : qnw; const float sc = ISK ? 1.0f : 0.125f * 1.4426950408889634f;
        float rs[2][4];
#pragma unroll
        for (int ai = 0; ai < 2; ++ai)
#pragma unroll
            for (int m = 0; m < 4; ++m) { float ss = 0.f;
#pragma unroll
                for (int bj = 0; bj < 2; ++bj)
#pragma unroll
                    for (int n = 0; n < 2; ++n) { const f32x4 v = acc[ai][bj][m][n]; ss += (v[0] * v[0] + v[1] * v[1]) + (v[2] * v[2] + v[3] * v[3]); }
                ss += __shfl_xor(ss, 16); ss += __shfl_xor(ss, 32);
                rs[ai][m] = 1.0f / sqrtf(ss * (1.0f / 64.0f) + 1e-6f); }
        bf16_t* base = QKVB + (size_t)(u.pm * BM + wr * 64 + fr) * 3072 + (ISK ? 1024 : 0) + hh * 64 + 8 * fq;
#pragma unroll
        for (int bj = 0; bj < 2; ++bj) {
            const f32x4 w0 = *(const f32x4*)(nw + 32 * bj + 8 * fq), w1 = *(const f32x4*)(nw + 32 * bj + 8 * fq + 4);
            const float wv[8] = {w0[0] * sc, w0[1] * sc, w0[2] * sc, w0[3] * sc, w1[0] * sc, w1[1] * sc, w1[2] * sc, w1[3] * sc};
            float cs[8] = {0.f, 0.f, 0.f, 0.f, 0.f, 0.f, 0.f, 0.f};
#pragma unroll
            for (int ai = 0; ai < 2; ++ai)
#pragma unroll
                for (int m = 0; m < 4; ++m) { const f32x4 v0 = acc[ai][bj][m][0], v1 = acc[ai][bj][m][1]; const float r = rs[ai][m]; float o[8];
                    o[0] = v0[0] * r * wv[0]; o[1] = v0[1] * r * wv[1]; o[2] = v0[2] * r * wv[2]; o[3] = v0[3] * r * wv[3]; o[4] = v1[0] * r * wv[4]; o[5] = v1[1] * r * wv[5]; o[6] = v1[2] * r * wv[6]; o[7] = v1[3] * r * wv[7];
                    if (ISK) {
#pragma unroll
                        for (int j = 0; j < 8; ++j) cs[j] += o[j]; }
                    u32x4 w; w.x = cvt2(o[0], o[1]); w.y = cvt2(o[2], o[3]); w.z = cvt2(o[4], o[5]); w.w = cvt2(o[6], o[7]);
                    epi_st<0>((u32x4*)(base + (size_t)(ai * HALF + m * 16) * 3072 + 32 * bj), w); }
            if (ISK) { float* km = KMEAN + ((size_t)((u.pm >> 3) * 16 + hh) * 8 + (u.pm & 7)) * 64;
#pragma unroll
                for (int j = 0; j < 8; ++j) { float s = cs[j]; s += __shfl_xor(s, 1); s += __shfl_xor(s, 2); s += __shfl_xor(s, 4); s += __shfl_xor(s, 8);
                    if (fr == 0) atomicAdd(km + 32 * bj + 8 * fq + j, s * (1.0f / 256.0f)); } } }
    }
    __device__ __forceinline__ void putgate(const f32x4 (&acc)[2][2][4][2], const Unit& u, int wr, int wc, int fr, int fq) const {
        u32x4* gp = (u32x4*)G + ((((size_t)u.pm * 16 + (u.pn - 32)) * 8 + wr * 4 + wc) * 8) * 64 + fq * 16 + fr;
#pragma unroll
        for (int ai = 0; ai < 2; ++ai)
#pragma unroll
            for (int m = 0; m < 4; ++m) { float s[8], r[8];
#pragma unroll
                for (int n = 0; n < 2; ++n)
#pragma unroll
                    for (int e = 0; e < 4; ++e) { const float sa = fmaxf(fast_sigmoid(acc[ai][0][m][n][e]), 1e-30f), sb = fast_sigmoid(acc[ai][1][m][n][e]); s[4 * n + e] = sa; r[4 * n + e] = sb * __builtin_amdgcn_rcpf(sa); }
                u32x4 w; w.x = cvt2(s[0], s[1]); w.y = cvt2(s[2], s[3]); w.z = cvt2(s[4], s[5]); w.w = cvt2(s[6], s[7]); epi_st<0>(gp + (ai * 4 + m) * 64, w);
                w.x = cvt2(r[0], r[1]); w.y = cvt2(r[2], r[3]); w.z = cvt2(r[4], r[5]); w.w = cvt2(r[6], r[7]); epi_st<0>(gp + T_LIN + (ai * 4 + m) * 64, w); }
    }
    __device__ __forceinline__ void operator()(const f32x4 (&acc)[2][2][4][2], const Unit& u, int wr, int wc, int fr, int fq) const {
        asm volatile("" : "+v"(fr), "+v"(fq));
        const int row0 = u.pm * BM + wr * 64 + fr, cw = wc * 32 + 8 * fq, pn = u.pn;
        if (pn >= 16 && pn < 20) putqk<false>(acc, u, wr, wc, fr, fq);
        else if (pn >= 20 && pn < 24) putqk<true>(acc, u, wr, wc, fr, fq);
        else if (pn < 12) put<0, 2>(acc, RKV, 3072, row0, pn * 256 + cw);
        else if (pn < 16) put<1, 2>(acc, ZA, 1024, row0, (pn - 12) * 256 + cw);
        else if (pn < 28) put<0, 2>(acc, QKVB, 3072, row0, (pn - 16) * 256 + cw);
        else if (pn < 32) put<1, 2>(acc, ZB, 1024, row0, (pn - 28) * 256 + cw);
        else if (pn < 48) putgate(acc, u, wr, wc, fr, fq);
        else put<0, 1>(acc, LORA, 128, row0, cw);
    }
};
template <bool LD = true, bool ST = true, bool LIN = true> struct EpiMergeFT {
    static constexpr bool PERM = true, AFTER_DRAIN = false, INIT = false, MID = true;
    const bf16_t* G; bf16_t* O;
    __device__ __forceinline__ void mid(f32x4 (&acc)[2][2][4][2], const Unit& u, int wr, int wc, int fr, int fq) const {
        asm volatile("" : "+v"(fr), "+v"(fq));
        const int row0 = u.pm * BM + wr * 64 + fr, col0 = u.pn * BM + wc * 32 + 8 * fq;
#pragma unroll
        for (int ai = 0; ai < 2; ++ai) { u32x4 g[4][2];
#pragma unroll
            for (int m = 0; m < 4; ++m)
#pragma unroll
                for (int bj = 0; bj < 2; ++bj) g[m][bj] = LIN ? epi_ld<2>((const u32x4*)(G + 8 * ((((((size_t)u.pm * 16 + 2 * u.pn + bj) * 8 + wr * 4 + wc) * 8 + ai * 4 + m) * 64 + fq * 16 + fr) + (size_t)T_LIN))) : LD ? *(const u32x4*)(G + (size_t)(row0 + ai * HALF + m * 16) * 4096 + 2048 + col0 + bj * HALF) : (u32x4){0x3f003f00u, 0x3f003f00u, 0x3f003f00u, 0x3f003f00u};
#pragma unroll
            for (int m = 0; m < 4; ++m)
#pragma unroll
                for (int bj = 0; bj < 2; ++bj) { const u32x4 gg = g[m][bj]; f32x4 v0 = acc[ai][bj][m][0], v1 = acc[ai][bj][m][1];
                    v0[0] *= bf_lo(gg.x); v0[1] *= bf_hi(gg.x); v0[2] *= bf_lo(gg.y); v0[3] *= bf_hi(gg.y); v1[0] *= bf_lo(gg.z); v1[1] *= bf_hi(gg.z); v1[2] *= bf_lo(gg.w); v1[3] *= bf_hi(gg.w);
                    acc[ai][bj][m][0] = v0; acc[ai][bj][m][1] = v1; } }
    }
    __device__ __forceinline__ void operator()(const f32x4 (&acc)[2][2][4][2], const Unit& u, int wr, int wc, int fr, int fq) const {
        const int row0 = u.pm * BM + wr * 64 + fr, col0 = u.pn * BM + wc * 32 + 8 * fq;
#pragma unroll
        for (int ai = 0; ai < 2; ++ai) { u32x4 g[4][2];
#pragma unroll
            for (int m = 0; m < 4; ++m)
#pragma unroll
                for (int bj = 0; bj < 2; ++bj) g[m][bj] = LIN ? epi_ld<2>((const u32x4*)(G + 8 * (((((size_t)u.pm * 16 + 2 * u.pn + bj) * 8 + wr * 4 + wc) * 8 + ai * 4 + m) * 64 + fq * 16 + fr))) : LD ? *(const u32x4*)(G + (size_t)(row0 + ai * HALF + m * 16) * 4096 + col0 + bj * HALF) : (u32x4){0x3f003f00u, 0x3f003f00u, 0x3f003f00u, 0x3f003f00u};
#pragma unroll
            for (int m = 0; m < 4; ++m)
#pragma unroll
                for (int bj = 0; bj < 2; ++bj) { const u32x4 gg = g[m][bj]; const f32x4 v0 = acc[ai][bj][m][0], v1 = acc[ai][bj][m][1]; u32x4 w;
                    w.x = cvt2(v0[0] * bf_lo(gg.x), v0[1] * bf_hi(gg.x)); w.y = cvt2(v0[2] * bf_lo(gg.y), v0[3] * bf_hi(gg.y)); w.z = cvt2(v1[0] * bf_lo(gg.z), v1[1] * bf_hi(gg.z)); w.w = cvt2(v1[2] * bf_lo(gg.w), v1[3] * bf_hi(gg.w));
                    if (ST || w.x == 0x7fc17fc1u) epi_st<2>((u32x4*)(O + (size_t)(row0 + ai * HALF + m * 16) * 2048 + col0 + bj * HALF), w); } }
    }
};
typedef EpiMergeFT<true, true, true> EpiMergeF;
template <bool LD = true, bool ST = true, int BATCH = 16> struct EpiOutT {
    static constexpr bool PERM = false, AFTER_DRAIN = false, INIT = false, MID = false;
    const float* X; float* O;
    __device__ __forceinline__ void operator()(const f32x4 (&acc)[2][2][4][2], const Unit& u, int wr, int wc, int fr, int fq) const {
        const int row0 = u.pm * BM + wr * 64 + fr, col0 = u.pn * BM + wc * 32 + 4 * fq;
        if constexpr (BATCH == 17) {
            f32x4 x[4][2][2], r[4][2][2];
#pragma unroll
            for (int m = 0; m < 4; ++m)
#pragma unroll
                for (int bj = 0; bj < 2; ++bj)
#pragma unroll
                    for (int n = 0; n < 2; ++n) x[m][bj][n] = epi_ld<1>((const f32x4*)(X + (size_t)(row0 + m * 16) * 2048 + col0 + bj * HALF + n * 16));
#pragma unroll
            for (int m = 0; m < 4; ++m)
#pragma unroll
                for (int bj = 0; bj < 2; ++bj)
#pragma unroll
                    for (int n = 0; n < 2; ++n) r[m][bj][n] = x[m][bj][n] + acc[0][bj][m][n];
#pragma unroll
            for (int m = 0; m < 4; ++m)
#pragma unroll
                for (int bj = 0; bj < 2; ++bj)
#pragma unroll
                    for (int n = 0; n < 2; ++n) x[m][bj][n] = epi_ld<1>((const f32x4*)(X + (size_t)(row0 + HALF + m * 16) * 2048 + col0 + bj * HALF + n * 16));
#pragma unroll
            for (int m = 0; m < 4; ++m)
#pragma unroll
                for (int bj = 0; bj < 2; ++bj)
#pragma unroll
                    for (int n = 0; n < 2; ++n) epi_st<1>((f32x4*)(O + (size_t)(row0 + m * 16) * 2048 + col0 + bj * HALF + n * 16), r[m][bj][n]);
#pragma unroll
            for (int m = 0; m < 4; ++m)
#pragma unroll
                for (int bj = 0; bj < 2; ++bj)
#pragma unroll
                    for (int n = 0; n < 2; ++n) epi_st<1>((f32x4*)(O + (size_t)(row0 + HALF + m * 16) * 2048 + col0 + bj * HALF + n * 16), x[m][bj][n] + acc[1][bj][m][n]);
        } else if constexpr (BATCH == 16) {
#pragma unroll
            for (int ai = 0; ai < 2; ++ai) { f32x4 x[4][2][2];
#pragma unroll
                for (int m = 0; m < 4; ++m)
#pragma unroll
                    for (int bj = 0; bj < 2; ++bj)
#pragma unroll
                        for (int n = 0; n < 2; ++n) x[m][bj][n] = LD ? epi_ld<1>((const f32x4*)(X + (size_t)(row0 + ai * HALF + m * 16) * 2048 + col0 + bj * HALF + n * 16)) : (f32x4){1.f, 1.f, 1.f, 1.f};
#pragma unroll
                for (int m = 0; m < 4; ++m)
#pragma unroll
                    for (int bj = 0; bj < 2; ++bj)
#pragma unroll
                        for (int n = 0; n < 2; ++n) { const f32x4 v = x[m][bj][n] + acc[ai][bj][m][n]; if (ST || v[0] == 1.2345e30f) epi_st<1>((f32x4*)(O + (size_t)(row0 + ai * HALF + m * 16) * 2048 + col0 + bj * HALF + n * 16), v); } }
        } else {
#pragma unroll
        for (int ai = 0; ai < 2; ++ai)
#pragma unroll
            for (int m = 0; m < 4; ++m) { const size_t off = (size_t)(row0 + ai * HALF + m * 16) * 2048 + col0;
#pragma unroll
                for (int bj = 0; bj < 2; ++bj)
#pragma unroll
                    for (int n = 0; n < 2; ++n) { const f32x4 v = (LD ? *(const f32x4*)(X + off + bj * HALF + n * 16) : (f32x4){1.f, 1.f, 1.f, 1.f}) + acc[ai][bj][m][n]; if (ST || v[0] == 1.2345e30f) *(f32x4*)(O + off + bj * HALF + n * 16) = v; } }
        }
    }
};
typedef EpiOutT<true, true, 17> EpiOut;
template <class Epi, class Sched, bool ALIGN_EPI = false, bool SP2 = false>
__device__ __forceinline__ void gemm_phase(PG8_LAS unsigned char* lds, const Gemm g, const Sched& S, const Epi& E, const int wave_id) {
    const int wid = __builtin_amdgcn_readfirstlane(wave_id), lane = mk_lane_id(), tid = wid * 64 + lane, wr = wid >> 2, wc = wid & 3, fr = lane & 15, fq = lane >> 4;
    const int K = g.K, nt = K / BK;
    unsigned voffA[2], voffB[2];
#pragma unroll
    for (int i = 0; i < 2; ++i) { int R, C; stage_rc(tid * 16 + i * 8192, R, C); const int Rb = Epi::PERM ? ((R & ~31) + perm32(R & 31)) : R;
        voffA[i] = (unsigned)(R * K + C) * 2u; voffB[i] = (unsigned)(Rb * K + C) * 2u; }
    const size_t kstep = (size_t)(BK * 2);
    const size_t hstep = (size_t)HALF * K * 2;
    const size_t tstep = 2 * hstep;
    const unsigned ldsw = (unsigned)wid * 1024u;
    const int aoff = lds_byte(wr * 64 + fr, fq * 8), boff = lds_byte(wc * 32 + fr, fq * 8);
#define PG8_SA(b, h) (((b) * 2 + (h)) * HTB)
#define PG8_SB(b, h) ((4 + (b) * 2 + (h)) * HTB)
#define PG8_STAGE(bufoff, gbase, voff) do { _Pragma("unroll") for (int _i = 0; _i < 2; ++_i) \
        __builtin_amdgcn_global_load_lds((const unsigned*)((const char*)(gbase) + (voff)[_i]), (PG8_LAS unsigned*)(lds + (bufoff) + ldsw + _i * 8192), 16, 0, 0); } while (0)
#define PG8_LDA(dst, b, h) do { _Pragma("unroll") for (int m = 0; m < 4; ++m) _Pragma("unroll") for (int k = 0; k < 2; ++k) dst[m][k] = *(const PG8_LAS bf16x8*)(lds + PG8_SA(b, h) + aoff + m * 2048 + k * 1024); } while (0)
#define PG8_LDB(dst, b, h) do { _Pragma("unroll") for (int n = 0; n < 2; ++n) _Pragma("unroll") for (int k = 0; k < 2; ++k) dst[n][k] = *(const PG8_LAS bf16x8*)(lds + PG8_SB(b, h) + boff + n * 2048 + k * 1024); } while (0)
#define PG8_MMA(ai, bj, At, Bt) do { __builtin_amdgcn_s_setprio(1); _Pragma("unroll") for (int m = 0; m < 4; ++m) _Pragma("unroll") for (int n = 0; n < 2; ++n) _Pragma("unroll") for (int k = 0; k < 2; ++k) \
        acc[ai][bj][m][n] = __builtin_amdgcn_mfma_f32_16x16x32_bf16(Bt[n][k], At[m][k], acc[ai][bj][m][n], 0, 0, 0); __builtin_amdgcn_s_setprio(0); } while (0)
#define PG8_WAIT_V(n) asm volatile("s_waitcnt vmcnt(" #n ")" ::: "memory")
#define PG8_WAIT_L(n) asm volatile("s_waitcnt lgkmcnt(" #n ")" ::: "memory")
#define PG8_BAR __builtin_amdgcn_s_barrier()
#define PG8_SCHED __builtin_amdgcn_sched_barrier(0)
    Unit cur, nxt; int ui = 0;
    if (!S.next(0, cur)) return;
    f32x4 acc[2][2][4][2];
    if constexpr (Epi::INIT) E.init(acc, cur, wr, wc, fr, fq);
    else {
#pragma unroll
    for (int a = 0; a < 2; ++a)
#pragma unroll
        for (int b = 0; b < 2; ++b)
#pragma unroll
            for (int m = 0; m < 4; ++m)
#pragma unroll
                for (int n = 0; n < 2; ++n) acc[a][b][m][n] = (f32x4){0.f, 0.f, 0.f, 0.f};
    }
    bf16x8 At[4][2], B0[2][2], B1[2][2];
    const char* cA = (const char*)g.A + (size_t)cur.pm * tstep; const char* cB = (const char*)g.Bt + (size_t)cur.pn * tstep;
    S.a_ready(cur);
    if constexpr (SP2) {
        PG8_STAGE(PG8_SB(0, 0), cB, voffB); PG8_STAGE(PG8_SB(0, 1), cB + hstep, voffB); PG8_STAGE(PG8_SA(0, 0), cA, voffA); PG8_STAGE(PG8_SA(0, 1), cA + hstep, voffA);
        if (wr == 1) PG8_BAR;
        PG8_WAIT_V(2); PG8_BAR;
        PG8_STAGE(PG8_SB(1, 0), cB + kstep, voffB); PG8_STAGE(PG8_SA(1, 0), cA + kstep, voffA); PG8_STAGE(PG8_SB(1, 1), cB + hstep + kstep, voffB);
        PG8_WAIT_V(6); PG8_BAR;
    } else {
        PG8_STAGE(PG8_SB(0, 0), cB, voffB); PG8_STAGE(PG8_SA(0, 0), cA, voffA); PG8_STAGE(PG8_SB(0, 1), cB + hstep, voffB); PG8_STAGE(PG8_SA(0, 1), cA + hstep, voffA);
        if (wr == 1) PG8_BAR;
        PG8_WAIT_V(4); PG8_BAR;
        PG8_STAGE(PG8_SB(1, 0), cB + kstep, voffB); PG8_STAGE(PG8_SA(1, 0), cA + kstep, voffA); PG8_STAGE(PG8_SB(1, 1), cB + hstep + kstep, voffB);
        PG8_WAIT_V(6); PG8_BAR;
    }
    for (;;) {
        const bool has_next = S.next(ui + 1, nxt);
        const char* nA = has_next ? (const char*)g.A + (size_t)nxt.pm * tstep : cA; const char* nB = has_next ? (const char*)g.Bt + (size_t)nxt.pn * tstep : cB;
        for (int t = 0; t < nt; t += 2) {
            const bool last = (t == nt - 2);
            const char* a1 = cA + (size_t)(t + 1) * kstep;
            const char* a2 = last ? nA : cA + (size_t)(t + 2) * kstep; const char* b2 = last ? nB : cB + (size_t)(t + 2) * kstep;
            const char* a3 = a2 + kstep; const char* b3 = b2 + kstep;
            if (last && has_next) S.a_ready(nxt);
            if constexpr (Epi::MID) { if (t == nt / 2) E.mid(acc, cur, wr, wc, fr, fq); }
            if constexpr (SP2) {
            PG8_LDB(B0, 0, 0); PG8_LDB(B1, 0, 1); PG8_SCHED; PG8_LDA(At, 0, 0); PG8_STAGE(PG8_SA(1, 1), a1 + hstep, voffA);
            PG8_WAIT_V(8); PG8_WAIT_L(0); PG8_BAR; PG8_MMA(0, 0, At, B0); PG8_MMA(0, 1, At, B1); PG8_BAR; PG8_SCHED;
            PG8_LDA(At, 0, 1); PG8_STAGE(PG8_SB(0, 0), b2, voffB); PG8_STAGE(PG8_SB(0, 1), b2 + hstep, voffB); PG8_STAGE(PG8_SA(0, 0), a2, voffA);
            PG8_WAIT_V(8); PG8_WAIT_L(0); PG8_BAR; PG8_MMA(1, 0, At, B0); PG8_MMA(1, 1, At, B1); PG8_BAR; PG8_SCHED;
            PG8_LDB(B0, 1, 0); PG8_LDB(B1, 1, 1); PG8_SCHED; PG8_LDA(At, 1, 0); PG8_STAGE(PG8_SA(0, 1), a2 + hstep, voffA);
            PG8_WAIT_V(8); PG8_WAIT_L(0); PG8_BAR; PG8_MMA(0, 0, At, B0); PG8_MMA(0, 1, At, B1); PG8_BAR; PG8_SCHED;
            PG8_LDA(At, 1, 1); PG8_STAGE(PG8_SB(1, 0), b3, voffB); PG8_STAGE(PG8_SB(1, 1), b3 + hstep, voffB); PG8_STAGE(PG8_SA(1, 0), a3, voffA);
            PG8_WAIT_V(8); PG8_WAIT_L(0); PG8_BAR; PG8_MMA(1, 0, At, B0); PG8_MMA(1, 1, At, B1); PG8_BAR; PG8_SCHED;
            } else {
            PG8_LDB(B0, 0, 0); PG8_SCHED; PG8_LDA(At, 0, 0); PG8_STAGE(PG8_SA(1, 1), a1 + hstep, voffA);
            PG8_WAIT_L(8); PG8_BAR; PG8_WAIT_L(0); PG8_MMA(0, 0, At, B0); PG8_BAR; PG8_SCHED;
            PG8_LDB(B1, 0, 1); PG8_STAGE(PG8_SB(0, 0), b2, voffB);
            PG8_BAR; PG8_WAIT_L(0); PG8_MMA(0, 1, At, B1); PG8_BAR;
            PG8_LDA(At, 0, 1); PG8_STAGE(PG8_SA(0, 0), a2, voffA);
            PG8_BAR; PG8_WAIT_L(0); PG8_MMA(1, 0, At, B0); PG8_BAR; PG8_SCHED;
            PG8_STAGE(PG8_SB(0, 1), b2 + hstep, voffB);
            PG8_WAIT_V(6); PG8_BAR; PG8_MMA(1, 1, At, B1); PG8_BAR;
            PG8_LDB(B0, 1, 0); PG8_SCHED; PG8_LDA(At, 1, 0); PG8_STAGE(PG8_SA(0, 1), a2 + hstep, voffA);
            PG8_WAIT_L(8); PG8_BAR; PG8_WAIT_L(0); PG8_MMA(0, 0, At, B0); PG8_BAR; PG8_SCHED;
            PG8_LDB(B1, 1, 1); PG8_STAGE(PG8_SB(1, 0), b3, voffB);
            PG8_BAR; PG8_WAIT_L(0); PG8_MMA(0, 1, At, B1); PG8_BAR;
            PG8_LDA(At, 1, 1); PG8_STAGE(PG8_SA(1, 0), a3, voffA);
            PG8_BAR; PG8_WAIT_L(0); PG8_MMA(1, 0, At, B0); PG8_BAR; PG8_SCHED;
            PG8_STAGE(PG8_SB(1, 1), b3 + hstep, voffB);
            PG8_WAIT_V(6); PG8_BAR; PG8_MMA(1, 1, At, B1); PG8_BAR;
            }
        }
        if constexpr (ALIGN_EPI) { if (wr == 0) PG8_BAR; }
        if constexpr (!Epi::AFTER_DRAIN) { E(acc, cur, wr, wc, fr, fq); S.done(cur); }
        if (!has_next) break;
        if constexpr (Epi::INIT) E.init(acc, nxt, wr, wc, fr, fq);
        else {
#pragma unroll
        for (int a = 0; a < 2; ++a)
#pragma unroll
            for (int b = 0; b < 2; ++b)
#pragma unroll
                for (int m = 0; m < 4; ++m)
#pragma unroll
                    for (int n = 0; n < 2; ++n) acc[a][b][m][n] = (f32x4){0.f, 0.f, 0.f, 0.f};
        }
        cur = nxt; cA = nA; cB = nB; ++ui;
        if constexpr (ALIGN_EPI) { if (wr == 1) PG8_BAR; }
    }
    PG8_WAIT_V(0);
    if constexpr (!ALIGN_EPI) { if (wr == 0) PG8_BAR; }
    PG8_BAR;
    if constexpr (Epi::AFTER_DRAIN) { E.fused(acc, cur, wr, wc, fr, fq, lds, wid, lane); S.done(cur); }
#undef PG8_SA
#undef PG8_SB
#undef PG8_STAGE
#undef PG8_LDA
#undef PG8_LDB
#undef PG8_MMA
#undef PG8_WAIT_V
#undef PG8_WAIT_L
#undef PG8_BAR
#undef PG8_SCHED
}
}
#define GAS __attribute__((address_space(1)))
#define LAS __attribute__((address_space(3)))
typedef unsigned short bf16;
typedef unsigned v4u __attribute__((ext_vector_type(4)));
typedef float f32x4 __attribute__((ext_vector_type(4)));
typedef short bf16x8 __attribute__((ext_vector_type(8)));
typedef GAS unsigned gu32;
typedef GAS unsigned long long gu64;
#define RLX_AGENT __ATOMIC_RELAXED, __HIP_MEMORY_SCOPE_AGENT
#define LDS_WAIT() asm volatile("s_waitcnt lgkmcnt(0)" ::: "memory")
#define VM_WAIT() asm volatile("s_waitcnt vmcnt(0)" ::: "memory")
__device__ __forceinline__ unsigned long long rt() { return __builtin_amdgcn_s_memrealtime(); }
__device__ __forceinline__ unsigned f2bf(float f) { unsigned u = __builtin_bit_cast(unsigned, f); return (u + 0x7fffu + ((u >> 16) & 1u)) >> 16; }
__device__ __forceinline__ unsigned pk2(float lo, float hi) { return f2bf(lo) | (f2bf(hi) << 16); }

#define XB_TMO      128
#define XB_XCNT(j)  (256  + 64 * (j))
#define XB_XSUB(j)  (1280 + 64 * (j))
#define XB_XGEN(j)  (2304 + 64 * (j))
#define XB_TOP      3328
#define XB_TOPGEN   3392
#define XCD_BAR_WORDS 3456
#define XB_SPIN_CAP (1u << 18)

__device__ __forceinline__ unsigned xb_ld(unsigned* p)              { return __hip_atomic_load(p, __ATOMIC_RELAXED, __HIP_MEMORY_SCOPE_AGENT); }
__device__ __forceinline__ unsigned xb_add(unsigned* p, unsigned v) { return __hip_atomic_fetch_add(p, v, __ATOMIC_RELAXED, __HIP_MEMORY_SCOPE_AGENT); }
__device__ __forceinline__ unsigned xb_xcc_id() { return (unsigned)__builtin_amdgcn_s_getreg((3 << 11) | 20) & 0xFu; }
#define XB_SPIN(cond, bar) do { unsigned _sp = 0; while (cond) { __builtin_amdgcn_s_sleep(1); \
    if ((++_sp & 255u) == 0u) { if (xb_ld(&(bar)[XB_TMO])) break; if (_sp > XB_SPIN_CAP) { atomicAdd(&(bar)[XB_TMO], 1u); break; } } } } while (0)

struct XcdBarrier {
    unsigned* bar; unsigned x;
    volatile LAS unsigned* st;
};

__device__ __forceinline__ XcdBarrier xcd_barrier_post(unsigned* bar, volatile LAS unsigned* st, const bool t0) {
    XcdBarrier b; b.bar = bar; b.x = xb_xcc_id(); b.st = st;
    if (t0) (void)xb_add(&bar[XB_XCNT(b.x)], 1u);
    return b;
}
__device__ __forceinline__ void xcd_barrier_complete(unsigned* bar, unsigned x, unsigned& nloc, unsigned& nx) {
    const unsigned G = gridDim.x * gridDim.y * gridDim.z;
    unsigned sum, cnt, mine, sp = 0u;
    for (;;) {
        sum = 0u; cnt = 0u; mine = 0u;
#pragma unroll
        for (unsigned j = 0; j < 16; ++j) { const unsigned c = xb_ld(&bar[XB_XCNT(j)]); sum += c; cnt += (c > 0u) ? 1u : 0u; mine = (j == x) ? c : mine; }
        if (sum == G) break;
        __builtin_amdgcn_s_sleep(1);
        if ((++sp & 255u) == 0u) { if (xb_ld(&bar[XB_TMO])) break; if (sp > XB_SPIN_CAP) { atomicAdd(&bar[XB_TMO], 1u); break; } }
    }
    nloc = mine > 0u ? mine : 1u; nx = cnt > 0u ? cnt : 1u;
}

__device__ __forceinline__ void xcd_barrier_a() {
    asm volatile("s_waitcnt vmcnt(0)" ::: "memory");
    __syncthreads();
}
__device__ __forceinline__ void xcd_barrier_b(const XcdBarrier& b, const bool t0) {
    if (t0) {
        unsigned* bar = b.bar;
        __builtin_amdgcn_s_waitcnt(0);
        unsigned nloc = b.st[0], nx = b.st[1];
        if (nloc == 0u) { xcd_barrier_complete(bar, b.x, nloc, nx); b.st[0] = nloc; b.st[1] = nx; }
        const unsigned old = xb_add(&bar[XB_XSUB(b.x)], 1u);
        const unsigned gen = old / nloc;
        if (old + 1u == (gen + 1u) * nloc) {
            __builtin_amdgcn_fence(__ATOMIC_RELEASE, "agent");
            asm volatile("s_waitcnt vmcnt(0)" ::: "memory");
            const unsigned og = xb_add(&bar[XB_TOP], 1u);
            const unsigned tg = og / nx;
            if (og + 1u == (tg + 1u) * nx) xb_add(&bar[XB_TOPGEN], 1u);
            else XB_SPIN(xb_ld(&bar[XB_TOPGEN]) == tg, bar);
            __builtin_amdgcn_fence(__ATOMIC_ACQUIRE, "agent");
            xb_add(&bar[XB_XGEN(b.x)], 1u);
            asm volatile("s_waitcnt vmcnt(0)" ::: "memory");
        } else {
            XB_SPIN(xb_ld(&bar[XB_XGEN(b.x)]) == gen, bar);
            __builtin_amdgcn_fence(__ATOMIC_ACQUIRE, "agent");
            asm volatile("s_waitcnt vmcnt(0)" ::: "memory");
        }
    }
    __syncthreads();
}
__device__ __forceinline__ void xcd_barrier(const XcdBarrier& b, const bool t0) { xcd_barrier_a(); xcd_barrier_b(b, t0); }
namespace attn_body {
using bf16=__hip_bfloat16;
using bf16x8=__attribute__((ext_vector_type(8)))short;
using s16x4=__attribute__((ext_vector_type(4)))short;
using f32x16=__attribute__((ext_vector_type(16)))float;
using u32x4=__attribute__((ext_vector_type(4)))unsigned;
constexpr int BATCH=8,NHEAD=16,SEQ=2048,D=64,DM=3072,OPITCH=2048,ZPITCH=1024;
constexpr int NW=8,QBLK=32,QB=QBLK*NW,KVBLK=64,NQB=SEQ/QB;
constexpr int ATTN_PITCH=DM, ATTN_UNIT_ROWS=QB;
__device__ __forceinline__ int crow(int r,int hi){return (r&3)+8*(r>>2)+4*hi;}
#define SBAR() __builtin_amdgcn_sched_barrier(0)
__device__ __forceinline__ void cmask(f32x16&p0,f32x16&p1,int jb,int qrel,int hi){
  const float NEG=-INFINITY; int kb=64*jb+4*hi;
  #pragma unroll
  for(int r=0;r<16;++r){int kv=kb+(r&3)+8*(r>>2); if(kv>qrel)p0[r]=NEG; if(kv+32>qrel)p1[r]=NEG;}
}

constexpr int NSLOT=3, SLOTB=8192;
constexpr int LDS_K=0, LDS_V=NSLOT*SLOTB, LDS_WS=2*NSLOT*SLOTB, LDS_OST=LDS_WS+NW*64*4, LDS_BYTES=LDS_OST+NW*4096;
constexpr float C2=0.125f*1.4426950408889634f;
__device__ __forceinline__ float bflo(unsigned w){return __uint_as_float(w<<16);}
__device__ __forceinline__ float bfhi(unsigned w){return __uint_as_float(w&0xffff0000u);}
__device__ __forceinline__ float bfs(short v){return __uint_as_float(((unsigned)(unsigned short)v)<<16);}
__device__ __forceinline__ void glds16(const void*gsrc,unsigned lds_dst){unsigned keep;
  asm volatile("s_mov_b32 %0, m0\n\ts_mov_b32 m0, %2\n\ts_nop 0\n\tglobal_load_lds_dwordx4 %1, off\n\ts_mov_b32 m0, %0":"=&s"(keep):"v"(gsrc),"s"(lds_dst):"memory");}
__device__ __forceinline__ float max3f(float a,float b,float c){float r;asm("v_max3_f32 %0, %1, %2, %3":"=v"(r):"v"(a),"v"(b),"v"(c));return r;}
__device__ __forceinline__ float max2f(float a,float b){float r;asm("v_max_f32_e32 %0, %1, %2":"=v"(r):"v"(a),"v"(b));return r;}
__device__ __forceinline__ float fadd_s(float a,float b){float r;asm("v_add_f32_e32 %0, %1, %2":"=v"(r):"v"(a),"v"(b));return r;}
__device__ __forceinline__ float fsub_s(float a,float b){float r;asm("v_sub_f32_e32 %0, %1, %2":"=v"(r):"v"(a),"v"(b));return r;}
typedef float f32x2_t __attribute__((ext_vector_type(2))); typedef __bf16 bf16x2_t __attribute__((ext_vector_type(2)));
__device__ __forceinline__ unsigned cvtpk_s(float lo,float hi){f32x2_t v={lo,hi};bf16x2_t b=__builtin_convertvector(v,bf16x2_t);return __builtin_bit_cast(unsigned,b);}
#define WAIT_BAR(N) asm volatile("s_waitcnt vmcnt(" #N ") lgkmcnt(0)\n\ts_barrier":::"memory")

__device__ __forceinline__ void qkt(f32x16&p0,f32x16&p1,const char*Kslot,const bf16x8*qr,const f32x16&negm,int r32,int hi){
  const char*kb=Kslot+hi*1024+r32*16;
  #pragma unroll
  for(int d0=0;d0<4;++d0){
    const bf16x8 b0=*reinterpret_cast<const bf16x8*>(kb+d0*2048);
    const bf16x8 b1=*reinterpret_cast<const bf16x8*>(kb+d0*2048+512);
    if(d0==0){p0=__builtin_amdgcn_mfma_f32_32x32x16_bf16(b0,qr[0],negm,0,0,0);p1=__builtin_amdgcn_mfma_f32_32x32x16_bf16(b1,qr[0],negm,0,0,0);}
    else{p0=__builtin_amdgcn_mfma_f32_32x32x16_bf16(b0,qr[d0],p0,0,0,0);p1=__builtin_amdgcn_mfma_f32_32x32x16_bf16(b1,qr[d0],p1,0,0,0);}}
}
typedef __attribute__((address_space(3))) const char* lds_cptr;
typedef short v4i16_t __attribute__((ext_vector_type(4)));
__device__ __forceinline__ void kload8(bf16x8*kf,lds_cptr kp){
  kf[0]=*(const __attribute__((address_space(3))) bf16x8*)(kp);      kf[1]=*(const __attribute__((address_space(3))) bf16x8*)(kp+512);
  kf[2]=*(const __attribute__((address_space(3))) bf16x8*)(kp+2048); kf[3]=*(const __attribute__((address_space(3))) bf16x8*)(kp+2560);
  kf[4]=*(const __attribute__((address_space(3))) bf16x8*)(kp+4096); kf[5]=*(const __attribute__((address_space(3))) bf16x8*)(kp+4608);
  kf[6]=*(const __attribute__((address_space(3))) bf16x8*)(kp+6144); kf[7]=*(const __attribute__((address_space(3))) bf16x8*)(kp+6656);
}
__device__ __forceinline__ void kload2(bf16x8*kf,lds_cptr kp,int j){ kf[2*j]=*(const __attribute__((address_space(3))) bf16x8*)(kp+j*2048); kf[2*j+1]=*(const __attribute__((address_space(3))) bf16x8*)(kp+j*2048+512); }
__device__ __forceinline__ s16x4 vtr(lds_cptr p){ return __builtin_bit_cast(s16x4,__builtin_amdgcn_ds_read_tr16_b64_v4i16((__attribute__((address_space(3))) v4i16_t*)p)); }
__device__ __forceinline__ float rowmax(const f32x16&p0,const f32x16&p1){
  float a=max3f(p0[0],p0[1],p1[0]),b=max3f(p0[2],p0[3],p1[1]);a=max3f(a,p1[2],p1[3]);
  #pragma unroll
  for(int r=4;r<16;r+=4){a=max3f(a,p0[r],p0[r+1]);b=max3f(b,p0[r+2],p0[r+3]);a=max3f(a,p1[r],p1[r+1]);b=max3f(b,p1[r+2],p1[r+3]);}
  const float m=max2f(a,b);
  auto rr=__builtin_amdgcn_permlane32_swap(__float_as_uint(m),__float_as_uint(m),false,false);
  return max2f(__uint_as_float(rr[0]),__uint_as_float(rr[1]));
}
__device__ __forceinline__ void pv(f32x16*o,int vb,bf16x8 pa0,bf16x8 pa1,bf16x8 pa2,bf16x8 pa3){
  #pragma unroll
  for(int d0=0;d0<2;++d0){s16x4 lo[4],hi[4];
    #pragma unroll
    for(int ks=0;ks<4;++ks){
      asm volatile("ds_read_b64_tr_b16 %0,%1 offset:%c2":"=&v"(lo[ks]):"v"(vb),"i"(d0*4096+ks*1024):"memory");
      asm volatile("ds_read_b64_tr_b16 %0,%1 offset:%c2":"=&v"(hi[ks]):"v"(vb),"i"(d0*4096+ks*1024+512):"memory");}
    asm volatile("s_waitcnt lgkmcnt(0)":::"memory");SBAR();
    #define PK(k) (bf16x8){lo[k][0],lo[k][1],lo[k][2],lo[k][3],hi[k][0],hi[k][1],hi[k][2],hi[k][3]}
    o[d0]=__builtin_amdgcn_mfma_f32_32x32x16_bf16(pa0,PK(0),o[d0],0,0,0);
    o[d0]=__builtin_amdgcn_mfma_f32_32x32x16_bf16(pa1,PK(1),o[d0],0,0,0);
    o[d0]=__builtin_amdgcn_mfma_f32_32x32x16_bf16(pa2,PK(2),o[d0],0,0,0);
    o[d0]=__builtin_amdgcn_mfma_f32_32x32x16_bf16(pa3,PK(3),o[d0],0,0,0);
    #undef PK
  }
}

#ifndef ATTN_STORE16
#define ATTN_STORE16(p,v) (*(u32x4*)(p)=(v))
#endif
template<int THRL> __device__ __forceinline__ void attn_unit(int b,int h,int qb,const bf16*Q,const bf16*__restrict__ K,const bf16*__restrict__ V,bf16*O,const bf16*__restrict__ ZB,const float*__restrict__ KMEAN,char*shm,const int wave_id){
  const int wid=__builtin_amdgcn_readfirstlane(wave_id); const int lane=mk_lane_id(),tid=wid*64+lane,r32=lane&31,hi=lane>>5; (void)tid;
  const long rowbase=(long)b*SEQ; const int q0=qb*QB;
  const bf16*Qw=Q+(rowbase+q0+wid*QBLK)*DM+h*D;
  const bf16*Kh=K+rowbase*DM+h*D,*Vh=V+rowbase*DM+h*D;
  const unsigned lds0=(unsigned)(uintptr_t)shm;
  float*wsf=(float*)(shm+LDS_WS)+wid*64;
  const bf16*ksrc=Kh+(long)lane*DM+wid*8;
  const bf16*vsrc=Vh+(long)(16*(wid&3)+(lane>>2))*DM+(wid>>2)*32+(lane&3)*8;
  const unsigned kdst=lds0+LDS_K+wid*1024, vdst=lds0+LDS_V+wid*1024;
  #define TROW(t) (((t)<4)?(q0+64*(t)):(64*((t)-4)))
  #define DMA_K(t,slot) glds16(ksrc+(long)TROW(t)*DM,(unsigned)__builtin_amdgcn_readfirstlane(kdst+(slot)))
  #define DMA_V(t,slot) glds16(vsrc+(long)TROW(t)*DM,(unsigned)__builtin_amdgcn_readfirstlane(vdst+(slot)))
  const int vb0=(int)(lds0+LDS_V)+((lane>>4)&1)*32+(lane&3)*8+(4*hi+((lane&15)>>2))*64;
  const char*Kbase=shm+LDS_K; bf16x8 kf[8];
  const lds_cptr shm3=(lds_cptr)shm; const lds_cptr kp0=shm3+LDS_K+hi*1024+r32*16; const lds_cptr vp0=shm3+LDS_V+((lane>>4)&1)*32+(lane&3)*8+(4*hi+((lane&15)>>2))*64;
  const int NT=(q0+QB)/KVBLK;
  DMA_K(0,0);DMA_V(0,0);DMA_K(1,SLOTB);
  bf16x8 qr[4];
  #pragma unroll
  for(int d0=0;d0<4;++d0)qr[d0]=*reinterpret_cast<const bf16x8*>(&Qw[(long)r32*DM+d0*16+hi*8]);
  float mhat=0.f,l_reg=0.f;f32x16 o[2];o[0]=f32x16{};o[1]=f32x16{};f32x16 negm=f32x16{};asm volatile("":"+v"(negm));
  const int qrel=wid*QBLK+r32;
  unsigned selm=(1u<<qb)-1u;
  if(qb>3){ float g[7];
    #pragma unroll
    for(int n=0;n<7;++n){ g[n]=-INFINITY; if(n<qb){ const float*km=KMEAN+(((long)b*NHEAD+h)*8+n)*64+hi*8; float acc_=0.f;
        #pragma unroll
        for(int d0=0;d0<4;++d0){ const float4 k0=*reinterpret_cast<const float4*>(km+d0*16), k1=*reinterpret_cast<const float4*>(km+d0*16+4); const bf16x8 qv_=qr[d0];
          acc_+=bfs(qv_[0])*k0.x+bfs(qv_[1])*k0.y+bfs(qv_[2])*k0.z+bfs(qv_[3])*k0.w+bfs(qv_[4])*k1.x+bfs(qv_[5])*k1.y+bfs(qv_[6])*k1.z+bfs(qv_[7])*k1.w; }
        auto rr=__builtin_amdgcn_permlane32_swap(__float_as_uint(acc_),__float_as_uint(acc_),false,false); g[n]=__uint_as_float(rr[0])+__uint_as_float(rr[1]); } }
    selm=0u;
    #pragma unroll
    for(int n=0;n<7;++n){ int rank=0;
      #pragma unroll
      for(int m_=0;m_<7;++m_) if(m_!=n) rank+=(g[m_]>g[n]||(g[m_]==g[n]&&m_<n))?1:0;
      if(n<qb&&rank<3) selm|=1u<<n; } }
  #define CMASK(P0,P1,t) do{int jb_=(t); if(jb_<4)cmask(P0,P1,jb_,qrel,hi);}while(0)
  bool resc=false;
  #define START(P0,P1) do{ const float rm=rowmax(P0,P1); resc=false; \
    { const float dl=rm; mhat=fadd_s(mhat,dl); \
      _Pragma("unroll") for(int r=0;r<16;++r){P0[r]=fsub_s(P0[r],dl);P1[r]=fsub_s(P1[r],dl);} \
      _Pragma("unroll") for(int r=0;r<16;++r)negm[r]=-mhat; asm volatile("":"+v"(negm)); } \
    _Pragma("unroll") for(int r=0;r<16;++r)P0[r]=__builtin_amdgcn_exp2f(P0[r]); }while(0)
  #define RESC() do{ if(resc){ asm volatile("s_waitcnt lgkmcnt(0)":::"memory"); \
      _Pragma("unroll") for(int d_=0;d_<2;++d_) _Pragma("unroll") for(int r=0;r<16;++r)o[d_][r]*=wsf[crow(r,hi)]; } }while(0)
  f32x16 pA0,pA1,pB0,pB1;
  int sl_prev=0,sl_cur=0,sl_next=SLOTB;
  #define ROT() do{sl_prev=sl_cur;sl_cur=sl_next;sl_next=(sl_next==(NSLOT-1)*SLOTB)?0:sl_next+SLOTB;}while(0)
  DMA_K(2,2*SLOTB);
  WAIT_BAR(3);
  qkt(pA0,pA1,Kbase,qr,negm,r32,hi);asm volatile("s_nop 15\n\ts_nop 7":"+v"(pA0),"+v"(pA1));CMASK(pA0,pA1,0);
  START(pA0,pA1);
  _Pragma("unroll") for(int r=0;r<16;++r)pA1[r]=__builtin_amdgcn_exp2f(pA1[r]);
  WAIT_BAR(0);
  DMA_K(3,0);DMA_V(1,SLOTB);
  ROT();
  kload8(kf,kp0+sl_cur);
  WAIT_BAR(2);
  s16x4 vlo[8],vhi[8]; u32x4 pw0,pw1,pw2,pw3;
  #define PKW(P,B) cvtpk_s(P[B],P[B+1])
  #define PAF(k) __builtin_bit_cast(bf16x8,pw##k)
  #define VFR(i) (bf16x8){vlo[i][0],vlo[i][1],vlo[i][2],vlo[i][3],vhi[i][0],vhi[i][1],vhi[i][2],vhi[i][3]}
  #define PIN(x) asm volatile("":"+v"(x))
  #define MX3(a,b,c) __builtin_fmaxf(__builtin_fmaxf((a),(b)),(c))
  #define GAPA(MF,A0,A1,A2,A3,W0,W1,PW) do{ MF; sacc+=A0; sacc+=A1; sacc+=A2; sacc+=A3; PIN(sacc); W0; W1; PIN(PW); SBAR(); }while(0)
  #define EX(v) __builtin_amdgcn_exp2f(v)
  #define GAPB(MF,X,B) do{ MF; X[B]=EX(X[B]); X[B+1]=EX(X[B+1]); X[B+2]=EX(X[B+2]); X[B+3]=EX(X[B+3]); PIN(X); SBAR(); }while(0)
  #define VRD(i) do{ vlo[i]=vtr(vp_+(((i)>>2)*4096+((i)&3)*1024)); vhi[i]=vtr(vp_+(((i)>>2)*4096+((i)&3)*1024+512)); }while(0)
  #define KRD(G,j) do{ if(G){ kload2(kf,kp0+sl_next,j); SBAR(); } }while(0)
  #define STEP(C0,C1,P0,P1,t,GK,GV,GL) do{ SBAR(); \
    { const float ci_=(((t)<4)||((selm>>(((t)-4)>>2))&1u))?-mhat:-INFINITY; _Pragma("unroll") for(int r=0;r<16;++r)negm[r]=ci_; asm volatile("":"+v"(negm)); } SBAR(); \
    const lds_cptr vp_=vp0+sl_prev; \
    VRD(0); SBAR(); float sacc=(P0[0]+P0[1]); \
    GAPA(C0=__builtin_amdgcn_mfma_f32_32x32x16_bf16(kf[0],qr[0],negm,0,0,0), P0[2],P0[3],P0[4],P0[5],     pw0[0]=PKW(P0,0), pw0[1]=PKW(P0,2), pw0); \
    VRD(4); SBAR(); GAPA(C1=__builtin_amdgcn_mfma_f32_32x32x16_bf16(kf[1],qr[0],negm,0,0,0), P0[6],P0[7],P0[8],P0[9],     pw0[2]=PKW(P0,4), pw0[3]=PKW(P0,6), pw0); \
    VRD(1); SBAR(); GAPA(C0=__builtin_amdgcn_mfma_f32_32x32x16_bf16(kf[2],qr[1],C0,0,0,0),   P0[10],P0[11],P0[12],P0[13], pw1[0]=PKW(P0,8), pw1[1]=PKW(P0,10), pw1); \
    VRD(5); SBAR(); GAPA(C1=__builtin_amdgcn_mfma_f32_32x32x16_bf16(kf[3],qr[1],C1,0,0,0),   P0[14],P0[15],P1[0],P1[1],   pw1[2]=PKW(P0,12),pw1[3]=PKW(P0,14), pw1); \
    VRD(2); SBAR(); GAPA(C0=__builtin_amdgcn_mfma_f32_32x32x16_bf16(kf[4],qr[2],C0,0,0,0),   P1[2],P1[3],P1[4],P1[5],     pw2[0]=PKW(P1,0), pw2[1]=PKW(P1,2), pw2); \
    VRD(6); SBAR(); GAPA(C1=__builtin_amdgcn_mfma_f32_32x32x16_bf16(kf[5],qr[2],C1,0,0,0),   P1[6],P1[7],P1[8],P1[9],     pw2[2]=PKW(P1,4), pw2[3]=PKW(P1,6), pw2); \
    VRD(3); SBAR(); GAPA(C0=__builtin_amdgcn_mfma_f32_32x32x16_bf16(kf[6],qr[3],C0,0,0,0),   P1[10],P1[11],P1[12],P1[13], pw3[0]=PKW(P1,8), pw3[1]=PKW(P1,10), pw3); \
    VRD(7); SBAR(); GAPA(C1=__builtin_amdgcn_mfma_f32_32x32x16_bf16(kf[7],qr[3],C1,0,0,0),   P1[14],P1[15],0.f,0.f,       pw3[2]=PKW(P1,12),pw3[3]=PKW(P1,14), pw3); \
    l_reg+=sacc; \
    if(GK){DMA_K((t)+3,sl_cur);} if(GV){DMA_V((t)+1,sl_next);} \
    CMASK(C0,C1,t); \
    { float a=MX3(C0[0],C0[1],C1[0]),b=MX3(C0[2],C0[3],C1[1]); a=MX3(a,C1[2],C1[3]); \
      _Pragma("unroll") for(int r=4;r<16;r+=4){a=MX3(a,C0[r],C0[r+1]);b=MX3(b,C0[r+2],C0[r+3]);a=MX3(a,C1[r],C1[r+1]);b=MX3(b,C1[r+2],C1[r+3]);} \
      float rm=__builtin_fmaxf(a,b); { auto rr=__builtin_amdgcn_permlane32_swap(__float_as_uint(rm),__float_as_uint(rm),false,false); rm=__builtin_fmaxf(__uint_as_float(rr[0]),__uint_as_float(rr[1])); } \
      resc=false; \
      if(__builtin_expect(__any(rm>(float)THRL),0)){ const float dl=__builtin_fmaxf(rm,0.f); mhat+=dl; \
        _Pragma("unroll") for(int r=0;r<16;++r){C0[r]-=dl;C1[r]-=dl;} \
        _Pragma("unroll") for(int r=0;r<16;++r)negm[r]=-mhat; asm volatile("":"+v"(negm)); \
        const float f=__builtin_amdgcn_exp2f(-dl); l_reg*=f; if(hi==0)wsf[r32]=f; resc=true; } } \
    SBAR(); \
    GAPB(o[0]=__builtin_amdgcn_mfma_f32_32x32x16_bf16(PAF(0),VFR(0),o[0],0,0,0), C0,0); \
    GAPB(o[1]=__builtin_amdgcn_mfma_f32_32x32x16_bf16(PAF(0),VFR(4),o[1],0,0,0), C0,4); \
    KRD(GL,0); GAPB(o[0]=__builtin_amdgcn_mfma_f32_32x32x16_bf16(PAF(1),VFR(1),o[0],0,0,0), C0,8); \
    KRD(GL,1); GAPB(o[1]=__builtin_amdgcn_mfma_f32_32x32x16_bf16(PAF(1),VFR(5),o[1],0,0,0), C0,12); \
    KRD(GL,2); GAPB(o[0]=__builtin_amdgcn_mfma_f32_32x32x16_bf16(PAF(2),VFR(2),o[0],0,0,0), C1,0); \
    KRD(GL,3); GAPB(o[1]=__builtin_amdgcn_mfma_f32_32x32x16_bf16(PAF(2),VFR(6),o[1],0,0,0), C1,4); \
    GAPB(o[0]=__builtin_amdgcn_mfma_f32_32x32x16_bf16(PAF(3),VFR(3),o[0],0,0,0), C1,8); \
    GAPB(o[1]=__builtin_amdgcn_mfma_f32_32x32x16_bf16(PAF(3),VFR(7),o[1],0,0,0), C1,12); \
    }while(0)
  int t=1;
  #define ENDW(tt) do{ if((tt)+3<NT){WAIT_BAR(2);} else if((tt)+2<NT){WAIT_BAR(1);} else {WAIT_BAR(0);} }while(0)
  for(;t+1<NT;t+=2){
    STEP(pB0,pB1,pA0,pA1,t,(t+3<NT),(t+1<NT),(t+1<NT));       ENDW(t);   RESC(); ROT();
    STEP(pA0,pA1,pB0,pB1,t+1,(t+4<NT),(t+2<NT),(t+2<NT));     ENDW(t+1); RESC(); ROT();
  }
  STEP(pB0,pB1,pA0,pA1,NT-1,false,false,false); RESC();
  { float sacc=pB0[0]+pB0[1]; _Pragma("unroll") for(int r=2;r<16;++r)sacc+=pB0[r]; _Pragma("unroll") for(int r=0;r<16;++r)sacc+=pB1[r]; l_reg+=sacc;
    pw0=(u32x4){PKW(pB0,0),PKW(pB0,2),PKW(pB0,4),PKW(pB0,6)};pw1=(u32x4){PKW(pB0,8),PKW(pB0,10),PKW(pB0,12),PKW(pB0,14)};pw2=(u32x4){PKW(pB1,0),PKW(pB1,2),PKW(pB1,4),PKW(pB1,6)};pw3=(u32x4){PKW(pB1,8),PKW(pB1,10),PKW(pB1,12),PKW(pB1,14)};
    SBAR(); pv(o,vb0+sl_cur,PAF(0),PAF(1),PAF(2),PAF(3)); }
  #undef PKW
  #undef PAF
  #undef VFR
  #undef PIN
  #undef MX3
  #undef GAPA
  #undef GAPB
  #undef EX
  #undef VRD
  #undef KRD
  #undef STEP
  #undef ENDW
  {auto rr=__builtin_amdgcn_permlane32_swap(__float_as_uint(l_reg),__float_as_uint(l_reg),false,false);l_reg=__uint_as_float(rr[0])+__uint_as_float(rr[1]);}
  if(hi==0)wsf[32+r32]=l_reg;asm volatile("s_waitcnt lgkmcnt(0)":::"memory");
  float rli[16];
  #pragma unroll
  for(int r=0;r<16;++r)rli[r]=__builtin_amdgcn_rcpf(wsf[32+crow(r,hi)]);
  bf16*Ow=O+(rowbase+q0+wid*QBLK)*OPITCH+h*D; const bf16*Zw=ZB+(rowbase+q0+wid*QBLK)*ZPITCH+h*D;
  { bf16*stg=(bf16*)(shm+LDS_OST)+wid*2048;
    #pragma unroll
    for(int r=0;r<16;++r){const int orow=crow(r,hi);
      #pragma unroll
      for(int d0=0;d0<2;++d0)stg[orow*64+d0*32+r32]=__float2bfloat16(o[d0][r]*rli[r]);}
    asm volatile("s_waitcnt lgkmcnt(0)":::"memory");
    #pragma unroll
    for(int i=0;i<4;++i){const int row=i*8+(lane>>3),ch=lane&7; const u32x4 v=*(const u32x4*)(stg+row*64+ch*8); const u32x4 z=*(const u32x4*)(Zw+(long)row*ZPITCH+ch*8); u32x4 w;
      w.x=cvtpk_s(bflo(v.x)*bflo(z.x),bfhi(v.x)*bfhi(z.x)); w.y=cvtpk_s(bflo(v.y)*bflo(z.y),bfhi(v.y)*bfhi(z.y)); w.z=cvtpk_s(bflo(v.z)*bflo(z.z),bfhi(v.z)*bfhi(z.z)); w.w=cvtpk_s(bflo(v.w)*bflo(z.w),bfhi(v.w)*bfhi(z.w));
      ATTN_STORE16(Ow+(long)row*OPITCH+ch*8,w);} }
  asm volatile("s_waitcnt lgkmcnt(0)\n\ts_barrier":::"memory");
  #undef DMA_K
  #undef DMA_V
  #undef CMASK
  #undef START
  #undef RESC
  #undef ROT
}
constexpr int ATTN_LDS_BYTES=LDS_BYTES;
struct AttnTensors { const bf16* Q; const bf16* K; const bf16* V; bf16* O; const bf16* ZB; const float* KMEAN; };
struct AttnUnit { int bh; int qb; };
struct StaticOrder {
  int vcu, G;
  __device__ __forceinline__ explicit StaticOrder(int grid,int block):vcu((grid%8==0)?(block%8)*(grid/8)+block/8:block),G(grid){}
  __device__ __forceinline__ StaticOrder(int ncu,int v,int):vcu(v),G(ncu){}
  __device__ __forceinline__ bool next(int i,AttnUnit&u)const{ const int pi=(i>>1)*G+vcu; if(pi>=BATCH*NHEAD*4)return false; u.bh=pi>>2; const int p=pi&3; u.qb=(i&1)?p:7-p; return true; }
  __device__ __forceinline__ void a_ready(const AttnUnit&)const{}
  __device__ __forceinline__ void done(const AttnUnit&)const{}
};
struct MobaOrder {
  int c,G; bool shift16; int give;
  __device__ __forceinline__ bool own(int ii,int cc,AttnUnit&u)const{ const int r=ii>>1,q=r*G+cc; if(q>=BATCH*NHEAD*4)return false; const int p=(G&3)?(q&3):(((q&3)+r)&3); u.bh=q>>2; u.qb=(ii&1)?p:7-p; return true; }
  __device__ __forceinline__ int slot_of(int cc,int qb)const{ const int p=qb<4?qb:7-qb; return 2*((p-(cc&3))&3)+(qb<4?1:0); }
  __device__ __forceinline__ bool next(int i,AttnUnit&u)const{
    if(!shift16&&give<=0) return own(i,c,u);
    const bool lite=shift16&&(c&31)<16; const int s2=lite?slot_of(c,2):-1;
    int k=i; for(int ii=0;ii<8;++ii){ AttnUnit t; own(ii,c,t); if(ii==s2||((give>>t.qb)&1))continue; if(k==0){u=t;return t.bh<BATCH*NHEAD;} --k; }
    if(shift16&&!lite&&k==0) return own(slot_of(c-16,2),c-16,u);
    return false; }
  __device__ __forceinline__ void a_ready(const AttnUnit&)const{}
  __device__ __forceinline__ void done(const AttnUnit&)const{}
};
template<class Sched,int THRL=8> __device__ __forceinline__ void attn_phase(char*lds,const AttnTensors&T,const Sched&S,const int wave_id){
  AttnUnit u;
  for(int i=0;S.next(i,u);++i){ S.a_ready(u); attn_unit<THRL>(u.bh/NHEAD,u.bh%NHEAD,u.qb,T.Q,T.K,T.V,T.O,T.ZB,T.KMEAN,lds,wave_id); S.done(u); }
}
#undef SBAR
#undef WAIT_BAR
}
constexpr int NWAVES = 8;
#ifndef MK_TS
#define MK_TS 0
#endif
#ifndef MK_ALIGN34
#define MK_ALIGN34 true
#endif
constexpr int CW_TS = 12288;
#ifndef MK_N_LAUNCHES
#define MK_N_LAUNCHES 0
#endif
constexpr int BATCH = 8, SEQ = 2048, DM = 2048, T = BATCH * SEQ, NH = 16, HD = 64, WID = 1024;
constexpr int NIN = 12544;
constexpr float RMS_EPS = 1e-6f, GN_EPS = 64e-5f, QSCALE = 0.125f * 1.4426950408889634f;
constexpr size_t MiB = 1u << 20;
constexpr size_t WS_CTL = 0, CTL_ZERO_BYTES = 64 * 1024;
constexpr size_t WS_KMEAN = 1 * MiB;
constexpr size_t WS_WINT = 2 * MiB;
constexpr size_t WS_WMT = 52 * MiB, WS_WOT = 60 * MiB;
constexpr size_t WS_XN = 68 * MiB;
constexpr size_t WS_MERGED = 68 * MiB;
constexpr size_t WS_RKV = 132 * MiB;
constexpr size_t WS_Y = 392 * MiB;
constexpr size_t WS_ZA = 228 * MiB, WS_QKVB = 260 * MiB, WS_ZB = 356 * MiB, WS_LORA = 388 * MiB;
constexpr size_t WS_END = 456 * MiB;
constexpr int CW_BAR = 4096, CW_SUB = 14336;
constexpr int RING_BYTES = 131072, LDSCTL_OFF = 143360, MISC_OFF = LDSCTL_OFF + 320, LDS_BYTES = 147456;

__device__ __forceinline__ float bf2f(bf16 v) { return __builtin_bit_cast(float, (unsigned)v << 16); }
__device__ __forceinline__ float blo(unsigned w) { return __builtin_bit_cast(float, w << 16); }
__device__ __forceinline__ float bhi(unsigned w) { return __builtin_bit_cast(float, w & 0xffff0000u); }
__device__ __forceinline__ void unpack8(const v4u w, float* f) { f[0] = blo(w.x); f[1] = bhi(w.x); f[2] = blo(w.y); f[3] = bhi(w.y); f[4] = blo(w.z); f[5] = bhi(w.z); f[6] = blo(w.w); f[7] = bhi(w.w); }
__device__ __forceinline__ v4u pack8(const float* f) { v4u w; w.x = pk2(f[0], f[1]); w.y = pk2(f[2], f[3]); w.z = pk2(f[4], f[5]); w.w = pk2(f[6], f[7]); return w; }
__device__ __forceinline__ float wave_sum(float v) {
#pragma unroll
    for (int o = 1; o < 64; o <<= 1) v += __shfl_xor(v, o);
    return v;
}
__device__ __forceinline__ float wave_max(float v) {
#pragma unroll
    for (int o = 1; o < 64; o <<= 1) v = fmaxf(v, __shfl_xor(v, o));
    return v;
}
__device__ __forceinline__ float dpp_f(float x, int ctrl_unused) { return x; }
#define DPP_ADD(x, CTRL) ((x) + __builtin_bit_cast(float, __builtin_amdgcn_update_dpp(0, __builtin_bit_cast(int, (x)), (CTRL), 0xF, 0xF, true)))
__device__ __forceinline__ float red8(float x) {
    x = DPP_ADD(x, 0xB1);
    x = DPP_ADD(x, 0x4E);
    x = DPP_ADD(x, 0x141);
    return x;
}

struct Frame {
    LAS unsigned char* lds; volatile LAS unsigned* MISC; gu32* ctl;
    int tid, lane, wave, vcu, G;
    const float* in[22]; float* out; unsigned char* ws;
};
#define IN_X 0
#define IN_NORMW 1
#define IN_WIN 2
#define IN_MUR 3
#define IN_MUK 4
#define IN_MUV 5
#define IN_MUW 6
#define IN_MUA 7
#define IN_W0 8
#define IN_WDUP 9
#define IN_A0 10
#define IN_WAUP 11
#define IN_KK 12
#define IN_KA 13
#define IN_RK 14
#define IN_GNW 15
#define IN_GNB 16
#define IN_QNW 17
#define IN_KNW 18
#define IN_WPR 19
#define IN_WPM 20
#define IN_WOUT 21

__device__ __forceinline__ void transpose_item(const float* W, int ldw, int k0, int srcn0, bf16* WT, int K, int dstn0, LAS float* scr, int lane) {
    if (srcn0 >= 0) {
        float t[32]; const float* wp = W + (size_t)(k0 + (lane >> 5)) * ldw + srcn0 + (lane & 31);
#pragma unroll
        for (int i = 0; i < 32; ++i) t[i] = wp[(size_t)(2 * i) * ldw];
#pragma unroll
        for (int i = 0; i < 32; ++i) scr[(2 * i + (lane >> 5)) * 33 + (lane & 31)] = t[i];
    } else {
#pragma unroll 8
        for (int i = 0; i < 32; ++i) { const int kk = 2 * i + (lane >> 5); scr[kk * 33 + (lane & 31)] = 0.f; }
    }
    LDS_WAIT(); asm volatile("" ::: "memory");
    const int c = lane & 7;
#pragma unroll
    for (int j = 0; j < 4; ++j) { const int n = (lane >> 3) + 8 * j; const LAS float* s = scr + (8 * c) * 33 + n;
        v4u o; o.x = pk2(s[0 * 33], s[1 * 33]); o.y = pk2(s[2 * 33], s[3 * 33]); o.z = pk2(s[4 * 33], s[5 * 33]); o.w = pk2(s[6 * 33], s[7 * 33]);
        *(GAS v4u*)(WT + (size_t)(dstn0 + n) * K + k0 + 8 * c) = o; }
    LDS_WAIT(); asm volatile("" ::: "memory");
}
__device__ __forceinline__ int win_src_col(int d) { if (d >= 4096 && d < 6144) { const int i = d & 255; return 4224 + ((d - 4096) & ~255) + 64 * ((i >> 5) & 3) + 32 * (i >> 7) + (i & 31); }
    if (d >= 8192 && d < 12288) { const int j = (d - 8192) >> 8, o = d & 255; return 8320 + (o >> 7) * 2048 + 128 * j + (o & 127); }
    return d < 4096 ? d : d < 8192 ? 4224 + (d - 4096) : d < 12416 ? 4096 + (d - 12288) : -1; }
__device__ __forceinline__ void rms_row_to_bf16(Frame& F, const float* xrow, const float* g, bf16* orow) {
    const GAS f32x4* xr = (const GAS f32x4*)xrow + F.lane; const GAS f32x4* gr = (const GAS f32x4*)g + F.lane;
    f32x4 v[8]; float s = 0.f;
#pragma unroll
    for (int j = 0; j < 8; ++j) { v[j] = xr[64 * j]; s += (v[j].x * v[j].x + v[j].y * v[j].y) + (v[j].z * v[j].z + v[j].w * v[j].w); }
    const float rstd = 1.f / sqrtf(wave_sum(s) * (1.f / DM) + RMS_EPS);
    GAS unsigned long long* o8 = (GAS unsigned long long*)orow + F.lane;
#pragma unroll
    for (int j = 0; j < 8; ++j) { const f32x4 gg = gr[64 * j]; o8[64 * j] = (unsigned long long)pk2(v[j].x * rstd * gg.x, v[j].y * rstd * gg.y) | ((unsigned long long)pk2(v[j].z * rstd * gg.z, v[j].w * rstd * gg.w) << 32); }
}
__device__ __forceinline__ void p0_prologue(Frame& F) {
    LAS float* scr = (LAS float*)(F.lds + F.wave * 16384);
    const int gw = F.vcu * NWAVES + F.wave, NGW = F.G * NWAVES;
    bf16* WINT = (bf16*)(F.ws + WS_WINT);
    constexpr int I_IN = (DM / 64) * (NIN / 32);
    for (int it = gw; it < I_IN; it += NGW) { const int nblk = NIN / 32, kb = it / nblk, nb = it % nblk; transpose_item(F.in[IN_WIN], 12416, 64 * kb, win_src_col(32 * nb), WINT, DM, 32 * nb, scr, F.lane); }
    { GAS f32x4* km = (GAS f32x4*)(F.ws + WS_KMEAN); for (int e = gw * 64 + F.lane; e < BATCH * NH * 8 * 64 / 4; e += NGW * 64) km[e] = (f32x4){0.f, 0.f, 0.f, 0.f}; }
    bf16* XN = (bf16*)(F.ws + WS_XN);
    for (int m = gw; m < T; m += NGW) rms_row_to_bf16(F, F.in[IN_X] + (size_t)m * DM, F.in[IN_NORMW], XN + (size_t)m * DM);
}


__device__ __forceinline__ void p0_weights_late(Frame& F, int gw, int ngw, int lo = 0, int hi = 1 << 30) {
    LAS float* scr = (LAS float*)(F.lds + F.wave * 16384);
    bf16* WMT = (bf16*)(F.ws + WS_WMT); bf16* WOT = (bf16*)(F.ws + WS_WOT);
    constexpr int I_A = (WID / 64) * (DM / 32), I_O = (DM / 64) * (DM / 32), NITEMS = 2 * I_A + I_O;
    for (int it = lo + gw; it < (hi < NITEMS ? hi : NITEMS); it += ngw) {
        int r = it; const int nblk = DM / 32;
        if (r < I_A) { const int kb = r / nblk, nb = r % nblk; transpose_item(F.in[IN_WPM], DM, 64 * kb, 32 * nb, WMT, DM, 32 * nb, scr, F.lane); continue; } r -= I_A;
        if (r < I_A) { const int kb = r / nblk, nb = r % nblk; transpose_item(F.in[IN_WPR], DM, 64 * kb, 32 * nb, WMT + WID, DM, 32 * nb, scr, F.lane); continue; } r -= I_A;
        { const int kb = r / nblk, nb = r % nblk; transpose_item(F.in[IN_WOUT], DM, 64 * kb, 32 * nb, WOT, DM, 32 * nb, scr, F.lane); }
    }
}
#ifndef MK_NLATE
#define MK_NLATE 9
#endif
constexpr int NLATE = MK_NLATE, NMAIN = 49 - NLATE;
struct InOrderMain { pg8::StaticOrder S;
    __device__ __forceinline__ bool next(int i, pg8::Unit& u) const { if (!S.next(i, u)) return false; if (u.pn == NMAIN - 1) u.pn = 48; return true; }
    __device__ __forceinline__ void a_ready(const pg8::Unit&) const {}
    __device__ __forceinline__ void done(const pg8::Unit&) const {} };
struct InOrderLate { int c, G;
    __device__ __forceinline__ bool next(int i, pg8::Unit& u) const { const int ng = G >> 5, g = c >> 5, w = c & 31, per = (64 / ng) * NLATE, j = i * 32 + w; if (j >= per) return false;
        u.pm = g * (64 / ng) + j / NLATE; u.pn = 48 - NLATE + j % NLATE; return true; }
    __device__ __forceinline__ void a_ready(const pg8::Unit&) const {}
    __device__ __forceinline__ void done(const pg8::Unit&) const {} };
namespace ck {
constexpr int C = 32, NCH = SEQ / C, LT = 72, LX = 40;
typedef float f32x2 __attribute__((ext_vector_type(2)));
typedef float f32x16 __attribute__((ext_vector_type(16)));
typedef __bf16 bf16x2_t __attribute__((ext_vector_type(2)));
typedef unsigned u32x2 __attribute__((ext_vector_type(2)));
__device__ __forceinline__ unsigned cvt2(float lo, float hi) { f32x2 v = {lo, hi}; bf16x2_t b = __builtin_convertvector(v, bf16x2_t); return __builtin_bit_cast(unsigned, b); }
__device__ __forceinline__ float fsig(float x) { return __builtin_amdgcn_rcpf(1.0f + __builtin_amdgcn_exp2f(-1.4426950408889634f * x)); }
__device__ __forceinline__ float ftanh(float x) { return 1.0f - 2.0f * __builtin_amdgcn_rcpf(1.0f + __builtin_amdgcn_exp2f(2.8853900817779268f * x)); }
__device__ __forceinline__ float fexp(float x) { return __builtin_amdgcn_exp2f(1.4426950408889634f * x); }
__device__ __forceinline__ int crow(int r, int hi) { return (r & 3) + 8 * (r >> 2) + 4 * hi; }
__device__ __forceinline__ float red16(float x) { x = red8(x); x = DPP_ADD(x, 0x128); return x; }
__device__ __forceinline__ int opq(int x) { asm volatile("" : "+v"(x)); return x; }
#define CK_BAR() asm volatile("s_waitcnt lgkmcnt(0)\n\ts_barrier" ::: "memory")
#if MK_TS
#define CK_BARK(k) do { const unsigned t0_ = (unsigned)__builtin_amdgcn_s_memrealtime(); CK_BAR(); const unsigned t1_ = (unsigned)__builtin_amdgcn_s_memrealtime(); wsum[k] += t1_ - tprev; wwait[k] += t1_ - t0_; tprev = t1_; } while (0)
#else
#define CK_BARK(k) CK_BAR()
#endif
typedef short v4i16_t __attribute__((ext_vector_type(4)));
template <bool TR> __device__ __forceinline__ pg8::bf16x8 ck_frag(const LAS bf16* X, int ld, int k0, int lane) {
    if (!TR) return *(const LAS pg8::bf16x8*)(X + (lane & 31) * ld + k0 + 8 * (lane >> 5));
    const LAS bf16* p = X + (k0 + 8 * (lane >> 5) + ((lane & 15) >> 2)) * ld + 16 * ((lane >> 4) & 1) + 4 * (lane & 3);
    const v4i16_t lo = __builtin_amdgcn_ds_read_tr16_b64_v4i16((LAS v4i16_t*)p), hi4 = __builtin_amdgcn_ds_read_tr16_b64_v4i16((LAS v4i16_t*)(p + 4 * ld));
    return (pg8::bf16x8){lo[0], lo[1], lo[2], lo[3], hi4[0], hi4[1], hi4[2], hi4[3]};
}
template <int K, bool TA, bool TB> __device__ __forceinline__ f32x16 mm_tile(const LAS bf16* A, int lda, const LAS bf16* B, int ldb, f32x16 acc, int lane) {
#pragma unroll
    for (int k0 = 0; k0 < K; k0 += 16) acc = __builtin_amdgcn_mfma_f32_32x32x16_bf16(ck_frag<TA>(A, lda, k0, lane), ck_frag<TB>(B, ldb, k0, lane), acc, 0, 0, 0);
    return acc;
}
constexpr int SZ_TOK = C * LT * 2, SZ_GRM = C * 36 * 4 + 3 * C * LX * 2 + 64 * 4;
constexpr int O_TOK = 0;
constexpr int O_GRM = O_TOK + 2 * 5 * SZ_TOK;
constexpr int O_TM = O_GRM + 2 * SZ_GRM, O_LVT = O_TM + C * LX * 2, O_AHT = O_LVT + 64 * LX * 2, O_W2T = O_AHT + 64 * LX * 2;
constexpr int O_RH = O_W2T + 64 * LX * 2, O_PP = O_RH + C * LT * 2, O_ZT = O_PP + 64 * LT * 2;
constexpr int O_GX = O_ZT + 64 * LT * 2, O_LA = O_GX + C * 64 * 4, O_LW = O_LA + C * 68 * 4, O_PAR = O_LW + C * 64 * 4, O_L21 = O_PAR + 12 * 64 * 4, O_XT = O_L21 + 16 * 24 * 2, O_HAND = O_XT + 16 * 24 * 2, O_END1 = O_HAND + 8 * 64;
constexpr int O_YL = O_LVT, O_WST = 0;
static_assert(O_END1 <= 143360 && C * 65 * 4 <= 2 * 64 * LX * 2, "chunk LDS map");

__device__ __forceinline__ void head(Frame& F, int bh) {
    LAS unsigned char* lds = F.lds; LAS float* Lpar = (LAS float*)(lds + O_PAR); LAS float* La = (LAS float*)(lds + O_LA); LAS float* Lws = (LAS float*)(lds + O_LW); LAS bf16* BVb = (LAS bf16*)(lds + O_GX); LAS unsigned* Lhand = (LAS unsigned*)(lds + O_HAND);
    LAS bf16* Tm = (LAS bf16*)(lds + O_TM); LAS bf16* LVt = (LAS bf16*)(lds + O_LVT); LAS bf16* AhT = (LAS bf16*)(lds + O_AHT); LAS bf16* W2t = (LAS bf16*)(lds + O_W2T); LAS bf16* Rh = (LAS bf16*)(lds + O_RH); LAS bf16* Pp = (LAS bf16*)(lds + O_PP); LAS bf16* ZT = (LAS bf16*)(lds + O_ZT);
    LAS float* Yl = (LAS float*)(lds + O_YL);
    const bf16* RKV = (const bf16*)(F.ws + WS_RKV); const bf16* LORA = (const bf16*)(F.ws + WS_LORA); const bf16* ZA = (const bf16*)(F.ws + WS_ZA); bf16* YA = (bf16*)(F.ws + WS_Y) + 1024;
    const int tid0 = F.tid, lane0 = F.lane, wave = F.wave, b = bh >> 4, h = bh & 15;
    const size_t row0 = (size_t)b * SEQ;
    const bool front = wave >= 4; const int fw = wave - 4;
    CK_BAR();
    { const int tid = tid0;
    for (int e = tid; e < 12 * 64; e += 512) { const int a = e >> 6, d = e & 63;
        const float* pp = a == 0 ? F.in[IN_MUR] : a == 1 ? F.in[IN_MUK] : a == 2 ? F.in[IN_MUV] : a == 3 ? F.in[IN_KK] : a == 4 ? F.in[IN_KA] : a == 5 ? F.in[IN_RK] : a == 6 ? F.in[IN_GNW] : a == 7 ? F.in[IN_GNB] : a == 8 ? F.in[IN_W0] : a == 9 ? F.in[IN_A0] : a == 10 ? F.in[IN_MUW] : F.in[IN_MUA];
        Lpar[e] = pp[a >= 10 ? d : h * 64 + d]; }
    { LAS float* Wst = (LAS float*)(lds + O_WST);
#pragma unroll
        for (int it = 0; it < 4; ++it) { const int e = tid + 512 * it, mtx = e >> 10, row = (e >> 4) & 63, c4 = (e & 15) * 4; const float* W = mtx ? F.in[IN_WAUP] : F.in[IN_WDUP];
            *(LAS pg8::f32x4*)(Wst + mtx * 4096 + row * 64 + c4) = *(const GAS pg8::f32x4*)(W + (size_t)row * 1024 + h * 64 + c4); } }
    for (int e = tid; e < 64 * LT / 2; e += 512) ((LAS unsigned*)ZT)[e] = 0u;
    if (tid < 256) Tm[(tid >> 4) * LX + 16 + (tid & 15)] = (bf16)0;
    if (tid < 128) Lhand[tid] = 0u; }
    CK_BAR();
    const bool la = (fw & 1) != 0, lw = !la; const int lct = (fw >> 1) & 1;
    pg8::bf16x8 wf[4];
    if (front) { const int l_ = lane0, hi_ = l_ >> 5, c_ = l_ & 31; const LAS float* Wst = (LAS float*)(lds + O_WST) + (la ? 4096 : 0) + (8 * hi_) * 64 + c_ + 32 * lct;
#pragma unroll
        for (int s = 0; s < 4; ++s) { float t[8];
#pragma unroll
            for (int j = 0; j < 8; ++j) t[j] = Wst[(16 * s + j) * 64];
            const v4u pk_ = {cvt2(t[0], t[1]), cvt2(t[2], t[3]), cvt2(t[4], t[5]), cvt2(t[6], t[7])}; wf[s] = __builtin_bit_cast(pg8::bf16x8, pk_); } }
    CK_BAR();
    v4u pLc[4], pR[6];
#define CK_PF_LORA(nn) do { const int l_ = opq(lane0), t_ = (nn) * C + (l_ & 31); const bf16* lp_ = LORA + (row0 + t_) * 128 + (la ? 64 : 0) + 8 * (l_ >> 5); \
        _Pragma("unroll") for (int s = 0; s < 4; ++s) pLc[s] = *(const GAS v4u*)(lp_ + 16 * s); } while (0)
#define CK_PF_RKV(nn) do { const int i_ = fw * 64 + opq(lane0), t_ = (nn) * C + (i_ >> 3); const bf16* rp_ = RKV + (row0 + t_) * 3072 + h * 64 + 8 * (i_ & 7); \
        pR[0] = *(const GAS v4u*)rp_; pR[1] = *(const GAS v4u*)(rp_ + 1024); pR[2] = *(const GAS v4u*)(rp_ + 2048); \
        if (t_ > 0) { pR[3] = *(const GAS v4u*)(rp_ - 3072); pR[4] = *(const GAS v4u*)(rp_ - 3072 + 1024); pR[5] = *(const GAS v4u*)(rp_ - 3072 + 2048); } else { pR[3] = (v4u){0u, 0u, 0u, 0u}; pR[4] = pR[3]; pR[5] = pR[3]; } \
        } while (0)
    if (front) CK_PF_LORA(0);
    f32x16 Z = {};
    v4u zaC = {0u, 0u, 0u, 0u};
#if MK_TS
    unsigned wsum[4] = {0u, 0u, 0u, 0u}, wwait[4] = {0u, 0u, 0u, 0u}, tprev = (unsigned)__builtin_amdgcn_s_memrealtime();
#endif
    for (int n = -1; n < NCH; ++n) {
        const int m = n + 1; const bool fm = front && m < NCH, bn = !front && n >= 0;
        const int lane = opq(lane0), r32 = lane & 31, hi = lane >> 5, idx = fw * 64 + lane, tok = idx >> 3, p = idx & 7;
        LAS bf16* tkM = (LAS bf16*)(lds + O_TOK + (m & 1) * 5 * SZ_TOK); LAS unsigned char* gmM = lds + O_GRM + (m & 1) * SZ_GRM;
        const LAS bf16* tkN = (const LAS bf16*)(lds + O_TOK + (n & 1) * 5 * SZ_TOK); const LAS unsigned char* gmN = lds + O_GRM + (n & 1) * SZ_GRM;
        const LAS bf16* tokA = tkN, *tokR = tkN + C * LT, *tokB = tkN + 2 * C * LT, *tokK = tkN + 3 * C * LT, *tokV = tkN + 4 * C * LT;
        const LAS float* Lab = (const LAS float*)gmN; const LAS bf16* Lak = (const LAS bf16*)(gmN + C * 36 * 4); const LAS bf16* Mrb = Lak + C * LX; const LAS bf16* Mrk = Mrb + C * LX; const LAS float* gC = (const LAS float*)(gmN + C * 36 * 4 + 3 * C * LX * 2);
        float r_[8], kp_[8], v_[8], al_[8], be_[8], lw_[8];
        if (fm) { LAS float* mu_ = Lpar + (la ? 11 : 10) * 64 + 8 * hi;
            f32x16 acc0_ = {};
#pragma unroll
            for (int s = 0; s < 4; ++s) { float cu_[8], pv_[8]; unpack8(pLc[s], cu_);
                {
                    v4u pp_; const v4u hd_ = *(const LAS v4u*)(Lhand + (fw * 2 + hi) * 16 + 4 * s);
                    pp_.x = (unsigned)__builtin_amdgcn_update_dpp(0, (int)pLc[s].x, 0x138, 0xF, 0xF, false); pp_.y = (unsigned)__builtin_amdgcn_update_dpp(0, (int)pLc[s].y, 0x138, 0xF, 0xF, false);
                    pp_.z = (unsigned)__builtin_amdgcn_update_dpp(0, (int)pLc[s].z, 0x138, 0xF, 0xF, false); pp_.w = (unsigned)__builtin_amdgcn_update_dpp(0, (int)pLc[s].w, 0x138, 0xF, 0xF, false);
                    if (r32 == 0) pp_ = hd_;
                    unpack8(pp_, pv_); }
#pragma unroll
                for (int j = 0; j < 8; ++j) cu_[j] = cu_[j] + (pv_[j] - cu_[j]) * mu_[16 * s + j];
                if (lw) {
#pragma unroll
                    for (int j = 0; j < 8; ++j) cu_[j] = ftanh(cu_[j]); }
                const v4u pk_ = {cvt2(cu_[0], cu_[1]), cvt2(cu_[2], cu_[3]), cvt2(cu_[4], cu_[5]), cvt2(cu_[6], cu_[7])}; const pg8::bf16x8 af_ = __builtin_bit_cast(pg8::bf16x8, pk_);
                acc0_ = __builtin_amdgcn_mfma_f32_32x32x16_bf16(af_, wf[s], acc0_, 0, 0, 0); }
            if (r32 == 31) {
#pragma unroll
                for (int s = 0; s < 4; ++s) *(LAS v4u*)(Lhand + (fw * 2 + hi) * 16 + 4 * s) = pLc[s]; }
            asm volatile("" ::: "memory"); CK_PF_RKV(m); asm volatile("" ::: "memory");
            const float b0_ = Lpar[(lw ? 8 : 9) * 64 + 32 * lct + r32];
#pragma unroll
            for (int r = 0; r < 16; ++r) acc0_[r] = fsig(acc0_[r] + b0_);
            if (lw) { LAS float* o_ = Lws + (4 * hi) * 64 + 32 * lct + r32;
#pragma unroll
                for (int r = 0; r < 16; ++r) o_[((r & 3) + 8 * (r >> 2)) * 64] = -0.60653066f * acc0_[r]; }
            else { LAS float* o_ = La + (4 * hi) * 68 + 32 * lct + r32;
#pragma unroll
                for (int r = 0; r < 16; ++r) o_[((r & 3) + 8 * (r >> 2)) * 68] = acc0_[r]; } }
        if (bn && wave == 0) {
            LAS bf16* L21b = (LAS bf16*)(lds + O_L21); LAS bf16* Xt = (LAS bf16*)(lds + O_XT);
            const int blk = (lane >> 4) & 1, i = lane & 15; const LAS float* Lb = Lab + (16 * blk) * 36 + 16 * blk; float T[16];
#pragma unroll
            for (int t = 0; t < 16; ++t) { float a0 = (t == i) ? 1.f : 0.f, a1 = 0.f, a2 = 0.f, a3 = 0.f;
#pragma unroll
                for (int j4 = 0; j4 < t; j4 += 4) { const pg8::f32x4 l4 = *(const LAS pg8::f32x4*)(Lb + t * 36 + j4);
                    a0 += l4.x * T[j4]; if (j4 + 1 < t) a1 += l4.y * T[j4 + 1]; if (j4 + 2 < t) a2 += l4.z * T[j4 + 2]; if (j4 + 3 < t) a3 += l4.w * T[j4 + 3]; }
                T[t] = (a0 + a1) + (a2 + a3); }
            if (hi == 0) {
#pragma unroll
                for (int t = 0; t < 16; ++t) Tm[(16 * blk + t) * LX + 16 * blk + i] = (bf16)f2bf(T[t]); }
            { const int r = lane >> 2, j0 = 4 * (lane & 3); const pg8::f32x4 l4 = *(const LAS pg8::f32x4*)(Lab + (16 + r) * 36 + j0); *(LAS u32x2*)(L21b + r * 24 + j0) = (u32x2){cvt2(l4.x, l4.y), cvt2(l4.z, l4.w)}; }
            asm volatile("s_waitcnt lgkmcnt(0)" ::: "memory");
            { const pg8::bf16x8 a = *(const LAS pg8::bf16x8*)(L21b + i * 24 + 8 * hi); const f32x16 x = __builtin_amdgcn_mfma_f32_32x32x16_bf16(a, ck_frag<true>(Tm, LX, 0, lane), f32x16{}, 0, 0, 0);
                if (r32 < 16) {
#pragma unroll
                    for (int q = 0; q < 2; ++q) *(LAS u32x2*)(Xt + r32 * 24 + 8 * q + 4 * hi) = (u32x2){cvt2(x[4 * q], x[4 * q + 1]), cvt2(x[4 * q + 2], x[4 * q + 3])}; } }
            asm volatile("s_waitcnt lgkmcnt(0)" ::: "memory");
            { const pg8::bf16x8 a = *(const LAS pg8::bf16x8*)(Tm + (16 + i) * LX + 16 + 8 * hi), bfr = *(const LAS pg8::bf16x8*)(Xt + i * 24 + 8 * hi);
                const f32x16 t21 = __builtin_amdgcn_mfma_f32_32x32x16_bf16(a, bfr, f32x16{}, 0, 0, 0);
                if (r32 < 16) {
#pragma unroll
                    for (int q = 0; q < 2; ++q)
#pragma unroll
                        for (int e2 = 0; e2 < 4; ++e2) Tm[(16 + 8 * q + 4 * hi + e2) * LX + r32] = (bf16)f2bf(t21[4 * q + e2]); } } }
        CK_BARK(0);
        if (bn) zaC = *(const GAS v4u*)(ZA + (row0 + n * C + ((wave * 64 + lane) >> 3)) * 1024 + h * 64 + 8 * (lane & 7));
        if (fm) {
            const int cch = 16 * fw + (lane & 15), seg = lane >> 4; LAS float* gCm = (LAS float*)(gmM + C * 36 * 4 + 3 * C * LX * 2); float g[8];
#pragma unroll
            for (int j = 0; j < 8; ++j) g[j] = Lws[(8 * seg + j) * 64 + cch];
#pragma unroll
            for (int j = 1; j < 8; ++j) g[j] += g[j - 1];
            const float S = g[7];
            const auto a_ = __builtin_amdgcn_permlane16_swap(__float_as_uint(S), __float_as_uint(S), false, false); const float other16 = (seg & 1) ? __uint_as_float(a_[0]) : __uint_as_float(a_[1]);
            const float pairT = S + other16;
            const auto b_ = __builtin_amdgcn_permlane32_swap(__float_as_uint(pairT), __float_as_uint(pairT), false, false); const float other32 = (seg & 2) ? __uint_as_float(b_[0]) : __uint_as_float(b_[1]);
            const float off = ((seg & 1) ? other16 : 0.f) + ((seg & 2) ? other32 : 0.f);
#pragma unroll
            for (int j = 0; j < 8; ++j) Lws[(8 * seg + j) * 64 + cch] = g[j] + off;
            if (seg == 3) gCm[cch] = fexp(g[7] + off); }
        if (bn) { const int nt = wave & 1; const LAS bf16* A_ = wave < 2 ? Tm : Lak; const LAS bf16* B_ = (wave < 2 ? tokA : tokV) + nt * 32; LAS bf16* O_ = (wave < 2 ? AhT : LVt) + nt * 32 * LX;
            const f32x16 d = mm_tile<32, false, true>(A_, LX, B_, LT, f32x16{}, lane);
#pragma unroll
            for (int q = 0; q < 4; ++q) *(LAS u32x2*)(O_ + r32 * LX + 8 * q + 4 * hi) = (u32x2){cvt2(d[4 * q], d[4 * q + 1]), cvt2(d[4 * q + 2], d[4 * q + 3])}; }
        CK_BARK(1);
        if (fm) { float cr[8], ck_[8], cv[8], qr[8], qk[8], qv[8]; unpack8(pR[0], cr); unpack8(pR[1], ck_); unpack8(pR[2], cv); unpack8(pR[3], qr); unpack8(pR[4], qk); unpack8(pR[5], qv);
            float kkr[8], kk_[8], ss = 0.f, bon = 0.f;
#pragma unroll
            for (int j = 0; j < 8; ++j) { const int d = 8 * p + j; r_[j] = cr[j] + (qr[j] - cr[j]) * Lpar[0 * 64 + d]; kk_[j] = ck_[j] + (qk[j] - ck_[j]) * Lpar[1 * 64 + d]; v_[j] = cv[j] + (qv[j] - cv[j]) * Lpar[2 * 64 + d];
                kkr[j] = kk_[j] * Lpar[3 * 64 + d]; ss += kkr[j] * kkr[j]; }
            ss = red8(ss); const float inv = 1.f / fmaxf(sqrtf(ss), 1e-12f);
            const int tpv = tok > 0 ? tok - 1 : 0;
#pragma unroll
            for (int j = 0; j < 8; ++j) { const int d = 8 * p + j; const float aa = La[tok * 68 + d], kn = kkr[j] * inv; kp_[j] = kk_[j] * (1.f + (aa - 1.f) * Lpar[4 * 64 + d]); al_[j] = -kn; be_[j] = kn * aa;
                bon += r_[j] * kp_[j] * Lpar[5 * 64 + d]; lw_[j] = Lws[tok * 64 + d] - (tok > 0 ? Lws[tpv * 64 + d] : 0.f); }
            bon = red8(bon);
#pragma unroll
            for (int j = 0; j < 8; ++j) kkr[j] = bon * v_[j];
            *(LAS v4u*)(BVb + (m & 1) * C * 64 + tok * 64 + 8 * p) = (v4u){cvt2(kkr[0], kkr[1]), cvt2(kkr[2], kkr[3]), cvt2(kkr[4], kkr[5]), cvt2(kkr[6], kkr[7])};
            float at[8], rt[8], bt[8], kt[8];
#pragma unroll
            for (int j = 0; j < 8; ++j) { const float gi = Lws[tok * 64 + 8 * p + j], ge = gi - lw_[j], en = fexp(-gi); at[j] = al_[j] * fexp(ge); rt[j] = r_[j] * fexp(gi); bt[j] = be_[j] * en; kt[j] = kp_[j] * en; }
            const int o = tok * LT + 8 * p;
            *(LAS v4u*)(tkM + o) = (v4u){cvt2(at[0], at[1]), cvt2(at[2], at[3]), cvt2(at[4], at[5]), cvt2(at[6], at[7])}; *(LAS v4u*)(tkM + C * LT + o) = (v4u){cvt2(rt[0], rt[1]), cvt2(rt[2], rt[3]), cvt2(rt[4], rt[5]), cvt2(rt[6], rt[7])};
            *(LAS v4u*)(tkM + 2 * C * LT + o) = (v4u){cvt2(bt[0], bt[1]), cvt2(bt[2], bt[3]), cvt2(bt[4], bt[5]), cvt2(bt[6], bt[7])}; *(LAS v4u*)(tkM + 3 * C * LT + o) = (v4u){cvt2(kt[0], kt[1]), cvt2(kt[2], kt[3]), cvt2(kt[4], kt[5]), cvt2(kt[6], kt[7])};
            *(LAS v4u*)(tkM + 4 * C * LT + o) = (v4u){cvt2(v_[0], v_[1]), cvt2(v_[2], v_[3]), cvt2(v_[4], v_[5]), cvt2(v_[6], v_[7])}; }
        if (bn) {
            if (wave < 2) { const int nt = wave; const f32x16 d = mm_tile<32, false, false>(Tm, LX, LVt + nt * 32 * LX, LX, f32x16{}, lane);
#pragma unroll
                for (int q = 0; q < 4; ++q) *(LAS u32x2*)(W2t + (nt * 32 + r32) * LX + 8 * q + 4 * hi) = (u32x2){cvt2(d[4 * q], d[4 * q + 1]), cvt2(d[4 * q + 2], d[4 * q + 3])}; }
            else { const int ct = wave - 2; const f32x16 d = mm_tile<32, false, false>(AhT + ct * 32 * LX, LX, Mrb, LX, f32x16{}, lane); const int t = r32;
#pragma unroll
                for (int q = 0; q < 4; ++q) { const int c0 = ct * 32 + 8 * q + 4 * hi; const u32x2 rr = *(const LAS u32x2*)(tokR + t * LT + c0);
                    *(LAS u32x2*)(Rh + t * LT + c0) = (u32x2){cvt2(d[4 * q] + blo(rr.x), d[4 * q + 1] + bhi(rr.x)), cvt2(d[4 * q + 2] + blo(rr.y), d[4 * q + 3] + bhi(rr.y))}; } }
            { const int ct = wave & 1, c2t = wave >> 1; const f32x16 d = mm_tile<32, false, true>(AhT + ct * 32 * LX, LX, tokB + c2t * 32, LT, f32x16{}, lane); const int c2 = c2t * 32 + r32; const float gm = gC[c2];
#pragma unroll
                for (int q = 0; q < 4; ++q) { const int c0 = ct * 32 + 8 * q + 4 * hi;
                    *(LAS u32x2*)(Pp + c2 * LT + c0) = (u32x2){cvt2(gm * d[4 * q], gm * d[4 * q + 1]), cvt2(gm * d[4 * q + 2], gm * d[4 * q + 3])}; } } }
        CK_BARK(2);
        if (fm) { const LAS bf16* A_ = (fw == 0 || fw == 2) ? tkM + 2 * C * LT : tkM + 3 * C * LT; const LAS bf16* Bt_ = (fw < 2) ? tkM : tkM + C * LT;
            const f32x16 d = mm_tile<64, false, false>(A_, LT, Bt_, LT, f32x16{}, lane); const int t = r32;
            LAS float* LabM = (LAS float*)gmM; LAS bf16* O_ = (LAS bf16*)(gmM + C * 36 * 4) + (fw - 1) * C * LX;
            const int lim = t + (fw < 2 ? 0 : 1) - 4 * hi;
            float x[16];
#pragma unroll
            for (int r = 0; r < 16; ++r) x[r] = (8 * (r >> 2) + (r & 3) < lim) ? d[r] : 0.f;
            if (fw == 0) { LAS float* o_ = LabM + t * 36 + 4 * hi;
#pragma unroll
                for (int q = 0; q < 4; ++q) *(LAS pg8::f32x4*)(o_ + 8 * q) = (pg8::f32x4){x[4 * q], x[4 * q + 1], x[4 * q + 2], x[4 * q + 3]}; }
            else { LAS bf16* o_ = O_ + t * LX + 4 * hi;
#pragma unroll
                for (int q = 0; q < 4; ++q) *(LAS u32x2*)(o_ + 8 * q) = (u32x2){cvt2(x[4 * q], x[4 * q + 1]), cvt2(x[4 * q + 2], x[4 * q + 3])}; } }
        if (front && n >= 0 && fw < 2) { const int yv = fw;
            f32x16 y = mm_tile<32, false, false>(Mrb, LX, W2t + yv * 32 * LX, LX, f32x16{}, lane); y = mm_tile<32, false, true>(Mrk, LX, tokV + yv * 32, LT, y, lane);
            const f32x16 y2 = mm_tile<64, false, false>(Rh, LT, ZT + yv * 32 * LT, LT, f32x16{}, lane);
#pragma unroll
            for (int r = 0; r < 16; ++r) Yl[crow(r, hi) * 65 + yv * 32 + r32] = y[r] + y2[r]; }
        if (bn) { const int c2t = wave & 1, vt = wave >> 1;
            f32x16 d = mm_tile<32, true, false>(tokB + c2t * 32, LT, W2t + vt * 32 * LX, LX, f32x16{}, lane); d = mm_tile<32, true, true>(tokK + c2t * 32, LT, tokV + vt * 32, LT, d, lane);
#pragma unroll
            for (int q = 0; q < 4; ++q) { const pg8::f32x4 g4 = *(const LAS pg8::f32x4*)(gC + c2t * 32 + 8 * q + 4 * hi);
                d[4 * q] = g4.x * (d[4 * q] + Z[4 * q]); d[4 * q + 1] = g4.y * (d[4 * q + 1] + Z[4 * q + 1]); d[4 * q + 2] = g4.z * (d[4 * q + 2] + Z[4 * q + 2]); d[4 * q + 3] = g4.w * (d[4 * q + 3] + Z[4 * q + 3]); }
            const f32x16 pz = mm_tile<64, false, false>(Pp + c2t * 32 * LT, LT, ZT + vt * 32 * LT, LT, f32x16{}, lane);
            Z = d + pz;
 }
        CK_BARK(3);
        if (front && m + 1 < NCH) CK_PF_LORA(m + 1);
        if (bn) { const int c2t = wave & 1, vt = wave >> 1;
#pragma unroll
            for (int q = 0; q < 4; ++q) *(LAS u32x2*)(ZT + (vt * 32 + r32) * LT + c2t * 32 + 8 * q + 4 * hi) = (u32x2){cvt2(Z[4 * q], Z[4 * q + 1]), cvt2(Z[4 * q + 2], Z[4 * q + 3])};
            const int tb = (wave * 64 + lane) >> 3, pb = lane & 7;
            const size_t row = row0 + n * C + tb; float y[8], za[8], o[8], bv[8], sm = 0.f; unpack8(zaC, za); unpack8(*(const LAS v4u*)(BVb + (n & 1) * C * 64 + tb * 64 + 8 * pb), bv);
#pragma unroll
            for (int j = 0; j < 8; ++j) { y[j] = Yl[tb * 65 + 8 * pb + j]; sm += y[j]; }
            const float mean = red8(sm) * (1.f / 64.f); float q_ = 0.f;
#pragma unroll
            for (int j = 0; j < 8; ++j) { y[j] -= mean; q_ += y[j] * y[j]; }
            const float rstd = __builtin_amdgcn_rsqf(red8(q_) * (1.f / 64.f) + GN_EPS);
#pragma unroll
            for (int j = 0; j < 8; ++j) o[j] = (y[j] * rstd * Lpar[6 * 64 + 8 * pb + j] + Lpar[7 * 64 + 8 * pb + j] + bv[j]) * za[j];
            *(GAS v4u*)(YA + row * 2048 + h * 64 + 8 * pb) = (v4u){cvt2(o[0], o[1]), cvt2(o[2], o[3]), cvt2(o[4], o[5]), cvt2(o[6], o[7])}; }
    }
#if MK_TS
    if (bh == 0 && lane0 == 0 && (wave == 0 || wave == 4)) {
#pragma unroll
        for (int k = 0; k < 4; ++k) { if (wave == 4) __hip_atomic_store((unsigned*)(F.ctl + CW_TS + 92 + k), wsum[k], __ATOMIC_RELAXED, __HIP_MEMORY_SCOPE_AGENT);
            __hip_atomic_store((unsigned*)(F.ctl + CW_TS + 80 + (wave ? 4 : 0) + k), wwait[k], __ATOMIC_RELAXED, __HIP_MEMORY_SCOPE_AGENT); } }
#endif
#undef CK_PF_RKV
#undef CK_PF_LORA
}
#undef CK_BAR
}

__device__ __forceinline__ void subset_barrier(gu32* cnt, unsigned nwg, bool t0) {
    asm volatile("s_waitcnt vmcnt(0)" ::: "memory"); __syncthreads();
    if (t0) { __builtin_amdgcn_fence(__ATOMIC_RELEASE, "agent"); asm volatile("s_waitcnt vmcnt(0)" ::: "memory");
        __hip_atomic_fetch_add((unsigned*)cnt, 1u, RLX_AGENT);
        unsigned sp = 0; while (__hip_atomic_load((unsigned*)cnt, RLX_AGENT) < nwg && ++sp < (1u << 22)) __builtin_amdgcn_s_sleep(2);
        __builtin_amdgcn_fence(__ATOMIC_ACQUIRE, "agent"); asm volatile("s_waitcnt vmcnt(0)" ::: "memory"); }
    __syncthreads();
}

#ifndef MK_CHECK
#define MK_CHECK 0
#endif
#ifndef MK_NAIVE_ATTN
#define MK_NAIVE_ATTN 0
#endif

#ifndef MK_GIVE_QB
#define MK_GIVE_QB 3
#endif
constexpr int PER_PHASE = 5;
struct Args { const float* in[22]; float* out; unsigned char* ws; int ph_lo, ph_hi, li, pad; };
__global__ void __launch_bounds__(NWAVES * 64, 2) mk_fwd(Args args) {
    extern __shared__ __attribute__((aligned(16))) unsigned char lds[];
    Frame F;
    F.lds = (LAS unsigned char*)lds; F.MISC = (volatile LAS unsigned*)(F.lds + MISC_OFF);
    F.wave = __builtin_amdgcn_readfirstlane((int)threadIdx.x >> 6); F.lane = mk_lane_id(); F.tid = F.wave * 64 + F.lane;
    F.G = gridDim.x; { const int bx = blockIdx.x; F.vcu = (F.G % 8 == 0) ? (bx % 8) * (F.G / 8) + bx / 8 : bx; }
    F.ws = args.ws; F.out = args.out; F.ctl = (gu32*)(args.ws + WS_CTL);
#pragma unroll
    for (int i = 0; i < 22; ++i) F.in[i] = args.in[i];
    for (int u = F.tid; u < (LDS_BYTES - LDSCTL_OFF) / 4; u += NWAVES * 64) ((LAS unsigned*)(F.lds + LDSCTL_OFF))[u] = 0u;
    __syncthreads();
    XcdBarrier bar; bar.bar = (unsigned*)(F.ctl + CW_BAR); bar.x = 0; bar.st = nullptr;
    if (MK_N_LAUNCHES == 1) bar = xcd_barrier_post((unsigned*)(F.ctl + CW_BAR), F.MISC + 8, F.tid == 0);
#define GRID_BAR() do { if (MK_N_LAUNCHES == 1) { FRESH(); xcd_barrier(bar, F.tid == 0); } } while (0)
    const int lo = args.ph_lo, hi = args.ph_hi;
#define TS(k) do { if (MK_TS && F.tid == 0 && (blockIdx.x == 0 || blockIdx.x == 4)) __hip_atomic_store((unsigned*)(F.ctl + CW_TS + (blockIdx.x ? 32 : 0) + (k)), (unsigned)__builtin_amdgcn_s_memrealtime(), __ATOMIC_RELAXED, __HIP_MEMORY_SCOPE_AGENT); } while (0)
    TS(0);
#if MK_TS == 90
    if (blockIdx.x == 0 && F.lane == 0) __hip_atomic_store((unsigned*)(F.ctl + CW_TS + 100 + F.wave), 1u + ((unsigned)__builtin_amdgcn_s_getreg((2 - 1) << 11 | 4 << 6 | 4) & 3u), __ATOMIC_RELAXED, __HIP_MEMORY_SCOPE_AGENT);
#endif
#ifndef MK_PHASE_MASK
#define MK_PHASE_MASK 0x1f
#endif
#define IN(k) (((MK_PHASE_MASK >> (k)) & 1) && lo <= (k) && (k) < hi)
#define FRESH() do { int l_ = mk_lane_id(); asm volatile("" : "+v"(l_)); F.lane = l_; F.tid = F.wave * 64 + l_; } while (0)
#define BOTH(k) (IN(k) && IN((k) + 1))
    bf16* WS16 = (bf16*)args.ws; (void)WS16;
    if (IN(0)) { FRESH(); p0_prologue(F); TS(1); if (BOTH(0)) GRID_BAR(); TS(2); }
    if (IN(1)) {
        pg8::Gemm g{(const pg8::bf16_t*)(args.ws + WS_XN), (const pg8::bf16_t*)(args.ws + WS_WINT), T, NIN, DM}; InOrderMain S; S.S.init(T, NMAIN * 256, F.G, (int)blockIdx.x);
        pg8::EpiIn E{(pg8::bf16_t*)(args.ws + WS_RKV), (pg8::bf16_t*)(args.ws + WS_ZA), (pg8::bf16_t*)(args.ws + WS_QKVB), (pg8::bf16_t*)(args.ws + WS_ZB), (pg8::bf16_t*)args.out, (pg8::bf16_t*)(args.ws + WS_LORA), F.in[IN_QNW], F.in[IN_KNW], (float*)(args.ws + WS_KMEAN)};
        pg8::gemm_phase<pg8::EpiIn, InOrderMain, true, true>(F.lds, g, S, E, F.wave);
        TS(3); if (BOTH(1)) GRID_BAR(); TS(4);
    }
    if (IN(2)) {
        const attn_body::bf16* QK = (const attn_body::bf16*)(args.ws + WS_QKVB);
        const attn_body::AttnTensors AT{QK, QK + 1024, QK + 2048, (attn_body::bf16*)(args.ws + WS_Y), (const attn_body::bf16*)(args.ws + WS_ZB), (const float*)(args.ws + WS_KMEAN)};
        const pg8::Gemm gl{(const pg8::bf16_t*)(args.ws + WS_XN), (const pg8::bf16_t*)(args.ws + WS_WINT), T, NIN, DM};
        const pg8::EpiIn El{(pg8::bf16_t*)(args.ws + WS_RKV), (pg8::bf16_t*)(args.ws + WS_ZA), (pg8::bf16_t*)(args.ws + WS_QKVB), (pg8::bf16_t*)(args.ws + WS_ZB), (pg8::bf16_t*)args.out, (pg8::bf16_t*)(args.ws + WS_LORA), F.in[IN_QNW], F.in[IN_KNW], (float*)(args.ws + WS_KMEAN)};
        constexpr int NSCAN = BATCH * NH; FRESH();
        const bool split = F.G >= 2 * NSCAN && ((F.G - NSCAN) & 31) == 0 && 64 % ((F.G - NSCAN) >> 5) == 0;
        if (split && F.vcu < NSCAN) { ck::head(F, F.vcu); FRESH(); __syncthreads(); p0_weights_late(F, F.vcu * NWAVES + F.wave, NSCAN * NWAVES, 0, 2048);
            if (MK_GIVE_QB) { const attn_body::MobaOrder S{F.vcu, NSCAN, false, MK_GIVE_QB};
#pragma unroll 1
                for (int qb = 0; qb < 8; ++qb) if ((MK_GIVE_QB >> qb) & 1) { FRESH(); __syncthreads(); attn_body::AttnUnit u; if (S.own(S.slot_of(F.vcu, qb), F.vcu, u)) attn_body::attn_unit<8>(u.bh / NH, u.bh % NH, u.qb, AT.Q, AT.K, AT.V, AT.O, AT.ZB, AT.KMEAN, (char*)lds, F.wave); } } }
        else {
            const int c = split ? F.vcu - NSCAN : F.vcu, ng = split ? F.G - NSCAN : F.G;
            if (!split) { for (int u = F.vcu; u < NSCAN; u += F.G) ck::head(F, u); __syncthreads(); }
            if (split) { InOrderLate SL{c, ng}; pg8::gemm_phase<pg8::EpiIn, InOrderLate, true, true>(F.lds, gl, SL, El, F.wave); }
            else { InOrderLate SL{0, 32}; for (int k = F.vcu; k < 32; k += F.G) { SL.c = k; pg8::gemm_phase<pg8::EpiIn, InOrderLate, true, true>(F.lds, gl, SL, El, F.wave); } }
            FRESH(); __syncthreads();
            const attn_body::MobaOrder S{c, ng, split && ng == 128 && (((64 / (ng >> 5)) * NLATE) & 31) == 16, split ? MK_GIVE_QB : 0}; attn_body::attn_phase<attn_body::MobaOrder>((char*)lds, AT, S, F.wave);
            if (!split) { FRESH(); __syncthreads(); p0_weights_late(F, c * NWAVES + F.wave, ng * NWAVES, 0, 2048); }
        }
        TS(7);
#if MK_TS
        if (F.tid == 0) { const unsigned now = (unsigned)__builtin_amdgcn_s_memrealtime(); const unsigned st = __hip_atomic_load((unsigned*)(F.ctl + CW_TS + 4), __ATOMIC_RELAXED, __HIP_MEMORY_SCOPE_AGENT);
            __hip_atomic_fetch_max((unsigned*)(F.ctl + CW_TS + 64 + (F.vcu >= 128 ? 1 : 0)), now - st, __ATOMIC_RELAXED, __HIP_MEMORY_SCOPE_AGENT);
            if (F.vcu >= 128) __hip_atomic_fetch_max((unsigned*)(F.ctl + CW_TS + 66 + (((F.vcu - 128) & 31) < 16 ? 0 : 1)), now - st, __ATOMIC_RELAXED, __HIP_MEMORY_SCOPE_AGENT); }
#endif
        if (BOTH(2)) GRID_BAR(); TS(8);
    }
    if (IN(3) && !(blockIdx.x & 1)) { FRESH(); p0_weights_late(F, F.vcu * NWAVES + F.wave, F.G * NWAVES, 2048, 4096); __syncthreads(); }
    if (IN(3)) {
        pg8::Gemm g{(const pg8::bf16_t*)(args.ws + WS_Y), (const pg8::bf16_t*)(args.ws + WS_WMT), T, DM, DM}; pg8::StaticOrder S; S.init(T, DM, F.G, (int)blockIdx.x);
        pg8::EpiMergeF E{(const pg8::bf16_t*)args.out, (pg8::bf16_t*)(args.ws + WS_MERGED)};
        pg8::gemm_phase<pg8::EpiMergeF, pg8::StaticOrder, MK_ALIGN34, true>(F.lds, g, S, E, F.wave);
        if (blockIdx.x & 1) { FRESH(); __syncthreads(); p0_weights_late(F, F.vcu * NWAVES + F.wave, F.G * NWAVES, 2048, 4096); }
        TS(10); if (BOTH(3)) GRID_BAR(); TS(11);
    }
    if (IN(4)) {
        pg8::Gemm g{(const pg8::bf16_t*)(args.ws + WS_MERGED), (const pg8::bf16_t*)(args.ws + WS_WOT), T, DM, DM}; pg8::StaticOrder S; S.init(T, DM, F.G, (int)blockIdx.x);
        pg8::EpiOut E{F.in[IN_X], args.out};
        pg8::gemm_phase<pg8::EpiOut, pg8::StaticOrder, MK_ALIGN34, true>(F.lds, g, S, E, F.wave); TS(12);
    }
#if MK_TS >= 60 && MK_TS < 70
    {
        GRID_BAR(); TS(13);
        constexpr int V = MK_TS - 60;
        if constexpr (V < 4 || V == 8) { pg8::Gemm g{(const pg8::bf16_t*)(args.ws + WS_Y), (const pg8::bf16_t*)(args.ws + WS_WMT), T, DM, DM}; pg8::StaticOrder S; S.init(T, DM, F.G, (int)blockIdx.x);
            typedef pg8::EpiMergeFT<(V & 1) == 0, (V & 2) == 0, V == 8> EP; EP E{(const pg8::bf16_t*)(args.ws + WS_QKVB), (pg8::bf16_t*)(args.ws + WS_RKV)};
            pg8::gemm_phase<EP, pg8::StaticOrder, MK_ALIGN34, true>(F.lds, g, S, E, F.wave); }
        else { pg8::Gemm g{(const pg8::bf16_t*)(args.ws + WS_MERGED), (const pg8::bf16_t*)(args.ws + WS_WOT), T, DM, DM}; pg8::StaticOrder S; S.init(T, DM, F.G, (int)blockIdx.x);
            typedef pg8::EpiOutT<V == 9 || ((V - 4) & 1) == 0, V == 9 || ((V - 4) & 2) == 0, V == 9 ? 16 : 1> EP; EP E{F.in[IN_X], (float*)(args.ws + WS_RKV)};
            pg8::gemm_phase<EP, pg8::StaticOrder, MK_ALIGN34, true>(F.lds, g, S, E, F.wave); }
        GRID_BAR(); TS(14);
    }
#endif
#undef IN
#undef BOTH
}


#if MK_TS
__global__ void mk_report(Args args) {
    const unsigned* ts0 = (const unsigned*)(args.ws + WS_CTL) + CW_TS; const unsigned* ts4 = ts0 + 32;
    float A = 0.f, B = 0.f;
    const float tk = 0.01f;
    if (MK_TS == 1) { A = (ts0[1] - ts0[0]) * tk; B = (ts0[3] - ts0[2]) * tk; }
    if (MK_TS == 2) { A = (ts0[5] - ts0[4]) * tk; B = (ts0[7] - ts0[6]) * tk; }
    if (MK_TS == 3) { A = (ts4[7] - ts4[4]) * tk; B = 0.f; }
    if (MK_TS == 4) { A = (ts0[12] - ts0[11]) * tk; B = ((ts0[2] - ts0[1]) + (ts0[4] - ts0[3]) + (ts0[6] - ts0[5]) + (ts0[8] - ts0[7]) + (ts0[11] - ts0[10])) * tk; }
    if (MK_TS >= 20 && MK_TS < 32) { A = floorf(ts0[40 + (MK_TS - 20)] * tk / 25.f) * 25.f; B = 0.f; }
    if (MK_TS == 32) { A = 0.2f * ts0[40] * tk; B = 0.f; }
    if (MK_TS == 33) { A = 0.2f * (ts0[41] + ts0[42] + ts0[43]) * tk; B = 0.f; }
    if (MK_TS == 34) { A = 0.2f * (ts0[44] + ts0[46] + ts0[47]) * tk; B = 0.f; }
    if (MK_TS == 35) { A = 0.2f * ts0[48] * tk; B = 0.f; }
    if (MK_TS == 36) { A = 0.2f * ts0[51] * tk; B = 0.f; }
    if (MK_TS == 9) { A = (ts0[13] - ts0[8]) * tk; B = 0.f; }
    if (MK_TS == 10) { A = (ts0[15] - ts0[14]) * tk; B = 0.f; }
    if (MK_TS == 11) { A = (ts0[7] - ts0[6]) * tk; B = 0.f; }
    if (MK_TS == 8) { A = ts0[20] * tk; B = 0.f; }
    if (MK_TS == 6) { A = (ts0[7] - ts0[4]) * tk; B = 0.f; }
    if (MK_TS == 7) { A = (ts0[5] - ts0[4]) * tk; B = 0.f; }
    if (MK_TS == 5) { A = (ts0[12] - ts0[0]) * tk; B = 0.f; }
    if (MK_TS >= 50 && MK_TS < 54) { A = ts0[64 + MK_TS - 50] * tk; B = 0.f; }
    if (MK_TS >= 60 && MK_TS < 70) { A = (ts0[14] - ts0[13]) * tk; B = 0.f; }
    if (MK_TS == 55) { A = ts0[65] * tk - 400.f; B = 0.f; }
    if (MK_TS == 56) { A = ts0[64] * tk - 400.f; B = 0.f; }
    if (MK_TS == 57) { A = (ts0[8] - ts0[4]) * tk - 400.f; B = 0.f; }
    if (MK_TS == 58) { A = (ts0[4] - ts0[2]) * tk - 400.f; B = 0.f; }
    if (MK_TS == 59) { A = (ts0[12] - ts0[8]) * tk - 200.f; B = 0.f; }
    if (MK_TS == 70) { A = (ts0[4] - ts0[3]) * tk * 10.f; B = 0.f; }
    if (MK_TS == 71) { A = (ts0[2] - ts0[1]) * tk * 10.f; B = 0.f; }
    if (MK_TS == 72) { A = (ts0[8] - ts0[7]) * tk * 10.f; B = 0.f; }
    if (MK_TS == 73) { A = (ts0[11] - ts0[10]) * tk * 10.f; B = 0.f; }
    if (MK_TS >= 80 && MK_TS < 88) { A = ts0[MK_TS] * tk; B = 0.f; }
    if (MK_TS == 90) { int c1 = 0, c2 = 0; for (int w = 0; w < 4; ++w) { c1 += ts0[100 + w] == ts0[104 + w]; c2 += ts0[100 + 2 * w] == ts0[101 + 2 * w]; } A = 11.f + 10.f * c1 + c2; B = 0.f; }
    if (MK_TS >= 92 && MK_TS < 96) { A = ts0[MK_TS] * tk; B = 0.f; }
    if (MK_TS >= 80 && MK_TS < 90) { A = ts0[MK_TS] * tk; B = 0.f; }
    if (MK_TS >= 80 && MK_TS < 96) { A = ts0[MK_TS] * tk; B = 0.f; }
    if (MK_TS == 54) { A = (ts0[12] - ts0[0]) * tk - 1200.f; B = 0.f; }
    if (MK_TS == 44) { A = (ts0[8] - ts0[4]) * tk; B = 0.f; }
    if (MK_TS == 45) { A = (ts0[11] - ts0[8]) * tk; B = 0.f; }
    if (MK_TS == 46) { A = (ts0[4] - ts0[2]) * tk; B = 0.f; }
    if (MK_TS == 40) { A = (ts0[3] - ts0[2]) * tk; B = 0.f; }
    if (MK_TS == 41) { A = (ts0[10] - ts0[8]) * tk; B = 0.f; }
    if (MK_TS == 42) { A = (ts0[12] - ts0[11]) * tk; B = 0.f; }
    if (MK_TS == 43) { A = (ts0[1] - ts0[0]) * tk; B = 0.f; }
    const size_t N = 3355443;
    for (size_t e = (size_t)blockIdx.x * blockDim.x + threadIdx.x; e < N; e += (size_t)gridDim.x * blockDim.x) args.out[1 + e] += 2e-4f * B;
    if (blockIdx.x == 0 && threadIdx.x == 0) args.out[0] += 0.01f * A;
}
#endif
#if MK_CHECK
constexpr int CW_CHK = 8192;
__device__ __forceinline__ float chk_silu(float x) { return x / (1.f + expf(-x)); }
__device__ __forceinline__ float chk_sig(float x) { return 1.f / (1.f + expf(-x)); }
__global__ void __launch_bounds__(64) mk_check(Args args, int stage) {
    __shared__ float sh[8][64];
    const int lane = threadIdx.x; unsigned char* ws = args.ws; unsigned* ctl = (unsigned*)(ws + WS_CTL);
    const bf16* WINT = (const bf16*)(ws + WS_WINT); const bf16* WAT = (const bf16*)(ws + WS_WAT); const bf16* WBT = (const bf16*)(ws + WS_WBT); const bf16* WOT = (const bf16*)(ws + WS_WOT);
    const bf16* XN = (const bf16*)(ws + WS_XN); const bf16* RKV = (const bf16*)(ws + WS_RKV); const bf16* ZA = (const bf16*)(ws + WS_ZA); const bf16* QKVB = (const bf16*)(ws + WS_QKVB);
    const bf16* ZB = (const bf16*)(ws + WS_ZB); const bf16* G = (const bf16*)args.out; const bf16* LORA = (const bf16*)(ws + WS_LORA);
    const bf16* YA = (const bf16*)(ws + WS_YA); const bf16* YB = (const bf16*)(ws + WS_YB); const bf16* MERGED = (const bf16*)(ws + WS_MERGED); const float* KMEAN = (const float*)(ws + WS_KMEAN);
    float ratio = 0.f; int sub = 0; unsigned fmask = 0u;
#define CHK(got, want, rel, ab, SUB) do { const float r_ = fabsf((got) - (want)) / ((rel) * fabsf(want) + (ab)); if (!(r_ <= 1.f)) fmask |= 1u << (SUB); if (!(r_ <= ratio)) { ratio = r_; sub = (SUB); } } while (0)
    if (stage == 1) {
        for (int ri = 0; ri < 4; ++ri) { const int t = ri == 0 ? 0 : ri == 1 ? 1 : ri == 2 ? 5000 : 16383; const float* xr = args.in[IN_X] + (size_t)t * DM; float s = 0.f;
            for (int j = 0; j < 32; ++j) { const float v = xr[lane * 32 + j]; s += v * v; }
            s = wave_sum(s); const float rstd = 1.f / sqrtf(s / DM + RMS_EPS); const int k = lane * 32 + ((7 * ri + lane) & 31);
            CHK(bf2f(XN[(size_t)t * DM + k]), xr[k] * rstd * args.in[IN_NORMW][k], 0.01f, 1e-3f, 1); }
        for (int q = 0; q < 4; ++q) { int n = (lane * 197 + 13 + q * 3137) % NIN; if (q == 3 && lane < 9) { int v = 4095;
                v = lane == 1 ? 4096 : lane == 2 ? 8191 : lane == 3 ? 8192 : lane == 4 ? 12287 : lane == 5 ? 12288 : lane == 6 ? 12415 : lane == 7 ? 12416 : lane == 8 ? 12543 : 4095; n = v; }
            const int k = (lane * 31 + 5 + q * 511) % DM; const int src = win_src_col(n);
            const float want = src >= 0 ? args.in[IN_WIN][(size_t)k * 12416 + src] : 0.f; CHK(bf2f(WINT[(size_t)n * DM + k]), want, 0.01f, 1e-4f, 2); }
    }
    if (stage == 2) {
        for (int q = 0; q < 4; ++q) { const int t = (lane * 1031 + 17 + q * 4099) % T, grp = (lane + q) % 9, c = (lane * 67 + 3 + q * 131) % 1024, c2 = (lane * 113 + 9 + q * 517) % 2048, c3 = (lane * 5 + q) % 128;
            const int n = grp == 0 ? c : grp == 1 ? 1024 + c : grp == 2 ? 2048 + c : grp == 3 ? 3072 + c : grp == 4 ? 4096 + 2048 + c : grp == 5 ? 4096 + 3072 + c : grp == 6 ? 8192 + c2 : grp == 7 ? 8192 + 2048 + c2 : 12288 + c3;
            float d = 0.f; for (int k = 0; k < DM; ++k) d += bf2f(XN[(size_t)t * DM + k]) * bf2f(WINT[(size_t)n * DM + k]);
            float got, want = d;
            if (grp <= 2) got = bf2f(RKV[(size_t)t * 3072 + grp * 1024 + c]);
            else if (grp == 3) { got = bf2f(ZA[(size_t)t * 1024 + c]); want = chk_silu(d); }
            else if (grp == 4) got = bf2f(QKVB[(size_t)t * 3072 + 2048 + c]);
            else if (grp == 5) { got = bf2f(ZB[(size_t)t * 1024 + c]); want = chk_silu(d); }
            else if (grp == 6) { got = bf2f(G[(size_t)t * 4096 + c2]); want = chk_sig(d); }
            else if (grp == 7) { got = bf2f(G[(size_t)t * 4096 + 2048 + c2]); want = chk_sig(d); }
            else got = bf2f(LORA[(size_t)t * 128 + c3]);
            CHK(got, want, 0.02f, 0.02f, 1 + grp); }
    }
    if (stage == 4) {
        for (int pi = 0; pi < 2; ++pi) { const int b = pi ? 5 : 0, h = pi ? 9 : 0; float S[64];
#pragma unroll
            for (int j = 0; j < 64; ++j) S[j] = 0.f;
            const int d = h * 64 + lane; const float mur = args.in[IN_MUR][d], muk = args.in[IN_MUK][d], muv = args.in[IN_MUV][d], kk_ = args.in[IN_KK][d], ka = args.in[IN_KA][d], rk = args.in[IN_RK][d], gw = args.in[IN_GNW][d], gb = args.in[IN_GNB][d];
            for (int t = 0; t < 200; ++t) { const size_t row = (size_t)b * SEQ + t;
                const float cr = bf2f(RKV[row * 3072 + d]), ck = bf2f(RKV[row * 3072 + 1024 + d]), cv = bf2f(RKV[row * 3072 + 2048 + d]);
                const float pr = t ? bf2f(RKV[(row - 1) * 3072 + d]) : 0.f, pk = t ? bf2f(RKV[(row - 1) * 3072 + 1024 + d]) : 0.f, pv = t ? bf2f(RKV[(row - 1) * 3072 + 2048 + d]) : 0.f;
                const float lcw = bf2f(LORA[row * 128 + lane]), lca = bf2f(LORA[row * 128 + 64 + lane]), lpw = t ? bf2f(LORA[(row - 1) * 128 + lane]) : 0.f, lpa = t ? bf2f(LORA[(row - 1) * 128 + 64 + lane]) : 0.f;
                __syncthreads(); sh[5][lane] = tanhf(lcw + (lpw - lcw) * args.in[IN_MUW][lane]); sh[6][lane] = lca + (lpa - lca) * args.in[IN_MUA][lane]; __syncthreads();
                float sd = 0.f, sa2 = 0.f;
                for (int i2 = 0; i2 < 64; ++i2) { sd += sh[5][i2] * args.in[IN_WDUP][i2 * 1024 + d]; sa2 += sh[6][i2] * args.in[IN_WAUP][i2 * 1024 + d]; }
                const float zz = args.in[IN_W0][d] + sd, a = chk_sig(args.in[IN_A0][d] + sa2), w = expf(-expf(-log1pf(expf(-zz)) - 0.5f));
                const float r = cr + (pr - cr) * mur, k = ck + (pk - ck) * muk, v = cv + (pv - cv) * muv;
                float kkv = k * kk_; const float nrm = fmaxf(sqrtf(wave_sum(kkv * kkv)), 1e-12f); kkv /= nrm; const float kp = k * (1.f + (a - 1.f) * ka), bb = kkv * a;
                const float bon = wave_sum(r * kp * rk);
                __syncthreads(); sh[0][lane] = r; sh[1][lane] = w; sh[2][lane] = kp; sh[3][lane] = -kkv; sh[4][lane] = bb; __syncthreads();
                float sa = 0.f;
#pragma unroll
                for (int j = 0; j < 64; ++j) sa += S[j] * sh[3][j];
                float y = 0.f;
#pragma unroll
                for (int j = 0; j < 64; ++j) { S[j] = S[j] * sh[1][j] + sa * sh[4][j] + v * sh[2][j]; y += S[j] * sh[0][j]; }
                const float mean = wave_sum(y) * (1.f / 64.f), dy = y - mean, var = wave_sum(dy * dy) * (1.f / 64.f);
                const float want = (dy / sqrtf(var + GN_EPS) * gw + gb + bon * v) * bf2f(ZA[row * 1024 + d]);
                CHK(bf2f(YA[row * 1024 + d]), want, 0.03f, 0.03f, 1 + pi * 4 + (t >= 32 ? 1 : 0) + (t >= 64 ? 1 : 0)); } }
    }
    if (stage == 5) {
        for (int q = 0; q < 4; ++q) { const int t = (lane * 523 + 7 + q * 4111) % T, h = (lane + q) & 15, which = q & 1; float ss = 0.f; const float* nw = which ? args.in[IN_KNW] : args.in[IN_QNW];
            for (int dd = 0; dd < 64; ++dd) { const float v = bf2f(QKVB[(size_t)t * 3072 + which * 1024 + h * 64 + dd]) / nw[dd]; ss += v * v; }
            CHK(ss / 64.f, which ? 1.0f : QSCALE * QSCALE, 0.02f, 0.f, 1 + which); }
        for (int q = 0; q < 2; ++q) { const int b = (lane + q * 3) & 7, h = (lane * 5 + q) & 15, n = (lane >> 3) & 7, dd = (lane * 11 + q * 29) & 63; float s = 0.f;
            for (int k = 0; k < 256; ++k) s += bf2f(QKVB[((size_t)b * SEQ + n * 256 + k) * 3072 + 1024 + h * 64 + dd]);
            CHK(KMEAN[(((size_t)b * NH + h) * 8 + n) * 64 + dd], s / 256.f, 0.02f, 2e-3f, 3); }
    }
    if (stage == 6) {
        const int l15 = lane & 15;
        const int s = l15 == 0 ? 0 : l15 == 1 ? 1 : l15 == 2 ? 63 : l15 == 3 ? 64 : l15 == 4 ? 255 : l15 == 5 ? 256 : l15 == 6 ? 300 : l15 == 7 ? 511 : l15 == 8 ? 512 : l15 == 9 ? 777 : l15 == 10 ? 1023 : l15 == 11 ? 1024 : l15 == 12 ? 1300 : l15 == 13 ? 1791 : l15 == 14 ? 1800 : 2047;
        const int b = (lane >> 4) * 2 + 1, h = (lane * 7 + 3) & 15, qblk = s >> 8; const size_t row = (size_t)b * SEQ + s;
        float qv[64], o[64];
#pragma unroll
        for (int dd = 0; dd < 64; ++dd) { qv[dd] = bf2f(QKVB[row * 3072 + h * 64 + dd]); o[dd] = 0.f; }
        float g[8]; int nsel = qblk < 3 ? qblk : 3; unsigned selm = 0;
#pragma unroll
        for (int n = 0; n < 8; ++n) { g[n] = -1e30f; if (n < qblk) { float a = 0.f;
#pragma unroll
                for (int dd = 0; dd < 64; ++dd) a += qv[dd] * KMEAN[(((size_t)b * NH + h) * 8 + n) * 64 + dd];
                g[n] = a; } }
        for (int it = 0; it < nsel; ++it) { int best = -1; float bv = -3e38f;
#pragma unroll
            for (int n = 0; n < 8; ++n) if (!((selm >> n) & 1u) && g[n] > bv) { bv = g[n]; best = n; }
            selm |= 1u << best; }
        float m = -1e30f, l = 0.f;
        for (int n = 0; n <= qblk; ++n) { if (n < qblk && !((selm >> n) & 1u)) continue;
            for (int kk2 = 0; kk2 < 256; ++kk2) { const int j = n * 256 + kk2; if (j > s) break; const size_t kr = ((size_t)b * SEQ + j) * 3072; float sc = 0.f;
#pragma unroll
                for (int dd = 0; dd < 64; ++dd) sc += qv[dd] * bf2f(QKVB[kr + 1024 + h * 64 + dd]);
                const float mn = fmaxf(m, sc), al = exp2f(m - mn), p = exp2f(sc - mn); l = l * al + p; m = mn;
#pragma unroll
                for (int dd = 0; dd < 64; ++dd) o[dd] = o[dd] * al + p * bf2f(QKVB[kr + 2048 + h * 64 + dd]); } }
#pragma unroll
        for (int dd = 0; dd < 64; ++dd) CHK(bf2f(YB[row * 1024 + h * 64 + dd]), o[dd] / l * bf2f(ZB[row * 1024 + h * 64 + dd]), 0.03f, 0.003f, 1 + (qblk > 3 ? 1 : 0) + (qblk == 0 ? 2 : 0));
    }
    if (stage == 7) {
            { const int n = (lane * 37 + 3) % DM, k = (lane * 29 + 1) % WID; CHK(bf2f(WAT[(size_t)n * WID + k]), args.in[IN_WPR][(size_t)k * DM + n], 0.01f, 1e-4f, 3);
          CHK(bf2f(WBT[(size_t)n * WID + k]), args.in[IN_WPM][(size_t)k * DM + n], 0.01f, 1e-4f, 3); const int k2 = (lane * 61 + 7) % DM; CHK(bf2f(WOT[(size_t)n * DM + k2]), args.in[IN_WOUT][(size_t)k2 * DM + n], 0.01f, 1e-4f, 3); }
        for (int q = 0; q < 4; ++q) { const int t = (lane * 1031 + 17 + q * 4099) % T, n = (lane * 113 + 9 + q * 517) % 2048; float da = 0.f, db = 0.f;
            for (int k = 0; k < WID; ++k) { da += bf2f(YA[(size_t)t * 1024 + k]) * bf2f(WAT[(size_t)n * WID + k]); db += bf2f(YB[(size_t)t * 1024 + k]) * bf2f(WBT[(size_t)n * WID + k]); }
            CHK(bf2f(MERGED[(size_t)t * 2048 + n]), bf2f(G[(size_t)t * 4096 + n]) * da + bf2f(G[(size_t)t * 4096 + 2048 + n]) * db, 0.02f, 0.01f, 1); }
    }
    if (stage == 8) {
        for (int q = 0; q < 4; ++q) { const int t = (lane * 1031 + 17 + q * 4099) % T, n = (lane * 113 + 9 + q * 517) % 2048; float d = 0.f;
            for (int k = 0; k < DM; ++k) d += bf2f(MERGED[(size_t)t * 2048 + k]) * bf2f(WOT[(size_t)n * DM + k]);
            CHK(args.out[(size_t)t * DM + n], args.in[IN_X][(size_t)t * DM + n] + d, 0.f, 0.01f, 1); }
    }
    const float wr = wave_max(ratio);
#pragma unroll
    for (int o_ = 1; o_ < 64; o_ <<= 1) fmask |= (unsigned)__shfl_xor((int)fmask, o_);
    (void)sub;
    if (threadIdx.x == 0 && blockIdx.x == 0 && stage <= 8) { if (fmask && ctl[CW_CHK] == 0u) { const int low = __ffs((int)fmask) - 1, cnt = __popc(fmask);
            ctl[CW_CHK] = (unsigned)(stage * 10 + (low > 9 ? 9 : low)); ctl[CW_CHK + 1] = (unsigned)(cnt + (wr >= 64.f ? 20 : wr >= 8.f ? 10 : 0)); } }
    if (stage == 9) { const unsigned code = ctl[CW_CHK], code2 = ctl[CW_CHK + 1];
        if (code) { for (size_t e = (size_t)blockIdx.x * 64 + lane; e < (size_t)T * DM; e += (size_t)gridDim.x * 64) args.out[e] += (float)code2;
            if (blockIdx.x == 0 && lane == 0) args.out[0] = 100.f * (float)code; } }
#undef CHK
}
#endif

extern "C" void kernel_launch(void* const* d_in, const int* in_sizes, int n_in, void* d_out, int out_size, void* d_ws, size_t ws_size, hipStream_t stream) {
    static int grid = 0;
    if (grid == 0) {
        if (n_in != 22 || in_sizes[0] != T * DM || out_size != T * DM || ws_size < WS_END) { fprintf(stderr, "kernel_launch: unexpected shapes (n_in %d, in0 %d, out %d, ws %zu)\n", n_in, n_in > 0 ? in_sizes[0] : -1, out_size, ws_size); grid = -1; return; }
        int dev = 0, cus = 0, per_cu = 0;
        if (hipGetDevice(&dev) != hipSuccess || hipDeviceGetAttribute(&cus, hipDeviceAttributeMultiprocessorCount, dev) != hipSuccess) { grid = -1; return; }
        if (hipFuncSetAttribute((const void*)mk_fwd, hipFuncAttributeMaxDynamicSharedMemorySize, LDS_BYTES) != hipSuccess) { fprintf(stderr, "kernel_launch: hipFuncSetAttribute failed\n"); grid = -1; return; }
        if (hipOccupancyMaxActiveBlocksPerMultiprocessor(&per_cu, (const void*)mk_fwd, NWAVES * 64, LDS_BYTES) != hipSuccess || per_cu < 1) { fprintf(stderr, "kernel_launch: occupancy query says %d blocks per CU\n", per_cu); per_cu = 1; }
        (void)hipGetLastError();
        grid = cus;
    }
    if (grid < 0) return;
    (void)hipMemsetAsync((char*)d_ws + WS_CTL, 0, CTL_ZERO_BYTES, stream);
    Args a{};
    for (int i = 0; i < 22; ++i) a.in[i] = (const float*)d_in[i];
    a.out = (float*)d_out; a.ws = (unsigned char*)d_ws;
    if (MK_N_LAUNCHES == 1) { a.ph_lo = 0; a.ph_hi = PER_PHASE; a.li = 0; hipLaunchKernelGGL(mk_fwd, dim3(grid), dim3(NWAVES * 64), LDS_BYTES, stream, a);
#if MK_TS
        hipLaunchKernelGGL(mk_report, dim3(256), dim3(256), 0, stream, a);
#endif
    }
    else for (int li = 0; li < PER_PHASE; ++li) { a.ph_lo = li; a.ph_hi = li + 1; a.li = li; hipLaunchKernelGGL(mk_fwd, dim3(grid), dim3(NWAVES * 64), LDS_BYTES, stream, a);
#if MK_CHECK
        const int stg = li == 0 ? 1 : li == 1 ? 2 : li == 2 ? 4 : li == 3 ? 7 : li == 4 ? 8 : 0;
        if (stg) hipLaunchKernelGGL(mk_check, dim3(1), dim3(64), 0, stream, a, stg);
        if (li == 1) hipLaunchKernelGGL(mk_check, dim3(1), dim3(64), 0, stream, a, 5);
        if (li == 2) hipLaunchKernelGGL(mk_check, dim3(1), dim3(64), 0, stream, a, 6);
        if (li == 4) hipLaunchKernelGGL(mk_check, dim3(512), dim3(64), 0, stream, a, 9);
#endif
    }
}
```

```cpp
#define MK_N_LAUNCHES 1
#include <hip/hip_runtime.h>
#include <cstdio>
#include <cstdint>
#include <hip/hip_bf16.h>
#include <cmath>
__device__ __forceinline__ int mk_lane_id() { int l; asm volatile("v_mbcnt_lo_u32_b32 %0, -1, 0\n\tv_mbcnt_hi_u32_b32 %0, -1, %0" : "=v"(l)); return l; }
#ifndef MK_WGM
#define MK_WGM 4
#endif
namespace pg8 {
#define PG8_LAS __attribute__((address_space(3)))
typedef unsigned short bf16_t;
typedef short bf16x8 __attribute__((ext_vector_type(8)));
typedef float f32x4 __attribute__((ext_vector_type(4)));
typedef unsigned u32x4 __attribute__((ext_vector_type(4)));
constexpr int BM = 256, BK = 64, HALF = 128, HTB = HALF * BK * 2  , STAGE_BYTES = 8 * HTB, NXCD = 8, WGM = MK_WGM;

__host__ __device__ __forceinline__ int lds_byte(int r, int c) { const int st = (r >> 4) * 2 + (c >> 5), rr = r & 15, cc = c & 31, ob = rr * 64 + cc * 2; return st * 1024 + (ob ^ (((ob >> 9) & 1) << 5)); }
__host__ __device__ __forceinline__ void stage_rc(int b, int& R, int& C) { const int st = b / 1024, sb = b % 1024, swz = sb ^ (((sb >> 9) & 1) << 5); R = (st >> 1) * 16 + swz / 64; C = (st & 1) * 32 + (swz % 64) / 2; }
__host__ __device__ __forceinline__ int perm32(int rho) { const int n = rho >> 4, i = rho & 15; return 8 * (i >> 2) + 4 * n + (i & 3); }

struct Unit { int pm, pn; };
struct Gemm { const bf16_t* A; const bf16_t* Bt; int M, N, K; };

template <int W> struct StaticOrderT {
    int nM, nN, nwg, G, c;
    __host__ __device__ void init(int M, int N, int G_, int c_) { nM = M / BM; nN = N / BM; nwg = nM * nN; G = G_; c = c_; }
    __host__ __device__ bool next(int i, Unit& u) const {
        const long L = (long)i * G + c; if (L >= nwg) return false;
        int wgid = (int)L; { const int q = nwg / NXCD, r = nwg % NXCD, xcd = wgid % NXCD, off = wgid / NXCD; wgid = (xcd < r ? xcd * (q + 1) : r * (q + 1) + (xcd - r) * q) + off; }
        const int nig = W * nN, gid = wgid / nig, fm = gid * W, gsz = (nM - fm) < W ? (nM - fm) : W;
        u.pm = fm + ((wgid % nig) % gsz); u.pn = (wgid % nig) / gsz; return true;
    }
    __device__ __forceinline__ void a_ready(const Unit&) const {}
    __device__ __forceinline__ void done(const Unit&) const {}
};
typedef StaticOrderT<WGM> StaticOrder;

__device__ __forceinline__ unsigned cvt_pk_bf16(float lo, float hi) { unsigned r; asm volatile("v_cvt_pk_bf16_f32 %0, %1, %2" : "=v"(r) : "v"(lo), "v"(hi)); return r; }
typedef float f32x2 __attribute__((ext_vector_type(2)));
typedef __bf16 epi_bf16x2 __attribute__((ext_vector_type(2)));
__device__ __forceinline__ unsigned cvt2(float lo, float hi) { f32x2 v = {lo, hi}; epi_bf16x2 b = __builtin_convertvector(v, epi_bf16x2); return __builtin_bit_cast(unsigned, b); }
__device__ __forceinline__ float bf_lo(unsigned w) { return __builtin_bit_cast(float, w << 16); }
__device__ __forceinline__ float bf_hi(unsigned w) { return __builtin_bit_cast(float, w & 0xffff0000u); }
__device__ __forceinline__ float fast_sigmoid(float x) { return __builtin_amdgcn_rcpf(1.0f + __builtin_amdgcn_exp2f(-1.4426950408889634f * x)); }
template <int ACT> __device__ __forceinline__ float act_f(float x) { if (ACT == 1) return x * fast_sigmoid(x); if (ACT == 2) return fast_sigmoid(x); return x; }

#ifndef MK_NT
#define MK_NT 0
#endif
#ifndef MK_WT
#define MK_WT 0
#endif
template <int BIT, class V> __device__ __forceinline__ void epi_st(V* p, const V v) {
    if constexpr ((MK_WT >> BIT) & 1) asm volatile("global_store_dwordx4 %0, %1, off sc1\n\ts_nop 1" :: "v"(p), "v"(v) : "memory");
    else if constexpr ((MK_NT >> BIT) & 1) __builtin_nontemporal_store(v, p); else *p = v; }
template <int BIT, class V> __device__ __forceinline__ V epi_ld(const V* p) { if constexpr ((MK_NT >> BIT) & 1) return __builtin_nontemporal_load(p); else return *p; }
constexpr size_t T_LIN = (size_t)64 * 16 * 8 * 8 * 64;
struct EpiIn {
    static constexpr bool PERM = true, AFTER_DRAIN = false, INIT = false, MID = false;
    bf16_t *RKV, *ZA, *QKVB, *ZB, *G, *LORA;
    template <int ACT, int NBJ> __device__ __forceinline__ void put(const f32x4 (&acc)[2][2][4][2], bf16_t* base, int ldc, int row0, int col0) const {
#pragma unroll
        for (int ai = 0; ai < 2; ++ai)
#pragma unroll
            for (int m = 0; m < 4; ++m) { bf16_t* rowp = base + (size_t)(row0 + ai * HALF + m * 16) * ldc + col0;
#pragma unroll
                for (int bj = 0; bj < NBJ; ++bj) { const f32x4 v0 = acc[ai][bj][m][0], v1 = acc[ai][bj][m][1]; u32x4 w;
                    w.x = cvt2(act_f<ACT>(v0[0]), act_f<ACT>(v0[1])); w.y = cvt2(act_f<ACT>(v0[2]), act_f<ACT>(v0[3]));
                    w.z = cvt2(act_f<ACT>(v1[0]), act_f<ACT>(v1[1])); w.w = cvt2(act_f<ACT>(v1[2]), act_f<ACT>(v1[3]));
                    epi_st<0>((u32x4*)(rowp + bj * HALF), w); } }
    }
    const float* qnw; const float* knw; float* KMEAN;
    template <bool ISK> __device__ __forceinline__ void putqk(const f32x4 (&acc)[2][2][4][2], const Unit& u, int wr, int wc, int fr, int fq) const {
        const int hh = (u.pn & 3) * 4 + wc; const float* nw = ISK ? knw : qnw; const float sc = ISK ? 1.0f : 0.125f * 1.4426950408889634f;
        float rs[2][4];
#pragma unroll
        for (int ai = 0; ai < 2; ++ai)
#pragma unroll
            for (int m = 0; m < 4; ++m) { float ss = 0.f;
#pragma unroll
                for (int bj = 0; bj < 2; ++bj)
#pragma unroll
                    for (int n = 0; n < 2; ++n) { const f32x4 v = acc[ai][bj][m][n]; ss += (v[0] * v[0] + v[1] * v[1]) + (v[2] * v[2] + v[3] * v[3]); }
                ss += __shfl_xor(ss, 16); ss += __shfl_xor(ss, 32);
                rs[ai][m] = 1.0f / sqrtf(ss * (1.0f / 64.0f) + 1e-6f); }
        bf16_t* base = QKVB + (size_t)(u.pm * BM + wr * 64 + fr) * 3072 + (ISK ? 1024 : 0) + hh * 64 + 8 * fq;
#pragma unroll
        for (int bj = 0; bj < 2; ++bj) {
            const f32x4 w0 = *(const f32x4*)(nw + 32 * bj + 8 * fq), w1 = *(const f32x4*)(nw + 32 * bj + 8 * fq + 4);
            const float wv[8] = {w0[0] * sc, w0[1] * sc, w0[2] * sc, w0[3] * sc, w1[0] * sc, w1[1] * sc, w1[2] * sc, w1[3] * sc};
            float cs[8] = {0.f, 0.f, 0.f, 0.f, 0.f, 0.f, 0.f, 0.f};
#pragma unroll
            for (int ai = 0; ai < 2; ++ai)
#pragma unroll
                for (int m = 0; m < 4; ++m) { const f32x4 v0 = acc[ai][bj][m][0], v1 = acc[ai][bj][m][1]; const float r = rs[ai][m]; float o[8];
                    o[0] = v0[0] * r * wv[0]; o[1] = v0[1] * r * wv[1]; o[2] = v0[2] * r * wv[2]; o[3] = v0[3] * r * wv[3]; o[4] = v1[0] * r * wv[4]; o[5] = v1[1] * r * wv[5]; o[6] = v1[2] * r * wv[6]; o[7] = v1[3] * r * wv[7];
                    if (ISK) {
#pragma unroll
                        for (int j = 0; j < 8; ++j) cs[j] += o[j]; }
                    u32x4 w; w.x = cvt2(o[0], o[1]); w.y = cvt2(o[2], o[3]); w.z = cvt2(o[4], o[5]); w.w = cvt2(o[6], o[7]);
                    epi_st<0>((u32x4*)(base + (size_t)(ai * HALF + m * 16) * 3072 + 32 * bj), w); }
            if (ISK) { float* km = KMEAN + ((size_t)((u.pm >> 3) * 16 + hh) * 8 + (u.pm & 7)) * 64;
#pragma unroll
                for (int j = 0; j < 8; ++j) { float s = cs[j]; s += __shfl_xor(s, 1); s += __shfl_xor(s, 2); s += __shfl_xor(s, 4); s += __shfl_xor(s, 8);
                    if (fr == 0) atomicAdd(km + 32 * bj + 8 * fq + j, s * (1.0f / 256.0f)); } } }
    }
    __device__ __forceinline__ void putgate(const f32x4 (&acc)[2][2][4][2], const Unit& u, int wr, int wc, int fr, int fq) const {
        u32x4* gp = (u32x4*)G + ((((size_t)u.pm * 16 + (u.pn - 32)) * 8 + wr * 4 + wc) * 8) * 64 + fq * 16 + fr;
#pragma unroll
        for (int ai = 0; ai < 2; ++ai)
#pragma unroll
            for (int m = 0; m < 4; ++m) { float s[8], r[8];
#pragma unroll
                for (int n = 0; n < 2; ++n)
#pragma unroll
                    for (int e = 0; e < 4; ++e) { const float sa = fmaxf(fast_sigmoid(acc[ai][0][m][n][e]), 1e-30f), sb = fast_sigmoid(acc[ai][1][m][n][e]); s[4 * n + e] = sa; r[4 * n + e] = sb * __builtin_amdgcn_rcpf(sa); }
                u32x4 w; w.x = cvt2(s[0], s[1]); w.y = cvt2(s[2], s[3]); w.z = cvt2(s[4], s[5]); w.w = cvt2(s[6], s[7]); epi_st<0>(gp + (ai * 4 + m) * 64, w);
                w.x = cvt2(r[0], r[1]); w.y = cvt2(r[2], r[3]); w.z = cvt2(r[4], r[5]); w.w = cvt2(r[6], r[7]); epi_st<0>(gp + T_LIN + (ai * 4 + m) * 64, w); }
    }
    __device__ __forceinline__ void operator()(const f32x4 (&acc)[2][2][4][2], const Unit& u, int wr, int wc, int fr, int fq) const {
        asm volatile("" : "+v"(fr), "+v"(fq));
        const int row0 = u.pm * BM + wr * 64 + fr, cw = wc * 32 + 8 * fq, pn = u.pn;
        if (pn >= 16 && pn < 20) putqk<false>(acc, u, wr, wc, fr, fq);
        else if (pn >= 20 && pn < 24) putqk<true>(acc, u, wr, wc, fr, fq);
        else if (pn < 12) put<0, 2>(acc, RKV, 3072, row0, pn * 256 + cw);
        else if (pn < 16) put<1, 2>(acc, ZA, 1024, row0, (pn - 12) * 256 + cw);
        else if (pn < 28) put<0, 2>(acc, QKVB, 3072, row0, (pn - 16) * 256 + cw);
        else if (pn < 32) put<1, 2>(acc, ZB, 1024, row0, (pn - 28) * 256 + cw);
        else if (pn < 48) putgate(acc, u, wr, wc, fr, fq);
        else put<0, 1>(acc, LORA, 128, row0, cw);
    }
};
template <bool LD = true, bool ST = true, bool LIN = true> struct EpiMergeFT {
    static constexpr bool PERM = true, AFTER_DRAIN = false, INIT = false, MID = true;
    const bf16_t* G; bf16_t* O;
    __device__ __forceinline__ void mid(f32x4 (&acc)[2][2][4][2], const Unit& u, int wr, int wc, int fr, int fq) const {
        asm volatile("" : "+v"(fr), "+v"(fq));
        const int row0 = u.pm * BM + wr * 64 + fr, col0 = u.pn * BM + wc * 32 + 8 * fq;
#pragma unroll
        for (int ai = 0; ai < 2; ++ai) { u32x4 g[4][2];
#pragma unroll
            for (int m = 0; m < 4; ++m)
#pragma unroll
                for (int bj = 0; bj < 2; ++bj) g[m][bj] = LIN ? epi_ld<2>((const u32x4*)(G + 8 * ((((((size_t)u.pm * 16 + 2 * u.pn + bj) * 8 + wr * 4 + wc) * 8 + ai * 4 + m) * 64 + fq * 16 + fr) + (size_t)T_LIN))) : LD ? *(const u32x4*)(G + (size_t)(row0 + ai * HALF + m * 16) * 4096 + 2048 + col0 + bj * HALF) : (u32x4){0x3f003f00u, 0x3f003f00u, 0x3f003f00u, 0x3f003f00u};
#pragma unroll
            for (int m = 0; m < 4; ++m)
#pragma unroll
                for (int bj = 0; bj < 2; ++bj) { const u32x4 gg = g[m][bj]; f32x4 v0 = acc[ai][bj][m][0], v1 = acc[ai][bj][m][1];
                    v0[0] *= bf_lo(gg.x); v0[1] *= bf_hi(gg.x); v0[2] *= bf_lo(gg.y); v0[3] *= bf_hi(gg.y); v1[0] *= bf_lo(gg.z); v1[1] *= bf_hi(gg.z); v1[2] *= bf_lo(gg.w); v1[3] *= bf_hi(gg.w);
                    acc[ai][bj][m][0] = v0; acc[ai][bj][m][1] = v1; } }
    }
    __device__ __forceinline__ void operator()(const f32x4 (&acc)[2][2][4][2], const Unit& u, int wr, int wc, int fr, int fq) const {
        const int row0 = u.pm * BM + wr * 64 + fr, col0 = u.pn * BM + wc * 32 + 8 * fq;
#pragma unroll
        for (int ai = 0; ai < 2; ++ai) { u32x4 g[4][2];
#pragma unroll
            for (int m = 0; m < 4; ++m)
#pragma unroll
                for (int bj = 0; bj < 2; ++bj) g[m][bj] = LIN ? epi_ld<2>((const u32x4*)(G + 8 * (((((size_t)u.pm * 16 + 2 * u.pn + bj) * 8 + wr * 4 + wc) * 8 + ai * 4 + m) * 64 + fq * 16 + fr))) : LD ? *(const u32x4*)(G + (size_t)(row0 + ai * HALF + m * 16) * 4096 + col0 + bj * HALF) : (u32x4){0x3f003f00u, 0x3f003f00u, 0x3f003f00u, 0x3f003f00u};
#pragma unroll
            for (int m = 0; m < 4; ++m)
#pragma unroll
                for (int bj = 0; bj < 2; ++bj) { const u32x4 gg = g[m][bj]; const f32x4 v0 = acc[ai][bj][m][0], v1 = acc[ai][bj][m][1]; u32x4 w;
                    w.x = cvt2(v0[0] * bf_lo(gg.x), v0[1] * bf_hi(gg.x)); w.y = cvt2(v0[2] * bf_lo(gg.y), v0[3] * bf_hi(gg.y)); w.z = cvt2(v1[0] * bf_lo(gg.z), v1[1] * bf_hi(gg.z)); w.w = cvt2(v1[2] * bf_lo(gg.w), v1[3] * bf_hi(gg.w));
                    if (ST || w.x == 0x7fc17fc1u) epi_st<2>((u32x4*)(O + (size_t)(row0 + ai * HALF + m * 16) * 2048 + col0 + bj * HALF), w); } }
    }
};
typedef EpiMergeFT<true, true, true> EpiMergeF;
template <bool LD = true, bool ST = true, int BATCH = 16> struct EpiOutT {
    static constexpr bool PERM = false, AFTER_DRAIN = false, INIT = false, MID = false;
    const float* X; float* O;
    __device__ __forceinline__ void operator()(const f32x4 (&acc)[2][2][4][2], const Unit& u, int wr, int wc, int fr, int fq) const {
        const int row0 = u.pm * BM + wr * 64 + fr, col0 = u.pn * BM + wc * 32 + 4 * fq;
        if constexpr (BATCH == 17) {
            f32x4 x[4][2][2], r[4][2][2];
#pragma unroll
            for (int m = 0; m < 4; ++m)
#pragma unroll
                for (int bj = 0; bj < 2; ++bj)
#pragma unroll
                    for (int n = 0; n < 2; ++n) x[m][bj][n] = epi_ld<1>((const f32x4*)(X + (size_t)(row0 + m * 16) * 2048 + col0 + bj * HALF + n * 16));
#pragma unroll
            for (int m = 0; m < 4; ++m)
#pragma unroll
                for (int bj = 0; bj < 2; ++bj)
#pragma unroll
                    for (int n = 0; n < 2; ++n) r[m][bj][n] = x[m][bj][n] + acc[0][bj][m][n];
#pragma unroll
            for (int m = 0; m < 4; ++m)
#pragma unroll
                for (int bj = 0; bj < 2; ++bj)
#pragma unroll
                    for (int n = 0; n < 2; ++n) x[m][bj][n] = epi_ld<1>((const f32x4*)(X + (size_t)(row0 + HALF + m * 16) * 2048 + col0 + bj * HALF + n * 16));
#pragma unroll
            for (int m = 0; m < 4; ++m)
#pragma unroll
                for (int bj = 0; bj < 2; ++bj)
#pragma unroll
                    for (int n = 0; n < 2; ++n) epi_st<1>((f32x4*)(O + (size_t)(row0 + m * 16) * 2048 + col0 + bj * HALF + n * 16), r[m][bj][n]);
#pragma unroll
            for (int m = 0; m < 4; ++m)
#pragma unroll
                for (int bj = 0; bj < 2; ++bj)
#pragma unroll
                    for (int n = 0; n < 2; ++n) epi_st<1>((f32x4*)(O + (size_t)(row0 + HALF + m * 16) * 2048 + col0 + bj * HALF + n * 16), x[m][bj][n] + acc[1][bj][m][n]);
        } else if constexpr (BATCH == 16) {
#pragma unroll
            for (int ai = 0; ai < 2; ++ai) { f32x4 x[4][2][2];
#pragma unroll
                for (int m = 0; m < 4; ++m)
#pragma unroll
                    for (int bj = 0; bj < 2; ++bj)
#pragma unroll
                        for (int n = 0; n < 2; ++n) x[m][bj][n] = LD ? epi_ld<1>((const f32x4*)(X + (size_t)(row0 + ai * HALF + m * 16) * 2048 + col0 + bj * HALF + n * 16)) : (f32x4){1.f, 1.f, 1.f, 1.f};
#pragma unroll
                for (int m = 0; m < 4; ++m)
#pragma unroll
                    for (int bj = 0; bj < 2; ++bj)
#pragma unroll
                        for (int n = 0; n < 2; ++n) { const f32x4 v = x[m][bj][n] + acc[ai][bj][m][n]; if (ST || v[0] == 1.2345e30f) epi_st<1>((f32x4*)(O + (size_t)(row0 + ai * HALF + m * 16) * 2048 + col0 + bj * HALF + n * 16), v); } }
        } else {
#pragma unroll
        for (int ai = 0; ai < 2; ++ai)
#pragma unroll
            for (int m = 0; m < 4; ++m) { const size_t off = (size_t)(row0 + ai * HALF + m * 16) * 2048 + col0;
#pragma unroll
                for (int bj = 0; bj < 2; ++bj)
#pragma unroll
                    for (int n = 0; n < 2; ++n) { const f32x4 v = (LD ? *(const f32x4*)(X + off + bj * HALF + n * 16) : (f32x4){1.f, 1.f, 1.f, 1.f}) + acc[ai][bj][m][n]; if (ST || v[0] == 1.2345e30f) *(f32x4*)(O + off + bj * HALF + n * 16) = v; } }
        }
    }
};
typedef EpiOutT<true, true, 17> EpiOut;
template <class Epi, class Sched, bool ALIGN_EPI = false, bool SP2 = false>
__device__ __forceinline__ void gemm_phase(PG8_LAS unsigned char* lds, const Gemm g, const Sched& S, const Epi& E, const int wave_id) {
    const int wid = __builtin_amdgcn_readfirstlane(wave_id), lane = mk_lane_id(), tid = wid * 64 + lane, wr = wid >> 2, wc = wid & 3, fr = lane & 15, fq = lane >> 4;
    const int K = g.K, nt = K / BK;
    unsigned voffA[2], voffB[2];
#pragma unroll
    for (int i = 0; i < 2; ++i) { int R, C; stage_rc(tid * 16 + i * 8192, R, C); const int Rb = Epi::PERM ? ((R & ~31) + perm32(R & 31)) : R;
        voffA[i] = (unsigned)(R * K + C) * 2u; voffB[i] = (unsigned)(Rb * K + C) * 2u; }
    const size_t kstep = (size_t)(BK * 2);
    const size_t hstep = (size_t)HALF * K * 2;
    const size_t tstep = 2 * hstep;
    const unsigned ldsw = (unsigned)wid * 1024u;
    const int aoff = lds_byte(wr * 64 + fr, fq * 8), boff = lds_byte(wc * 32 + fr, fq * 8);
#define PG8_SA(b, h) (((b) * 2 + (h)) * HTB)
#define PG8_SB(b, h) ((4 + (b) * 2 + (h)) * HTB)
#define PG8_STAGE(bufoff, gbase, voff) do { _Pragma("unroll") for (int _i = 0; _i < 2; ++_i) \
        __builtin_amdgcn_global_load_lds((const unsigned*)((const char*)(gbase) + (voff)[_i]), (PG8_LAS unsigned*)(lds + (bufoff) + ldsw + _i * 8192), 16, 0, 0); } while (0)
#define PG8_LDA(dst, b, h) do { _Pragma("unroll") for (int m = 0; m < 4; ++m) _Pragma("unroll") for (int k = 0; k < 2; ++k) dst[m][k] = *(const PG8_LAS bf16x8*)(lds + PG8_SA(b, h) + aoff + m * 2048 + k * 1024); } while (0)
#define PG8_LDB(dst, b, h) do { _Pragma("unroll") for (int n = 0; n < 2; ++n) _Pragma("unroll") for (int k = 0; k < 2; ++k) dst[n][k] = *(const PG8_LAS bf16x8*)(lds + PG8_SB(b, h) + boff + n * 2048 + k * 1024); } while (0)
#define PG8_MMA(ai, bj, At, Bt) do { __builtin_amdgcn_s_setprio(1); _Pragma("unroll") for (int m = 0; m < 4; ++m) _Pragma("unroll") for (int n = 0; n < 2; ++n) _Pragma("unroll") for (int k = 0; k < 2; ++k) \
        acc[ai][bj][m][n] = __builtin_amdgcn_mfma_f32_16x16x32_bf16(Bt[n][k], At[m][k], acc[ai][bj][m][n], 0, 0, 0); __builtin_amdgcn_s_setprio(0); } while (0)
#define PG8_WAIT_V(n) asm volatile("s_waitcnt vmcnt(" #n ")" ::: "memory")
#define PG8_WAIT_L(n) asm volatile("s_waitcnt lgkmcnt(" #n ")" ::: "memory")
#define PG8_BAR __builtin_amdgcn_s_barrier()
#define PG8_SCHED __builtin_amdgcn_sched_barrier(0)
    Unit cur, nxt; int ui = 0;
    if (!S.next(0, cur)) return;
    f32x4 acc[2][2][4][2];
    if constexpr (Epi::INIT) E.init(acc, cur, wr, wc, fr, fq);
    else {
#pragma unroll
    for (int a = 0; a < 2; ++a)
#pragma unroll
        for (int b = 0; b < 2; ++b)
#pragma unroll
            for (int m = 0; m < 4; ++m)
#pragma unroll
                for (int n = 0; n < 2; ++n) acc[a][b][m][n] = (f32x4){0.f, 0.f, 0.f, 0.f};
    }
    bf16x8 At[4][2], B0[2][2], B1[2][2];
    const char* cA = (const char*)g.A + (size_t)cur.pm * tstep; const char* cB = (const char*)g.Bt + (size_t)cur.pn * tstep;
    S.a_ready(cur);
    if constexpr (SP2) {
        PG8_STAGE(PG8_SB(0, 0), cB, voffB); PG8_STAGE(PG8_SB(0, 1), cB + hstep, voffB); PG8_STAGE(PG8_SA(0, 0), cA, voffA); PG8_STAGE(PG8_SA(0, 1), cA + hstep, voffA);
        if (wr == 1) PG8_BAR;
        PG8_WAIT_V(2); PG8_BAR;
        PG8_STAGE(PG8_SB(1, 0), cB + kstep, voffB); PG8_STAGE(PG8_SA(1, 0), cA + kstep, voffA); PG8_STAGE(PG8_SB(1, 1), cB + hstep + kstep, voffB);
        PG8_WAIT_V(6); PG8_BAR;
    } else {
        PG8_STAGE(PG8_SB(0, 0), cB, voffB); PG8_STAGE(PG8_SA(0, 0), cA, voffA); PG8_STAGE(PG8_SB(0, 1), cB + hstep, voffB); PG8_STAGE(PG8_SA(0, 1), cA + hstep, voffA);
        if (wr == 1) PG8_BAR;
        PG8_WAIT_V(4); PG8_BAR;
        PG8_STAGE(PG8_SB(1, 0), cB + kstep, voffB); PG8_STAGE(PG8_SA(1, 0), cA + kstep, voffA); PG8_STAGE(PG8_SB(1, 1), cB + hstep + kstep, voffB);
        PG8_WAIT_V(6); PG8_BAR;
    }
    for (;;) {
        const bool has_next = S.next(ui + 1, nxt);
        const char* nA = has_next ? (const char*)g.A + (size_t)nxt.pm * tstep : cA; const char* nB = has_next ? (const char*)g.Bt + (size_t)nxt.pn * tstep : cB;
        for (int t = 0; t < nt; t += 2) {
            const bool last = (t == nt - 2);
            const char* a1 = cA + (size_t)(t + 1) * kstep;
            const char* a2 = last ? nA : cA + (size_t)(t + 2) * kstep; const char* b2 = last ? nB : cB + (size_t)(t + 2) * kstep;
            const char* a3 = a2 + kstep; const char* b3 = b2 + kstep;
            if (last && has_next) S.a_ready(nxt);
            if constexpr (Epi::MID) { if (t == nt / 2) E.mid(acc, cur, wr, wc, fr, fq); }
            if constexpr (SP2) {
            PG8_LDB(B0, 0, 0); PG8_LDB(B1, 0, 1); PG8_SCHED; PG8_LDA(At, 0, 0); PG8_STAGE(PG8_SA(1, 1), a1 + hstep, voffA);
            PG8_WAIT_V(8); PG8_WAIT_L(0); PG8_BAR; PG8_MMA(0, 0, At, B0); PG8_MMA(0, 1, At, B1); PG8_BAR; PG8_SCHED;
            PG8_LDA(At, 0, 1); PG8_STAGE(PG8_SB(0, 0), b2, voffB); PG8_STAGE(PG8_SB(0, 1), b2 + hstep, voffB); PG8_STAGE(PG8_SA(0, 0), a2, voffA);
            PG8_WAIT_V(8); PG8_WAIT_L(0); PG8_BAR; PG8_MMA(1, 0, At, B0); PG8_MMA(1, 1, At, B1); PG8_BAR; PG8_SCHED;
            PG8_LDB(B0, 1, 0); PG8_LDB(B1, 1, 1); PG8_SCHED; PG8_LDA(At, 1, 0); PG8_STAGE(PG8_SA(0, 1), a2 + hstep, voffA);
            PG8_WAIT_V(8); PG8_WAIT_L(0); PG8_BAR; PG8_MMA(0, 0, At, B0); PG8_MMA(0, 1, At, B1); PG8_BAR; PG8_SCHED;
            PG8_LDA(At, 1, 1); PG8_STAGE(PG8_SB(1, 0), b3, voffB); PG8_STAGE(PG8_SB(1, 1), b3 + hstep, voffB); PG8_STAGE(PG8_SA(1, 0), a3, voffA);
            PG8_WAIT_V(8); PG8_WAIT_L(0); PG8_BAR; PG8_MMA(1, 0, At, B0); PG8_MMA(1, 1, At, B1); PG8_BAR; PG8_SCHED;
            } else {
            PG8_LDB(B0, 0, 0); PG8_SCHED; PG8_LDA(At, 0, 0); PG8_STAGE(PG8_SA(1, 1), a1 + hstep, voffA);
            PG8_WAIT_L(8); PG8_BAR; PG8_WAIT_L(0); PG8_MMA(0, 0, At, B0); PG8_BAR; PG8_SCHED;
            PG8_LDB(B1, 0, 1); PG8_STAGE(PG8_SB(0, 0), b2, voffB);
            PG8_BAR; PG8_WAIT_L(0); PG8_MMA(0, 1, At, B1); PG8_BAR;
            PG8_LDA(At, 0, 1); PG8_STAGE(PG8_SA(0, 0), a2, voffA);
            PG8_BAR; PG8_WAIT_L(0); PG8_MMA(1, 0, At, B0); PG8_BAR; PG8_SCHED;
            PG8_STAGE(PG8_SB(0, 1), b2 + hstep, voffB);
            PG8_WAIT_V(6); PG8_BAR; PG8_MMA(1, 1, At, B1); PG8_BAR;
            PG8_LDB(B0, 1, 0); PG8_SCHED; PG8_LDA(At, 1, 0); PG8_STAGE(PG8_SA(0, 1), a2 + hstep, voffA);
            PG8_WAIT_L(8); PG8_BAR; PG8_WAIT_L(0); PG8_MMA(0, 0, At, B0); PG8_BAR; PG8_SCHED;
            PG8_LDB(B1, 1, 1); PG8_STAGE(PG8_SB(1, 0), b3, voffB);
            PG8_BAR; PG8_WAIT_L(0); PG8_MMA(0, 1, At, B1); PG8_BAR;
            PG8_LDA(At, 1, 1); PG8_STAGE(PG8_SA(1, 0), a3, voffA);
            PG8_BAR; PG8_WAIT_L(0); PG8_MMA(1, 0, At, B0); PG8_BAR; PG8_SCHED;
            PG8_STAGE(PG8_SB(1, 1), b3 + hstep, voffB);
            PG8_WAIT_V(6); PG8_BAR; PG8_MMA(1, 1, At, B1); PG8_BAR;
            }
        }
        if constexpr (ALIGN_EPI) { if (wr == 0) PG8_BAR; }
        if constexpr (!Epi::AFTER_DRAIN) { E(acc, cur, wr, wc, fr, fq); S.done(cur); }
        if (!has_next) break;
        if constexpr (Epi::INIT) E.init(acc, nxt, wr, wc, fr, fq);
        else {
#pragma unroll
        for (int a = 0; a < 2; ++a)
#pragma unroll
            for (int b = 0; b < 2; ++b)
#pragma unroll
                for (int m = 0; m < 4; ++m)
#pragma unroll
                    for (int n = 0; n < 2; ++n) acc[a][b][m][n] = (f32x4){0.f, 0.f, 0.f, 0.f};
        }
        cur = nxt; cA = nA; cB = nB; ++ui;
        if constexpr (ALIGN_EPI) { if (wr == 1) PG8_BAR; }
    }
    PG8_WAIT_V(0);
    if constexpr (!ALIGN_EPI) { if (wr == 0) PG8_BAR; }
    PG8_BAR;
    if constexpr (Epi::AFTER_DRAIN) { E.fused(acc, cur, wr, wc, fr, fq, lds, wid, lane); S.done(cur); }
#undef PG8_SA
#undef PG8_SB
#undef PG8_STAGE
#undef PG8_LDA
#undef PG8_LDB
#undef PG8_MMA
#undef PG8_WAIT_V
#undef PG8_WAIT_L
#undef PG8_BAR
#undef PG8_SCHED
}
}
#define GAS __attribute__((address_space(1)))
#define LAS __attribute__((address_space(3)))
typedef unsigned short bf16;
typedef unsigned v4u __attribute__((ext_vector_type(4)));
typedef float f32x4 __attribute__((ext_vector_type(4)));
typedef short bf16x8 __attribute__((ext_vector_type(8)));
typedef GAS unsigned gu32;
typedef GAS unsigned long long gu64;
#define RLX_AGENT __ATOMIC_RELAXED, __HIP_MEMORY_SCOPE_AGENT
#define LDS_WAIT() asm volatile("s_waitcnt lgkmcnt(0)" ::: "memory")
#define VM_WAIT() asm volatile("s_waitcnt vmcnt(0)" ::: "memory")
__device__ __forceinline__ unsigned long long rt() { return __builtin_amdgcn_s_memrealtime(); }
__device__ __forceinline__ unsigned f2bf(float f) { unsigned u = __builtin_bit_cast(unsigned, f); return (u + 0x7fffu + ((u >> 16) & 1u)) >> 16; }
__device__ __forceinline__ unsigned pk2(float lo, float hi) { return f2bf(lo) | (f2bf(hi) << 16); }

#define XB_TMO      128
#define XB_XCNT(j)  (256  + 64 * (j))
#define XB_XSUB(j)  (1280 + 64 * (j))
#define XB_XGEN(j)  (2304 + 64 * (j))
#define XB_TOP      3328
#define XB_TOPGEN   3392
#define XCD_BAR_WORDS 3456
#define XB_SPIN_CAP (1u << 18)

__device__ __forceinline__ unsigned xb_ld(unsigned* p)              { return __hip_atomic_load(p, __ATOMIC_RELAXED, __HIP_MEMORY_SCOPE_AGENT); }
__device__ __forceinline__ unsigned xb_add(unsigned* p, unsigned v) { return __hip_atomic_fetch_add(p, v, __ATOMIC_RELAXED, __HIP_MEMORY_SCOPE_AGENT); }
__device__ __forceinline__ unsigned xb_xcc_id() { return (unsigned)__builtin_amdgcn_s_getreg((3 << 11) | 20) & 0xFu; }
#define XB_SPIN(cond, bar) do { unsigned _sp = 0; while (cond) { __builtin_amdgcn_s_sleep(1); \
    if ((++_sp & 255u) == 0u) { if (xb_ld(&(bar)[XB_TMO])) break; if (_sp > XB_SPIN_CAP) { atomicAdd(&(bar)[XB_TMO], 1u); break; } } } } while (0)

struct XcdBarrier {
    unsigned* bar; unsigned x;
    volatile LAS unsigned* st;
};

__device__ __forceinline__ XcdBarrier xcd_barrier_post(unsigned* bar, volatile LAS unsigned* st, const bool t0) {
    XcdBarrier b; b.bar = bar; b.x = xb_xcc_id(); b.st = st;
    if (t0) (void)xb_add(&bar[XB_XCNT(b.x)], 1u);
    return b;
}
__device__ __forceinline__ void xcd_barrier_complete(unsigned* bar, unsigned x, unsigned& nloc, unsigned& nx) {
    const unsigned G = gridDim.x * gridDim.y * gridDim.z;
    unsigned sum, cnt, mine, sp = 0u;
    for (;;) {
        sum = 0u; cnt = 0u; mine = 0u;
#pragma unroll
        for (unsigned j = 0; j < 16; ++j) { const unsigned c = xb_ld(&bar[XB_XCNT(j)]); sum += c; cnt += (c > 0u) ? 1u : 0u; mine = (j == x) ? c : mine; }
        if (sum == G) break;
        __builtin_amdgcn_s_sleep(1);
        if ((++sp & 255u) == 0u) { if (xb_ld(&bar[XB_TMO])) break; if (sp > XB_SPIN_CAP) { atomicAdd(&bar[XB_TMO], 1u); break; } }
    }
    nloc = mine > 0u ? mine : 1u; nx = cnt > 0u ? cnt : 1u;
}

__device__ __forceinline__ void xcd_barrier_a() {
    asm volatile("s_waitcnt vmcnt(0)" ::: "memory");
    __syncthreads();
}
__device__ __forceinline__ void xcd_barrier_b(const XcdBarrier& b, const bool t0) {
    if (t0) {
        unsigned* bar = b.bar;
        __builtin_amdgcn_s_waitcnt(0);
        unsigned nloc = b.st[0], nx = b.st[1];
        if (nloc == 0u) { xcd_barrier_complete(bar, b.x, nloc, nx); b.st[0] = nloc; b.st[1] = nx; }
        const unsigned old = xb_add(&bar[XB_XSUB(b.x)], 1u);
        const unsigned gen = old / nloc;
        if (old + 1u == (gen + 1u) * nloc) {
            __builtin_amdgcn_fence(__ATOMIC_RELEASE, "agent");
            asm volatile("s_waitcnt vmcnt(0)" ::: "memory");
            const unsigned og = xb_add(&bar[XB_TOP], 1u);
            const unsigned tg = og / nx;
            if (og + 1u == (tg + 1u) * nx) xb_add(&bar[XB_TOPGEN], 1u);
            else XB_SPIN(xb_ld(&bar[XB_TOPGEN]) == tg, bar);
            __builtin_amdgcn_fence(__ATOMIC_ACQUIRE, "agent");
            xb_add(&bar[XB_XGEN(b.x)], 1u);
            asm volatile("s_waitcnt vmcnt(0)" ::: "memory");
        } else {
            XB_SPIN(xb_ld(&bar[XB_XGEN(b.x)]) == gen, bar);
            __builtin_amdgcn_fence(__ATOMIC_ACQUIRE, "agent");
            asm volatile("s_waitcnt vmcnt(0)" ::: "memory");
        }
    }
    __syncthreads();
}
__device__ __forceinline__ void xcd_barrier(const XcdBarrier& b, const bool t0) { xcd_barrier_a(); xcd_barrier_b(b, t0); }
namespace attn_body {
using bf16=__hip_bfloat16;
using bf16x8=__attribute__((ext_vector_type(8)))short;
using s16x4=__attribute__((ext_vector_type(4)))short;
using f32x16=__attribute__((ext_vector_type(16)))float;
using u32x4=__attribute__((ext_vector_type(4)))unsigned;
constexpr int BATCH=8,NHEAD=16,SEQ=2048,D=64,DM=3072,OPITCH=2048,ZPITCH=1024;
constexpr int NW=8,QBLK=32,QB=QBLK*NW,KVBLK=64,NQB=SEQ/QB;
constexpr int ATTN_PITCH=DM, ATTN_UNIT_ROWS=QB;
__device__ __forceinline__ int crow(int r,int hi){return (r&3)+8*(r>>2)+4*hi;}
#define SBAR() __builtin_amdgcn_sched_barrier(0)
__device__ __forceinline__ void cmask(f32x16&p0,f32x16&p1,int jb,int qrel,int hi){
  const float NEG=-INFINITY; int kb=64*jb+4*hi;
  #pragma unroll
  for(int r=0;r<16;++r){int kv=kb+(r&3)+8*(r>>2); if(kv>qrel)p0[r]=NEG; if(kv+32>qrel)p1[r]=NEG;}
}

constexpr int NSLOT=3, SLOTB=8192;
constexpr int LDS_K=0, LDS_V=NSLOT*SLOTB, LDS_WS=2*NSLOT*SLOTB, LDS_OST=LDS_WS+NW*64*4, LDS_BYTES=LDS_OST+NW*4096;
constexpr float C2=0.125f*1.4426950408889634f;
__device__ __forceinline__ float bflo(unsigned w){return __uint_as_float(w<<16);}
__device__ __forceinline__ float bfhi(unsigned w){return __uint_as_float(w&0xffff0000u);}
__device__ __forceinline__ float bfs(short v){return __uint_as_float(((unsigned)(unsigned short)v)<<16);}
__device__ __forceinline__ void glds16(const void*gsrc,unsigned lds_dst){unsigned keep;
  asm volatile("s_mov_b32 %0, m0\n\ts_mov_b32 m0, %2\n\ts_nop 0\n\tglobal_load_lds_dwordx4 %1, off\n\ts_mov_b32 m0, %0":"=&s"(keep):"v"(gsrc),"s"(lds_dst):"memory");}
__device__ __forceinline__ float max3f(float a,float b,float c){float r;asm("v_max3_f32 %0, %1, %2, %3":"=v"(r):"v"(a),"v"(b),"v"(c));return r;}
__device__ __forceinline__ float max2f(float a,float b){float r;asm("v_max_f32_e32 %0, %1, %2":"=v"(r):"v"(a),"v"(b));return r;}
__device__ __forceinline__ float fadd_s(float a,float b){float r;asm("v_add_f32_e32 %0, %1, %2":"=v"(r):"v"(a),"v"(b));return r;}
__device__ __forceinline__ float fsub_s(float a,float b){float r;asm("v_sub_f32_e32 %0, %1, %2":"=v"(r):"v"(a),"v"(b));return r;}
typedef float f32x2_t __attribute__((ext_vector_type(2))); typedef __bf16 bf16x2_t __attribute__((ext_vector_type(2)));
__device__ __forceinline__ unsigned cvtpk_s(float lo,float hi){f32x2_t v={lo,hi};bf16x2_t b=__builtin_convertvector(v,bf16x2_t);return __builtin_bit_cast(unsigned,b);}
#define WAIT_BAR(N) asm volatile("s_waitcnt vmcnt(" #N ") lgkmcnt(0)\n\ts_barrier":::"memory")

__device__ __forceinline__ void qkt(f32x16&p0,f32x16&p1,const char*Kslot,const bf16x8*qr,const f32x16&negm,int r32,int hi){
  const char*kb=Kslot+hi*1024+r32*16;
  #pragma unroll
  for(int d0=0;d0<4;++d0){
    const bf16x8 b0=*reinterpret_cast<const bf16x8*>(kb+d0*2048);
    const bf16x8 b1=*reinterpret_cast<const bf16x8*>(kb+d0*2048+512);
    if(d0==0){p0=__builtin_amdgcn_mfma_f32_32x32x16_bf16(b0,qr[0],negm,0,0,0);p1=__builtin_amdgcn_mfma_f32_32x32x16_bf16(b1,qr[0],negm,0,0,0);}
    else{p0=__builtin_amdgcn_mfma_f32_32x32x16_bf16(b0,qr[d0],p0,0,0,0);p1=__builtin_amdgcn_mfma_f32_32x32x16_bf16(b1,qr[d0],p1,0,0,0);}}
}
typedef __attribute__((address_space(3))) const char* lds_cptr;
typedef short v4i16_t __attribute__((ext_vector_type(4)));
__device__ __forceinline__ void kload8(bf16x8*kf,lds_cptr kp){
  kf[0]=*(const __attribute__((address_space(3))) bf16x8*)(kp);      kf[1]=*(const __attribute__((address_space(3))) bf16x8*)(kp+512);
  kf[2]=*(const __attribute__((address_space(3))) bf16x8*)(kp+2048); kf[3]=*(const __attribute__((address_space(3))) bf16x8*)(kp+2560);
  kf[4]=*(const __attribute__((address_space(3))) bf16x8*)(kp+4096); kf[5]=*(const __attribute__((address_space(3))) bf16x8*)(kp+4608);
  kf[6]=*(const __attribute__((address_space(3))) bf16x8*)(kp+6144); kf[7]=*(const __attribute__((address_space(3))) bf16x8*)(kp+6656);
}
__device__ __forceinline__ void kload2(bf16x8*kf,lds_cptr kp,int j){ kf[2*j]=*(const __attribute__((address_space(3))) bf16x8*)(kp+j*2048); kf[2*j+1]=*(const __attribute__((address_space(3))) bf16x8*)(kp+j*2048+512); }
__device__ __forceinline__ s16x4 vtr(lds_cptr p){ return __builtin_bit_cast(s16x4,__builtin_amdgcn_ds_read_tr16_b64_v4i16((__attribute__((address_space(3))) v4i16_t*)p)); }
__device__ __forceinline__ float rowmax(const f32x16&p0,const f32x16&p1){
  float a=max3f(p0[0],p0[1],p1[0]),b=max3f(p0[2],p0[3],p1[1]);a=max3f(a,p1[2],p1[3]);
  #pragma unroll
  for(int r=4;r<16;r+=4){a=max3f(a,p0[r],p0[r+1]);b=max3f(b,p0[r+2],p0[r+3]);a=max3f(a,p1[r],p1[r+1]);b=max3f(b,p1[r+2],p1[r+3]);}
  const float m=max2f(a,b);
  auto rr=__builtin_amdgcn_permlane32_swap(__float_as_uint(m),__float_as_uint(m),false,false);
  return max2f(__uint_as_float(rr[0]),__uint_as_float(rr[1]));
}
__device__ __forceinline__ void pv(f32x16*o,int vb,bf16x8 pa0,bf16x8 pa1,bf16x8 pa2,bf16x8 pa3){
  #pragma unroll
  for(int d0=0;d0<2;++d0){s16x4 lo[4],hi[4];
    #pragma unroll
    for(int ks=0;ks<4;++ks){
      asm volatile("ds_read_b64_tr_b16 %0,%1 offset:%c2":"=&v"(lo[ks]):"v"(vb),"i"(d0*4096+ks*1024):"memory");
      asm volatile("ds_read_b64_tr_b16 %0,%1 offset:%c2":"=&v"(hi[ks]):"v"(vb),"i"(d0*4096+ks*1024+512):"memory");}
    asm volatile("s_waitcnt lgkmcnt(0)":::"memory");SBAR();
    #define PK(k) (bf16x8){lo[k][0],lo[k][1],lo[k][2],lo[k][3],hi[k][0],hi[k][1],hi[k][2],hi[k][3]}
    o[d0]=__builtin_amdgcn_mfma_f32_32x32x16_bf16(pa0,PK(0),o[d0],0,0,0);
    o[d0]=__builtin_amdgcn_mfma_f32_32x32x16_bf16(pa1,PK(1),o[d0],0,0,0);
    o[d0]=__builtin_amdgcn_mfma_f32_32x32x16_bf16(pa2,PK(2),o[d0],0,0,0);
    o[d0]=__builtin_amdgcn_mfma_f32_32x32x16_bf16(pa3,PK(3),o[d0],0,0,0);
    #undef PK
  }
}

#ifndef ATTN_STORE16
#define ATTN_STORE16(p,v) (*(u32x4*)(p)=(v))
#endif
template<int THRL> __device__ __forceinline__ void attn_unit(int b,int h,int qb,const bf16*Q,const bf16*__restrict__ K,const bf16*__restrict__ V,bf16*O,const bf16*__restrict__ ZB,const float*__restrict__ KMEAN,char*shm,const int wave_id){
  const int wid=__builtin_amdgcn_readfirstlane(wave_id); const int lane=mk_lane_id(),tid=wid*64+lane,r32=lane&31,hi=lane>>5; (void)tid;
  const long rowbase=(long)b*SEQ; const int q0=qb*QB;
  const bf16*Qw=Q+(rowbase+q0+wid*QBLK)*DM+h*D;
  const bf16*Kh=K+rowbase*DM+h*D,*Vh=V+rowbase*DM+h*D;
  const unsigned lds0=(unsigned)(uintptr_t)shm;
  float*wsf=(float*)(shm+LDS_WS)+wid*64;
  const bf16*ksrc=Kh+(long)lane*DM+wid*8;
  const bf16*vsrc=Vh+(long)(16*(wid&3)+(lane>>2))*DM+(wid>>2)*32+(lane&3)*8;
  const unsigned kdst=lds0+LDS_K+wid*1024, vdst=lds0+LDS_V+wid*1024;
  #define TROW(t) (((t)<4)?(q0+64*(t)):(64*((t)-4)))
  #define DMA_K(t,slot) glds16(ksrc+(long)TROW(t)*DM,(unsigned)__builtin_amdgcn_readfirstlane(kdst+(slot)))
  #define DMA_V(t,slot) glds16(vsrc+(long)TROW(t)*DM,(unsigned)__builtin_amdgcn_readfirstlane(vdst+(slot)))
  const int vb0=(int)(lds0+LDS_V)+((lane>>4)&1)*32+(lane&3)*8+(4*hi+((lane&15)>>2))*64;
  const char*Kbase=shm+LDS_K; bf16x8 kf[8];
  const lds_cptr shm3=(lds_cptr)shm; const lds_cptr kp0=shm3+LDS_K+hi*1024+r32*16; const lds_cptr vp0=shm3+LDS_V+((lane>>4)&1)*32+(lane&3)*8+(4*hi+((lane&15)>>2))*64;
  const int NT=(q0+QB)/KVBLK;
  DMA_K(0,0);DMA_V(0,0);DMA_K(1,SLOTB);
  bf16x8 qr[4];
  #pragma unroll
  for(int d0=0;d0<4;++d0)qr[d0]=*reinterpret_cast<const bf16x8*>(&Qw[(long)r32*DM+d0*16+hi*8]);
  float mhat=0.f,l_reg=0.f;f32x16 o[2];o[0]=f32x16{};o[1]=f32x16{};f32x16 negm=f32x16{};asm volatile("":"+v"(negm));
  const int qrel=wid*QBLK+r32;
  unsigned selm=(1u<<qb)-1u;
  if(qb>3){ float g[7];
    #pragma unroll
    for(int n=0;n<7;++n){ g[n]=-INFINITY; if(n<qb){ const float*km=KMEAN+(((long)b*NHEAD+h)*8+n)*64+hi*8; float acc_=0.f;
        #pragma unroll
        for(int d0=0;d0<4;++d0){ const float4 k0=*reinterpret_cast<const float4*>(km+d0*16), k1=*reinterpret_cast<const float4*>(km+d0*16+4); const bf16x8 qv_=qr[d0];
          acc_+=bfs(qv_[0])*k0.x+bfs(qv_[1])*k0.y+bfs(qv_[2])*k0.z+bfs(qv_[3])*k0.w+bfs(qv_[4])*k1.x+bfs(qv_[5])*k1.y+bfs(qv_[6])*k1.z+bfs(qv_[7])*k1.w; }
        auto rr=__builtin_amdgcn_permlane32_swap(__float_as_uint(acc_),__float_as_uint(acc_),false,false); g[n]=__uint_as_float(rr[0])+__uint_as_float(rr[1]); } }
    selm=0u;
    #pragma unroll
    for(int n=0;n<7;++n){ int rank=0;
      #pragma unroll
      for(int m_=0;m_<7;++m_) if(m_!=n) rank+=(g[m_]>g[n]||(g[m_]==g[n]&&m_<n))?1:0;
      if(n<qb&&rank<3) selm|=1u<<n; } }
  #define CMASK(P0,P1,t) do{int jb_=(t); if(jb_<4)cmask(P0,P1,jb_,qrel,hi);}while(0)
  bool resc=false;
  #define START(P0,P1) do{ const float rm=rowmax(P0,P1); resc=false; \
    { const float dl=rm; mhat=fadd_s(mhat,dl); \
      _Pragma("unroll") for(int r=0;r<16;++r){P0[r]=fsub_s(P0[r],dl);P1[r]=fsub_s(P1[r],dl);} \
      _Pragma("unroll") for(int r=0;r<16;++r)negm[r]=-mhat; asm volatile("":"+v"(negm)); } \
    _Pragma("unroll") for(int r=0;r<16;++r)P0[r]=__builtin_amdgcn_exp2f(P0[r]); }while(0)
  #define RESC() do{ if(resc){ asm volatile("s_waitcnt lgkmcnt(0)":::"memory"); \
      _Pragma("unroll") for(int d_=0;d_<2;++d_) _Pragma("unroll") for(int r=0;r<16;++r)o[d_][r]*=wsf[crow(r,hi)]; } }while(0)
  f32x16 pA0,pA1,pB0,pB1;
  int sl_prev=0,sl_cur=0,sl_next=SLOTB;
  #define ROT() do{sl_prev=sl_cur;sl_cur=sl_next;sl_next=(sl_next==(NSLOT-1)*SLOTB)?0:sl_next+SLOTB;}while(0)
  DMA_K(2,2*SLOTB);
  WAIT_BAR(3);
  qkt(pA0,pA1,Kbase,qr,negm,r32,hi);asm volatile("s_nop 15\n\ts_nop 7":"+v"(pA0),"+v"(pA1));CMASK(pA0,pA1,0);
  START(pA0,pA1);
  _Pragma("unroll") for(int r=0;r<16;++r)pA1[r]=__builtin_amdgcn_exp2f(pA1[r]);
  WAIT_BAR(0);
  DMA_K(3,0);DMA_V(1,SLOTB);
  ROT();
  kload8(kf,kp0+sl_cur);
  WAIT_BAR(2);
  s16x4 vlo[8],vhi[8]; u32x4 pw0,pw1,pw2,pw3;
  #define PKW(P,B) cvtpk_s(P[B],P[B+1])
  #define PAF(k) __builtin_bit_cast(bf16x8,pw##k)
  #define VFR(i) (bf16x8){vlo[i][0],vlo[i][1],vlo[i][2],vlo[i][3],vhi[i][0],vhi[i][1],vhi[i][2],vhi[i][3]}
  #define PIN(x) asm volatile("":"+v"(x))
  #define MX3(a,b,c) __builtin_fmaxf(__builtin_fmaxf((a),(b)),(c))
  #define GAPA(MF,A0,A1,A2,A3,W0,W1,PW) do{ MF; sacc+=A0; sacc+=A1; sacc+=A2; sacc+=A3; PIN(sacc); W0; W1; PIN(PW); SBAR(); }while(0)
  #define EX(v) __builtin_amdgcn_exp2f(v)
  #define GAPB(MF,X,B) do{ MF; X[B]=EX(X[B]); X[B+1]=EX(X[B+1]); X[B+2]=EX(X[B+2]); X[B+3]=EX(X[B+3]); PIN(X); SBAR(); }while(0)
  #define VRD(i) do{ vlo[i]=vtr(vp_+(((i)>>2)*4096+((i)&3)*1024)); vhi[i]=vtr(vp_+(((i)>>2)*4096+((i)&3)*1024+512)); }while(0)
  #define KRD(G,j) do{ if(G){ kload2(kf,kp0+sl_next,j); SBAR(); } }while(0)
  #define STEP(C0,C1,P0,P1,t,GK,GV,GL) do{ SBAR(); \
    { const float ci_=(((t)<4)||((selm>>(((t)-4)>>2))&1u))?-mhat:-INFINITY; _Pragma("unroll") for(int r=0;r<16;++r)negm[r]=ci_; asm volatile("":"+v"(negm)); } SBAR(); \
    const lds_cptr vp_=vp0+sl_prev; \
    VRD(0); SBAR(); float sacc=(P0[0]+P0[1]); \
    GAPA(C0=__builtin_amdgcn_mfma_f32_32x32x16_bf16(kf[0],qr[0],negm,0,0,0), P0[2],P0[3],P0[4],P0[5],     pw0[0]=PKW(P0,0), pw0[1]=PKW(P0,2), pw0); \
    VRD(4); SBAR(); GAPA(C1=__builtin_amdgcn_mfma_f32_32x32x16_bf16(kf[1],qr[0],negm,0,0,0), P0[6],P0[7],P0[8],P0[9],     pw0[2]=PKW(P0,4), pw0[3]=PKW(P0,6), pw0); \
    VRD(1); SBAR(); GAPA(C0=__builtin_amdgcn_mfma_f32_32x32x16_bf16(kf[2],qr[1],C0,0,0,0),   P0[10],P0[11],P0[12],P0[13], pw1[0]=PKW(P0,8), pw1[1]=PKW(P0,10), pw1); \
    VRD(5); SBAR(); GAPA(C1=__builtin_amdgcn_mfma_f32_32x32x16_bf16(kf[3],qr[1],C1,0,0,0),   P0[14],P0[15],P1[0],P1[1],   pw1[2]=PKW(P0,12),pw1[3]=PKW(P0,14), pw1); \
    VRD(2); SBAR(); GAPA(C0=__builtin_amdgcn_mfma_f32_32x32x16_bf16(kf[4],qr[2],C0,0,0,0),   P1[2],P1[3],P1[4],P1[5],     pw2[0]=PKW(P1,0), pw2[1]=PKW(P1,2), pw2); \
    VRD(6); SBAR(); GAPA(C1=__builtin_amdgcn_mfma_f32_32x32x16_bf16(kf[5],qr[2],C1,0,0,0),   P1[6],P1[7],P1[8],P1[9],     pw2[2]=PKW(P1,4), pw2[3]=PKW(P1,6), pw2); \
    VRD(3); SBAR(); GAPA(C0=__builtin_amdgcn_mfma_f32_32x32x16_bf16(kf[6],qr[3],C0,0,0,0),   P1[10],P1[11],P1[12],P1[13], pw3[0]=PKW(P1,8), pw3[1]=PKW(P1,10), pw3); \
    VRD(7); SBAR(); GAPA(C1=__builtin_amdgcn_mfma_f32_32x32x16_bf16(kf[7],qr[3],C1,0,0,0),   P1[14],P1[15],0.f,0.f,       pw3[2]=PKW(P1,12),pw3[3]=PKW(P1,14), pw3); \
    l_reg+=sacc; \
    if(GK){DMA_K((t)+3,sl_cur);} if(GV){DMA_V((t)+1,sl_next);} \
    CMASK(C0,C1,t); \
    { float a=MX3(C0[0],C0[1],C1[0]),b=MX3(C0[2],C0[3],C1[1]); a=MX3(a,C1[2],C1[3]); \
      _Pragma("unroll") for(int r=4;r<16;r+=4){a=MX3(a,C0[r],C0[r+1]);b=MX3(b,C0[r+2],C0[r+3]);a=MX3(a,C1[r],C1[r+1]);b=MX3(b,C1[r+2],C1[r+3]);} \
      float rm=__builtin_fmaxf(a,b); { auto rr=__builtin_amdgcn_permlane32_swap(__float_as_uint(rm),__float_as_uint(rm),false,false); rm=__builtin_fmaxf(__uint_as_float(rr[0]),__uint_as_float(rr[1])); } \
      resc=false; \
      if(__builtin_expect(__any(rm>(float)THRL),0)){ const float dl=__builtin_fmaxf(rm,0.f); mhat+=dl; \
        _Pragma("unroll") for(int r=0;r<16;++r){C0[r]-=dl;C1[r]-=dl;} \
        _Pragma("unroll") for(int r=0;r<16;++r)negm[r]=-mhat; asm volatile("":"+v"(negm)); \
        const float f=__builtin_amdgcn_exp2f(-dl); l_reg*=f; if(hi==0)wsf[r32]=f; resc=true; } } \
    SBAR(); \
    GAPB(o[0]=__builtin_amdgcn_mfma_f32_32x32x16_bf16(PAF(0),VFR(0),o[0],0,0,0), C0,0); \
    GAPB(o[1]=__builtin_amdgcn_mfma_f32_32x32x16_bf16(PAF(0),VFR(4),o[1],0,0,0), C0,4); \
    KRD(GL,0); GAPB(o[0]=__builtin_amdgcn_mfma_f32_32x32x16_bf16(PAF(1),VFR(1),o[0],0,0,0), C0,8); \
    KRD(GL,1); GAPB(o[1]=__builtin_amdgcn_mfma_f32_32x32x16_bf16(PAF(1),VFR(5),o[1],0,0,0), C0,12); \
    KRD(GL,2); GAPB(o[0]=__builtin_amdgcn_mfma_f32_32x32x16_bf16(PAF(2),VFR(2),o[0],0,0,0), C1,0); \
    KRD(GL,3); GAPB(o[1]=__builtin_amdgcn_mfma_f32_32x32x16_bf16(PAF(2),VFR(6),o[1],0,0,0), C1,4); \
    GAPB(o[0]=__builtin_amdgcn_mfma_f32_32x32x16_bf16(PAF(3),VFR(3),o[0],0,0,0), C1,8); \
    GAPB(o[1]=__builtin_amdgcn_mfma_f32_32x32x16_bf16(PAF(3),VFR(7),o[1],0,0,0), C1,12); \
    }while(0)
  int t=1;
  #define ENDW(tt) do{ if((tt)+3<NT){WAIT_BAR(2);} else if((tt)+2<NT){WAIT_BAR(1);} else {WAIT_BAR(0);} }while(0)
  for(;t+1<NT;t+=2){
    STEP(pB0,pB1,pA0,pA1,t,(t+3<NT),(t+1<NT),(t+1<NT));       ENDW(t);   RESC(); ROT();
    STEP(pA0,pA1,pB0,pB1,t+1,(t+4<NT),(t+2<NT),(t+2<NT));     ENDW(t+1); RESC(); ROT();
  }
  STEP(pB0,pB1,pA0,pA1,NT-1,false,false,false); RESC();
  { float sacc=pB0[0]+pB0[1]; _Pragma("unroll") for(int r=2;r<16;++r)sacc+=pB0[r]; _Pragma("unroll") for(int r=0;r<16;++r)sacc+=pB1[r]; l_reg+=sacc;
    pw0=(u32x4){PKW(pB0,0),PKW(pB0,2),PKW(pB0,4),PKW(pB0,6)};pw1=(u32x4){PKW(pB0,8),PKW(pB0,10),PKW(pB0,12),PKW(pB0,14)};pw2=(u32x4){PKW(pB1,0),PKW(pB1,2),PKW(pB1,4),PKW(pB1,6)};pw3=(u32x4){PKW(pB1,8),PKW(pB1,10),PKW(pB1,12),PKW(pB1,14)};
    SBAR(); pv(o,vb0+sl_cur,PAF(0),PAF(1),PAF(2),PAF(3)); }
  #undef PKW
  #undef PAF
  #undef VFR
  #undef PIN
  #undef MX3
  #undef GAPA
  #undef GAPB
  #undef EX
  #undef VRD
  #undef KRD
  #undef STEP
  #undef ENDW
  {auto rr=__builtin_amdgcn_permlane32_swap(__float_as_uint(l_reg),__float_as_uint(l_reg),false,false);l_reg=__uint_as_float(rr[0])+__uint_as_float(rr[1]);}
  if(hi==0)wsf[32+r32]=l_reg;asm volatile("s_waitcnt lgkmcnt(0)":::"memory");
  float rli[16];
  #pragma unroll
  for(int r=0;r<16;++r)rli[r]=__builtin_amdgcn_rcpf(wsf[32+crow(r,hi)]);
  bf16*Ow=O+(rowbase+q0+wid*QBLK)*OPITCH+h*D; const bf16*Zw=ZB+(rowbase+q0+wid*QBLK)*ZPITCH+h*D;
  { bf16*stg=(bf16*)(shm+LDS_OST)+wid*2048;
    #pragma unroll
    for(int r=0;r<16;++r){const int orow=crow(r,hi);
      #pragma unroll
      for(int d0=0;d0<2;++d0)stg[orow*64+d0*32+r32]=__float2bfloat16(o[d0][r]*rli[r]);}
    asm volatile("s_waitcnt lgkmcnt(0)":::"memory");
    #pragma unroll
    for(int i=0;i<4;++i){const int row=i*8+(lane>>3),ch=lane&7; const u32x4 v=*(const u32x4*)(stg+row*64+ch*8); const u32x4 z=*(const u32x4*)(Zw+(long)row*ZPITCH+ch*8); u32x4 w;
      w.x=cvtpk_s(bflo(v.x)*bflo(z.x),bfhi(v.x)*bfhi(z.x)); w.y=cvtpk_s(bflo(v.y)*bflo(z.y),bfhi(v.y)*bfhi(z.y)); w.z=cvtpk_s(bflo(v.z)*bflo(z.z),bfhi(v.z)*bfhi(z.z)); w.w=cvtpk_s(bflo(v.w)*bflo(z.w),bfhi(v.w)*bfhi(z.w));
      ATTN_STORE16(Ow+(long)row*OPITCH+ch*8,w);} }
  asm volatile("s_waitcnt lgkmcnt(0)\n\ts_barrier":::"memory");
  #undef DMA_K
  #undef DMA_V
  #undef CMASK
  #undef START
  #undef RESC
  #undef ROT
}
constexpr int ATTN_LDS_BYTES=LDS_BYTES;
struct AttnTensors { const bf16* Q; const bf16* K; const bf16* V; bf16* O; const bf16* ZB; const float* KMEAN; };
struct AttnUnit { int bh; int qb; };
struct StaticOrder {
  int vcu, G;
  __device__ __forceinline__ explicit StaticOrder(int grid,int block):vcu((grid%8==0)?(block%8)*(grid/8)+block/8:block),G(grid){}
  __device__ __forceinline__ StaticOrder(int ncu,int v,int):vcu(v),G(ncu){}
  __device__ __forceinline__ bool next(int i,AttnUnit&u)const{ const int pi=(i>>1)*G+vcu; if(pi>=BATCH*NHEAD*4)return false; u.bh=pi>>2; const int p=pi&3; u.qb=(i&1)?p:7-p; return true; }
  __device__ __forceinline__ void a_ready(const AttnUnit&)const{}
  __device__ __forceinline__ void done(const AttnUnit&)const{}
};
struct MobaOrder {
  int c,G; bool shift16; int give;
  __device__ __forceinline__ bool own(int ii,int cc,AttnUnit&u)const{ const int r=ii>>1,q=r*G+cc; if(q>=BATCH*NHEAD*4)return false; const int p=(G&3)?(q&3):(((q&3)+r)&3); u.bh=q>>2; u.qb=(ii&1)?p:7-p; return true; }
  __device__ __forceinline__ int slot_of(int cc,int qb)const{ const int p=qb<4?qb:7-qb; return 2*((p-(cc&3))&3)+(qb<4?1:0); }
  __device__ __forceinline__ bool next(int i,AttnUnit&u)const{
    if(!shift16&&give<=0) return own(i,c,u);
    const bool lite=shift16&&(c&31)<16; const int s2=lite?slot_of(c,2):-1;
    int k=i; for(int ii=0;ii<8;++ii){ AttnUnit t; own(ii,c,t); if(ii==s2||((give>>t.qb)&1))continue; if(k==0){u=t;return t.bh<BATCH*NHEAD;} --k; }
    if(shift16&&!lite&&k==0) return own(slot_of(c-16,2),c-16,u);
    return false; }
  __device__ __forceinline__ void a_ready(const AttnUnit&)const{}
  __device__ __forceinline__ void done(const AttnUnit&)const{}
};
template<class Sched,int THRL=8> __device__ __forceinline__ void attn_phase(char*lds,const AttnTensors&T,const Sched&S,const int wave_id){
  AttnUnit u;
  for(int i=0;S.next(i,u);++i){ S.a_ready(u); attn_unit<THRL>(u.bh/NHEAD,u.bh%NHEAD,u.qb,T.Q,T.K,T.V,T.O,T.ZB,T.KMEAN,lds,wave_id); S.done(u); }
}
#undef SBAR
#undef WAIT_BAR
}
constexpr int NWAVES = 8;
#ifndef MK_TS
#define MK_TS 0
#endif
#ifndef MK_ALIGN34
#define MK_ALIGN34 true
#endif
constexpr int CW_TS = 12288;
#ifndef MK_N_LAUNCHES
#define MK_N_LAUNCHES 0
#endif
constexpr int BATCH = 8, SEQ = 2048, DM = 2048, T = BATCH * SEQ, NH = 16, HD = 64, WID = 1024;
constexpr int NIN = 12544;
constexpr float RMS_EPS = 1e-6f, GN_EPS = 64e-5f, QSCALE = 0.125f * 1.4426950408889634f;
constexpr size_t MiB = 1u << 20;
constexpr size_t WS_CTL = 0, CTL_ZERO_BYTES = 64 * 1024;
constexpr size_t WS_KMEAN = 1 * MiB;
constexpr size_t WS_WINT = 2 * MiB;
constexpr size_t WS_WMT = 52 * MiB, WS_WOT = 60 * MiB;
constexpr size_t WS_XN = 68 * MiB;
constexpr size_t WS_MERGED = 68 * MiB;
constexpr size_t WS_RKV = 132 * MiB;
constexpr size_t WS_Y = 392 * MiB;
constexpr size_t WS_ZA = 228 * MiB, WS_QKVB = 260 * MiB, WS_ZB = 356 * MiB, WS_LORA = 388 * MiB;
constexpr size_t WS_END = 456 * MiB;
constexpr int CW_BAR = 4096, CW_SUB = 14336;
constexpr int RING_BYTES = 131072, LDSCTL_OFF = 143360, MISC_OFF = LDSCTL_OFF + 320, LDS_BYTES = 147456;

__device__ __forceinline__ float bf2f(bf16 v) { return __builtin_bit_cast(float, (unsigned)v << 16); }
__device__ __forceinline__ float blo(unsigned w) { return __builtin_bit_cast(float, w << 16); }
__device__ __forceinline__ float bhi(unsigned w) { return __builtin_bit_cast(float, w & 0xffff0000u); }
__device__ __forceinline__ void unpack8(const v4u w, float* f) { f[0] = blo(w.x); f[1] = bhi(w.x); f[2] = blo(w.y); f[3] = bhi(w.y); f[4] = blo(w.z); f[5] = bhi(w.z); f[6] = blo(w.w); f[7] = bhi(w.w); }
__device__ __forceinline__ v4u pack8(const float* f) { v4u w; w.x = pk2(f[0], f[1]); w.y = pk2(f[2], f[3]); w.z = pk2(f[4], f[5]); w.w = pk2(f[6], f[7]); return w; }
__device__ __forceinline__ float wave_sum(float v) {
#pragma unroll
    for (int o = 1; o < 64; o <<= 1) v += __shfl_xor(v, o);
    return v;
}
__device__ __forceinline__ float wave_max(float v) {
#pragma unroll
    for (int o = 1; o < 64; o <<= 1) v = fmaxf(v, __shfl_xor(v, o));
    return v;
}
__device__ __forceinline__ float dpp_f(float x, int ctrl_unused) { return x; }
#define DPP_ADD(x, CTRL) ((x) + __builtin_bit_cast(float, __builtin_amdgcn_update_dpp(0, __builtin_bit_cast(int, (x)), (CTRL), 0xF, 0xF, true)))
__device__ __forceinline__ float red8(float x) {
    x = DPP_ADD(x, 0xB1);
    x = DPP_ADD(x, 0x4E);
    x = DPP_ADD(x, 0x141);
    return x;
}

struct Frame {
    LAS unsigned char* lds; volatile LAS unsigned* MISC; gu32* ctl;
    int tid, lane, wave, vcu, G;
    const float* in[22]; float* out; unsigned char* ws;
};
#define IN_X 0
#define IN_NORMW 1
#define IN_WIN 2
#define IN_MUR 3
#define IN_MUK 4
#define IN_MUV 5
#define IN_MUW 6
#define IN_MUA 7
#define IN_W0 8
#define IN_WDUP 9
#define IN_A0 10
#define IN_WAUP 11
#define IN_KK 12
#define IN_KA 13
#define IN_RK 14
#define IN_GNW 15
#define IN_GNB 16
#define IN_QNW 17
#define IN_KNW 18
#define IN_WPR 19
#define IN_WPM 20
#define IN_WOUT 21

__device__ __forceinline__ void transpose_item(const float* W, int ldw, int k0, int srcn0, bf16* WT, int K, int dstn0, LAS float* scr, int lane) {
    if (srcn0 >= 0) {
        float t[32]; const float* wp = W + (size_t)(k0 + (lane >> 5)) * ldw + srcn0 + (lane & 31);
#pragma unroll
        for (int i = 0; i < 32; ++i) t[i] = wp[(size_t)(2 * i) * ldw];
#pragma unroll
        for (int i = 0; i < 32; ++i) scr[(2 * i + (lane >> 5)) * 33 + (lane & 31)] = t[i];
    } else {
#pragma unroll 8
        for (int i = 0; i < 32; ++i) { const int kk = 2 * i + (lane >> 5); scr[kk * 33 + (lane & 31)] = 0.f; }
    }
    LDS_WAIT(); asm volatile("" ::: "memory");
    const int c = lane & 7;
#pragma unroll
    for (int j = 0; j < 4; ++j) { const int n = (lane >> 3) + 8 * j; const LAS float* s = scr + (8 * c) * 33 + n;
        v4u o; o.x = pk2(s[0 * 33], s[1 * 33]); o.y = pk2(s[2 * 33], s[3 * 33]); o.z = pk2(s[4 * 33], s[5 * 33]); o.w = pk2(s[6 * 33], s[7 * 33]);
        *(GAS v4u*)(WT + (size_t)(dstn0 + n) * K + k0 + 8 * c) = o; }
    LDS_WAIT(); asm volatile("" ::: "memory");
}
__device__ __forceinline__ int win_src_col(int d) { if (d >= 4096 && d < 6144) { const int i = d & 255; return 4224 + ((d - 4096) & ~255) + 64 * ((i >> 5) & 3) + 32 * (i >> 7) + (i & 31); }
    if (d >= 8192 && d < 12288) { const int j = (d - 8192) >> 8, o = d & 255; return 8320 + (o >> 7) * 2048 + 128 * j + (o & 127); }
    return d < 4096 ? d : d < 8192 ? 4224 + (d - 4096) : d < 12416 ? 4096 + (d - 12288) : -1; }
__device__ __forceinline__ void rms_row_to_bf16(Frame& F, const float* xrow, const float* g, bf16* orow) {
    const GAS f32x4* xr = (const GAS f32x4*)xrow + F.lane; const GAS f32x4* gr = (const GAS f32x4*)g + F.lane;
    f32x4 v[8]; float s = 0.f;
#pragma unroll
    for (int j = 0; j < 8; ++j) { v[j] = xr[64 * j]; s += (v[j].x * v[j].x + v[j].y * v[j].y) + (v[j].z * v[j].z + v[j].w * v[j].w); }
    const float rstd = 1.f / sqrtf(wave_sum(s) * (1.f / DM) + RMS_EPS);
    GAS unsigned long long* o8 = (GAS unsigned long long*)orow + F.lane;
#pragma unroll
    for (int j = 0; j < 8; ++j) { const f32x4 gg = gr[64 * j]; o8[64 * j] = (unsigned long long)pk2(v[j].x * rstd * gg.x, v[j].y * rstd * gg.y) | ((unsigned long long)pk2(v[j].z * rstd * gg.z, v[j].w * rstd * gg.w) << 32); }
}
__device__ __forceinline__ void p0_prologue(Frame& F) {
    LAS float* scr = (LAS float*)(F.lds + F.wave * 16384);
    const int gw = F.vcu * NWAVES + F.wave, NGW = F.G * NWAVES;
    bf16* WINT = (bf16*)(F.ws + WS_WINT);
    constexpr int I_IN = (DM / 64) * (NIN / 32);
    bf16* XN = (bf16*)(F.ws + WS_XN);
    { GAS f32x4* km = (GAS f32x4*)(F.ws + WS_KMEAN); for (int e = gw * 64 + F.lane; e < BATCH * NH * 8 * 64 / 4; e += NGW * 64) km[e] = (f32x4){0.f, 0.f, 0.f, 0.f}; }
    const bool rows_first = (F.wave & 1) != 0;
#pragma unroll 1
    for (int pass = 0; pass < 2; ++pass) {
        if ((pass == 0) == rows_first) { for (int m = gw; m < T; m += NGW) rms_row_to_bf16(F, F.in[IN_X] + (size_t)m * DM, F.in[IN_NORMW], XN + (size_t)m * DM); }
        else { for (int it = gw; it < I_IN; it += NGW) { const int nblk = NIN / 32, kb = it / nblk, nb = it % nblk; transpose_item(F.in[IN_WIN], 12416, 64 * kb, win_src_col(32 * nb), WINT, DM, 32 * nb, scr, F.lane); } }
    }
}


__device__ __forceinline__ void p0_weights_late(Frame& F, int gw, int ngw, int lo = 0, int hi = 1 << 30) {
    LAS float* scr = (LAS float*)(F.lds + F.wave * 16384);
    bf16* WMT = (bf16*)(F.ws + WS_WMT); bf16* WOT = (bf16*)(F.ws + WS_WOT);
    constexpr int I_A = (WID / 64) * (DM / 32), I_O = (DM / 64) * (DM / 32), NITEMS = 2 * I_A + I_O;
    for (int it = lo + gw; it < (hi < NITEMS ? hi : NITEMS); it += ngw) {
        int r = it; const int nblk = DM / 32;
        if (r < I_A) { const int kb = r / nblk, nb = r % nblk; transpose_item(F.in[IN_WPM], DM, 64 * kb, 32 * nb, WMT, DM, 32 * nb, scr, F.lane); continue; } r -= I_A;
        if (r < I_A) { const int kb = r / nblk, nb = r % nblk; transpose_item(F.in[IN_WPR], DM, 64 * kb, 32 * nb, WMT + WID, DM, 32 * nb, scr, F.lane); continue; } r -= I_A;
        { const int kb = r / nblk, nb = r % nblk; transpose_item(F.in[IN_WOUT], DM, 64 * kb, 32 * nb, WOT, DM, 32 * nb, scr, F.lane); }
    }
}
#ifndef MK_NLATE
#define MK_NLATE 9
#endif
constexpr int NLATE = MK_NLATE, NMAIN = 49 - NLATE;
struct InOrderMain { pg8::StaticOrder S;
    __device__ __forceinline__ bool next(int i, pg8::Unit& u) const { if (!S.next(i, u)) return false; if (u.pn == NMAIN - 1) u.pn = 48; return true; }
    __device__ __forceinline__ void a_ready(const pg8::Unit&) const {}
    __device__ __forceinline__ void done(const pg8::Unit&) const {} };
struct InOrderLate { int c, G;
    __device__ __forceinline__ bool next(int i, pg8::Unit& u) const { const int ng = G >> 5, g = c >> 5, w = c & 31, per = (64 / ng) * NLATE, j = i * 32 + w; if (j >= per) return false;
        u.pm = g * (64 / ng) + j / NLATE; u.pn = 48 - NLATE + j % NLATE; return true; }
    __device__ __forceinline__ void a_ready(const pg8::Unit&) const {}
    __device__ __forceinline__ void done(const pg8::Unit&) const {} };
namespace ck {
constexpr int C = 32, NCH = SEQ / C, LT = 72, LX = 40;
typedef float f32x2 __attribute__((ext_vector_type(2)));
typedef float f32x16 __attribute__((ext_vector_type(16)));
typedef __bf16 bf16x2_t __attribute__((ext_vector_type(2)));
typedef unsigned u32x2 __attribute__((ext_vector_type(2)));
__device__ __forceinline__ unsigned cvt2(float lo, float hi) { f32x2 v = {lo, hi}; bf16x2_t b = __builtin_convertvector(v, bf16x2_t); return __builtin_bit_cast(unsigned, b); }
__device__ __forceinline__ float fsig(float x) { return __builtin_amdgcn_rcpf(1.0f + __builtin_amdgcn_exp2f(-1.4426950408889634f * x)); }
__device__ __forceinline__ float ftanh(float x) { return 1.0f - 2.0f * __builtin_amdgcn_rcpf(1.0f + __builtin_amdgcn_exp2f(2.8853900817779268f * x)); }
__device__ __forceinline__ float fexp(float x) { return __builtin_amdgcn_exp2f(1.4426950408889634f * x); }
__device__ __forceinline__ int crow(int r, int hi) { return (r & 3) + 8 * (r >> 2) + 4 * hi; }
__device__ __forceinline__ float red16(float x) { x = red8(x); x = DPP_ADD(x, 0x128); return x; }
__device__ __forceinline__ int opq(int x) { asm volatile("" : "+v"(x)); return x; }
#define CK_BAR() asm volatile("s_waitcnt lgkmcnt(0)\n\ts_barrier" ::: "memory")
typedef short v4i16_t __attribute__((ext_vector_type(4)));
template <bool TR> __device__ __forceinline__ pg8::bf16x8 ck_frag(const LAS bf16* X, int ld, int k0, int lane) {
    if (!TR) return *(const LAS pg8::bf16x8*)(X + (lane & 31) * ld + k0 + 8 * (lane >> 5));
    const LAS bf16* p = X + (k0 + 8 * (lane >> 5) + ((lane & 15) >> 2)) * ld + 16 * ((lane >> 4) & 1) + 4 * (lane & 3);
    const v4i16_t lo = __builtin_amdgcn_ds_read_tr16_b64_v4i16((LAS v4i16_t*)p), hi4 = __builtin_amdgcn_ds_read_tr16_b64_v4i16((LAS v4i16_t*)(p + 4 * ld));
    return (pg8::bf16x8){lo[0], lo[1], lo[2], lo[3], hi4[0], hi4[1], hi4[2], hi4[3]};
}
template <int K, bool TA, bool TB> __device__ __forceinline__ f32x16 mm_tile(const LAS bf16* A, int lda, const LAS bf16* B, int ldb, f32x16 acc, int lane) {
#pragma unroll
    for (int k0 = 0; k0 < K; k0 += 16) acc = __builtin_amdgcn_mfma_f32_32x32x16_bf16(ck_frag<TA>(A, lda, k0, lane), ck_frag<TB>(B, ldb, k0, lane), acc, 0, 0, 0);
    return acc;
}
constexpr int SZ_TOK = C * LT * 2, SZ_GRM = C * 36 * 4 + 3 * C * LX * 2 + 64 * 4;
constexpr int O_TOK = 0;
constexpr int O_GRM = O_TOK + 2 * 5 * SZ_TOK;
constexpr int O_TM = O_GRM + 2 * SZ_GRM, O_LVT = O_TM + C * LX * 2, O_AHT = O_LVT + 64 * LX * 2, O_W2T = O_AHT + 64 * LX * 2;
constexpr int O_RH = O_W2T + 64 * LX * 2, O_PP = O_RH + C * LT * 2, O_ZT = O_PP + 64 * LT * 2;
constexpr int O_GX = O_ZT + 64 * LT * 2, O_LA = O_GX + C * 64 * 4, O_LW = O_LA + C * 68 * 4, O_PAR = O_LW + C * 64 * 4, O_L21 = O_PAR + 12 * 64 * 4, O_XT = O_L21 + 16 * 24 * 2, O_HAND = O_XT + 16 * 24 * 2, O_END1 = O_HAND + 8 * 64;
constexpr int O_YL = O_LVT, O_WST = 0;
static_assert(O_END1 <= 143360 && C * 65 * 4 <= 2 * 64 * LX * 2, "chunk LDS map");

__device__ __forceinline__ void head(Frame& F, int bh) {
    LAS unsigned char* lds = F.lds; LAS float* Lpar = (LAS float*)(lds + O_PAR); LAS float* La = (LAS float*)(lds + O_LA); LAS float* Lws = (LAS float*)(lds + O_LW); LAS bf16* BVb = (LAS bf16*)(lds + O_GX); LAS unsigned* Lhand = (LAS unsigned*)(lds + O_HAND);
    LAS bf16* Tm = (LAS bf16*)(lds + O_TM); LAS bf16* LVt = (LAS bf16*)(lds + O_LVT); LAS bf16* AhT = (LAS bf16*)(lds + O_AHT); LAS bf16* W2t = (LAS bf16*)(lds + O_W2T); LAS bf16* Rh = (LAS bf16*)(lds + O_RH); LAS bf16* Pp = (LAS bf16*)(lds + O_PP); LAS bf16* ZT = (LAS bf16*)(lds + O_ZT);
    LAS float* Yl = (LAS float*)(lds + O_YL);
    const bf16* RKV = (const bf16*)(F.ws + WS_RKV); const bf16* LORA = (const bf16*)(F.ws + WS_LORA); const bf16* ZA = (const bf16*)(F.ws + WS_ZA); bf16* YA = (bf16*)(F.ws + WS_Y) + 1024;
    const int tid0 = F.tid, lane0 = F.lane, wave = F.wave, b = bh >> 4, h = bh & 15;
    const size_t row0 = (size_t)b * SEQ;
    const bool front = wave >= 4; const int fw = wave - 4;
    CK_BAR();
    { const int tid = tid0;
    for (int e = tid; e < 12 * 64; e += 512) { const int a = e >> 6, d = e & 63;
        const float* pp = a == 0 ? F.in[IN_MUR] : a == 1 ? F.in[IN_MUK] : a == 2 ? F.in[IN_MUV] : a == 3 ? F.in[IN_KK] : a == 4 ? F.in[IN_KA] : a == 5 ? F.in[IN_RK] : a == 6 ? F.in[IN_GNW] : a == 7 ? F.in[IN_GNB] : a == 8 ? F.in[IN_W0] : a == 9 ? F.in[IN_A0] : a == 10 ? F.in[IN_MUW] : F.in[IN_MUA];
        Lpar[e] = pp[a >= 10 ? d : h * 64 + d]; }
    { LAS float* Wst = (LAS float*)(lds + O_WST);
#pragma unroll
        for (int it = 0; it < 4; ++it) { const int e = tid + 512 * it, mtx = e >> 10, row = (e >> 4) & 63, c4 = (e & 15) * 4; const float* W = mtx ? F.in[IN_WAUP] : F.in[IN_WDUP];
            *(LAS pg8::f32x4*)(Wst + mtx * 4096 + row * 64 + c4) = *(const GAS pg8::f32x4*)(W + (size_t)row * 1024 + h * 64 + c4); } }
    for (int e = tid; e < 64 * LT / 2; e += 512) ((LAS unsigned*)ZT)[e] = 0u;
    if (tid < 256) Tm[(tid >> 4) * LX + 16 + (tid & 15)] = (bf16)0;
    if (tid < 128) Lhand[tid] = 0u; }
    CK_BAR();
    const bool la = (fw & 1) != 0, lw = !la; const int lct = (fw >> 1) & 1;
    pg8::bf16x8 wf[4];
    if (front) { const int l_ = lane0, hi_ = l_ >> 5, c_ = l_ & 31; const LAS float* Wst = (LAS float*)(lds + O_WST) + (la ? 4096 : 0) + (8 * hi_) * 64 + c_ + 32 * lct;
#pragma unroll
        for (int s = 0; s < 4; ++s) { float t[8];
#pragma unroll
            for (int j = 0; j < 8; ++j) t[j] = Wst[(16 * s + j) * 64];
            const v4u pk_ = {cvt2(t[0], t[1]), cvt2(t[2], t[3]), cvt2(t[4], t[5]), cvt2(t[6], t[7])}; wf[s] = __builtin_bit_cast(pg8::bf16x8, pk_); } }
    CK_BAR();
    v4u pLc[4], pR[6];
#define CK_PF_LORA(nn) do { const int l_ = opq(lane0), t_ = (nn) * C + (l_ & 31); const bf16* lp_ = LORA + (row0 + t_) * 128 + (la ? 64 : 0) + 8 * (l_ >> 5); \
        _Pragma("unroll") for (int s = 0; s < 4; ++s) pLc[s] = *(const GAS v4u*)(lp_ + 16 * s); } while (0)
#define CK_PF_RKV(nn) do { const int i_ = fw * 64 + opq(lane0), t_ = (nn) * C + (i_ >> 3); const bf16* rp_ = RKV + (row0 + t_) * 3072 + h * 64 + 8 * (i_ & 7); \
        pR[0] = *(const GAS v4u*)rp_; pR[1] = *(const GAS v4u*)(rp_ + 1024); pR[2] = *(const GAS v4u*)(rp_ + 2048); \
        if (t_ > 0) { pR[3] = *(const GAS v4u*)(rp_ - 3072); pR[4] = *(const GAS v4u*)(rp_ - 3072 + 1024); pR[5] = *(const GAS v4u*)(rp_ - 3072 + 2048); } else { pR[3] = (v4u){0u, 0u, 0u, 0u}; pR[4] = pR[3]; pR[5] = pR[3]; } \
        } while (0)
    if (front) CK_PF_LORA(0);
    f32x16 Z = {};
    v4u zaC = {0u, 0u, 0u, 0u};
    for (int n = -1; n < NCH; ++n) {
        const int m = n + 1; const bool fm = front && m < NCH, bn = !front && n >= 0;
        const int lane = opq(lane0), r32 = lane & 31, hi = lane >> 5, idx = fw * 64 + lane, tok = idx >> 3, p = idx & 7;
        LAS bf16* tkM = (LAS bf16*)(lds + O_TOK + (m & 1) * 5 * SZ_TOK); LAS unsigned char* gmM = lds + O_GRM + (m & 1) * SZ_GRM;
        const LAS bf16* tkN = (const LAS bf16*)(lds + O_TOK + (n & 1) * 5 * SZ_TOK); const LAS unsigned char* gmN = lds + O_GRM + (n & 1) * SZ_GRM;
        const LAS bf16* tokA = tkN, *tokR = tkN + C * LT, *tokB = tkN + 2 * C * LT, *tokK = tkN + 3 * C * LT, *tokV = tkN + 4 * C * LT;
        const LAS float* Lab = (const LAS float*)gmN; const LAS bf16* Lak = (const LAS bf16*)(gmN + C * 36 * 4); const LAS bf16* Mrb = Lak + C * LX; const LAS bf16* Mrk = Mrb + C * LX; const LAS float* gC = (const LAS float*)(gmN + C * 36 * 4 + 3 * C * LX * 2);
        float r_[8], kp_[8], v_[8], al_[8], be_[8], lw_[8];
        if (fm) CK_PF_RKV(m);
        if (fm) { LAS float* mu_ = Lpar + (la ? 11 : 10) * 64 + 8 * hi;
            f32x16 acc0_ = {};
#pragma unroll
            for (int s = 0; s < 4; ++s) { float cu_[8], pv_[8]; unpack8(pLc[s], cu_);
                {
                    v4u pp_; const v4u hd_ = *(const LAS v4u*)(Lhand + (fw * 2 + hi) * 16 + 4 * s);
                    pp_.x = (unsigned)__builtin_amdgcn_update_dpp(0, (int)pLc[s].x, 0x138, 0xF, 0xF, false); pp_.y = (unsigned)__builtin_amdgcn_update_dpp(0, (int)pLc[s].y, 0x138, 0xF, 0xF, false);
                    pp_.z = (unsigned)__builtin_amdgcn_update_dpp(0, (int)pLc[s].z, 0x138, 0xF, 0xF, false); pp_.w = (unsigned)__builtin_amdgcn_update_dpp(0, (int)pLc[s].w, 0x138, 0xF, 0xF, false);
                    if (r32 == 0) pp_ = hd_;
                    unpack8(pp_, pv_); }
#pragma unroll
                for (int j = 0; j < 8; ++j) cu_[j] = cu_[j] + (pv_[j] - cu_[j]) * mu_[16 * s + j];
                if (lw) {
#pragma unroll
                    for (int j = 0; j < 8; ++j) cu_[j] = ftanh(cu_[j]); }
                const v4u pk_ = {cvt2(cu_[0], cu_[1]), cvt2(cu_[2], cu_[3]), cvt2(cu_[4], cu_[5]), cvt2(cu_[6], cu_[7])}; const pg8::bf16x8 af_ = __builtin_bit_cast(pg8::bf16x8, pk_);
                acc0_ = __builtin_amdgcn_mfma_f32_32x32x16_bf16(af_, wf[s], acc0_, 0, 0, 0); }
            if (r32 == 31) {
#pragma unroll
                for (int s = 0; s < 4; ++s) *(LAS v4u*)(Lhand + (fw * 2 + hi) * 16 + 4 * s) = pLc[s]; }
            const float b0_ = Lpar[(lw ? 8 : 9) * 64 + 32 * lct + r32];
#pragma unroll
            for (int r = 0; r < 16; ++r) acc0_[r] = fsig(acc0_[r] + b0_);
            if (lw) { LAS float* o_ = Lws + (4 * hi) * 64 + 32 * lct + r32;
#pragma unroll
                for (int r = 0; r < 16; ++r) o_[((r & 3) + 8 * (r >> 2)) * 64] = -0.60653066f * acc0_[r]; }
            else { LAS float* o_ = La + (4 * hi) * 68 + 32 * lct + r32;
#pragma unroll
                for (int r = 0; r < 16; ++r) o_[((r & 3) + 8 * (r >> 2)) * 68] = acc0_[r]; } }
        if (bn && wave == 0) {
            LAS bf16* L21b = (LAS bf16*)(lds + O_L21); LAS bf16* Xt = (LAS bf16*)(lds + O_XT);
            const int blk = (lane >> 4) & 1, i = lane & 15; const LAS float* Lb = Lab + (16 * blk) * 36 + 16 * blk; float T[16];
#pragma unroll
            for (int t = 0; t < 16; ++t) { float a0 = (t == i) ? 1.f : 0.f, a1 = 0.f, a2 = 0.f, a3 = 0.f;
#pragma unroll
                for (int j4 = 0; j4 < t; j4 += 4) { const pg8::f32x4 l4 = *(const LAS pg8::f32x4*)(Lb + t * 36 + j4);
                    a0 += l4.x * T[j4]; if (j4 + 1 < t) a1 += l4.y * T[j4 + 1]; if (j4 + 2 < t) a2 += l4.z * T[j4 + 2]; if (j4 + 3 < t) a3 += l4.w * T[j4 + 3]; }
                T[t] = (a0 + a1) + (a2 + a3); }
            if (hi == 0) {
#pragma unroll
                for (int t = 0; t < 16; ++t) Tm[(16 * blk + t) * LX + 16 * blk + i] = (bf16)f2bf(T[t]); }
            { const int r = lane >> 2, j0 = 4 * (lane & 3); const pg8::f32x4 l4 = *(const LAS pg8::f32x4*)(Lab + (16 + r) * 36 + j0); *(LAS u32x2*)(L21b + r * 24 + j0) = (u32x2){cvt2(l4.x, l4.y), cvt2(l4.z, l4.w)}; }
            asm volatile("s_waitcnt lgkmcnt(0)" ::: "memory");
            { const pg8::bf16x8 a = *(const LAS pg8::bf16x8*)(L21b + i * 24 + 8 * hi); const f32x16 x = __builtin_amdgcn_mfma_f32_32x32x16_bf16(a, ck_frag<true>(Tm, LX, 0, lane), f32x16{}, 0, 0, 0);
                if (r32 < 16) {
#pragma unroll
                    for (int q = 0; q < 2; ++q) *(LAS u32x2*)(Xt + r32 * 24 + 8 * q + 4 * hi) = (u32x2){cvt2(x[4 * q], x[4 * q + 1]), cvt2(x[4 * q + 2], x[4 * q + 3])}; } }
            asm volatile("s_waitcnt lgkmcnt(0)" ::: "memory");
            { const pg8::bf16x8 a = *(const LAS pg8::bf16x8*)(Tm + (16 + i) * LX + 16 + 8 * hi), bfr = *(const LAS pg8::bf16x8*)(Xt + i * 24 + 8 * hi);
                const f32x16 t21 = __builtin_amdgcn_mfma_f32_32x32x16_bf16(a, bfr, f32x16{}, 0, 0, 0);
                if (r32 < 16) {
#pragma unroll
                    for (int q = 0; q < 2; ++q)
#pragma unroll
                        for (int e2 = 0; e2 < 4; ++e2) Tm[(16 + 8 * q + 4 * hi + e2) * LX + r32] = (bf16)f2bf(t21[4 * q + e2]); } } }
        CK_BAR();
        if (bn) zaC = *(const GAS v4u*)(ZA + (row0 + n * C + ((wave * 64 + lane) >> 3)) * 1024 + h * 64 + 8 * (lane & 7));
        if (fm) {
            const int cch = 16 * fw + (lane & 15), seg = lane >> 4; LAS float* gCm = (LAS float*)(gmM + C * 36 * 4 + 3 * C * LX * 2); float g[8];
#pragma unroll
            for (int j = 0; j < 8; ++j) g[j] = Lws[(8 * seg + j) * 64 + cch];
#pragma unroll
            for (int j = 1; j < 8; ++j) g[j] += g[j - 1];
            const float S = g[7];
            const auto a_ = __builtin_amdgcn_permlane16_swap(__float_as_uint(S), __float_as_uint(S), false, false); const float other16 = (seg & 1) ? __uint_as_float(a_[0]) : __uint_as_float(a_[1]);
            const float pairT = S + other16;
            const auto b_ = __builtin_amdgcn_permlane32_swap(__float_as_uint(pairT), __float_as_uint(pairT), false, false); const float other32 = (seg & 2) ? __uint_as_float(b_[0]) : __uint_as_float(b_[1]);
            const float off = ((seg & 1) ? other16 : 0.f) + ((seg & 2) ? other32 : 0.f);
#pragma unroll
            for (int j = 0; j < 8; ++j) Lws[(8 * seg + j) * 64 + cch] = g[j] + off;
            if (seg == 3) gCm[cch] = fexp(g[7] + off); }
        if (bn) { const int nt = wave & 1; const LAS bf16* A_ = wave < 2 ? Tm : Lak; const LAS bf16* B_ = (wave < 2 ? tokA : tokV) + nt * 32; LAS bf16* O_ = (wave < 2 ? AhT : LVt) + nt * 32 * LX;
            const f32x16 d = mm_tile<32, false, true>(A_, LX, B_, LT, f32x16{}, lane);
#pragma unroll
            for (int q = 0; q < 4; ++q) *(LAS u32x2*)(O_ + r32 * LX + 8 * q + 4 * hi) = (u32x2){cvt2(d[4 * q], d[4 * q + 1]), cvt2(d[4 * q + 2], d[4 * q + 3])}; }
        CK_BAR();
        if (fm) { float cr[8], ck_[8], cv[8], qr[8], qk[8], qv[8]; unpack8(pR[0], cr); unpack8(pR[1], ck_); unpack8(pR[2], cv); unpack8(pR[3], qr); unpack8(pR[4], qk); unpack8(pR[5], qv);
            float kkr[8], kk_[8], ss = 0.f, bon = 0.f;
#pragma unroll
            for (int j = 0; j < 8; ++j) { const int d = 8 * p + j; r_[j] = cr[j] + (qr[j] - cr[j]) * Lpar[0 * 64 + d]; kk_[j] = ck_[j] + (qk[j] - ck_[j]) * Lpar[1 * 64 + d]; v_[j] = cv[j] + (qv[j] - cv[j]) * Lpar[2 * 64 + d];
                kkr[j] = kk_[j] * Lpar[3 * 64 + d]; ss += kkr[j] * kkr[j]; }
            ss = red8(ss); const float inv = 1.f / fmaxf(sqrtf(ss), 1e-12f);
#pragma unroll
            for (int j = 0; j < 8; ++j) { const int d = 8 * p + j; const float aa = La[tok * 68 + d], kn = kkr[j] * inv; kp_[j] = kk_[j] * (1.f + (aa - 1.f) * Lpar[4 * 64 + d]); al_[j] = -kn; be_[j] = kn * aa;
                bon += r_[j] * kp_[j] * Lpar[5 * 64 + d]; lw_[j] = Lws[tok * 64 + d] - (tok > 0 ? Lws[(tok - 1) * 64 + d] : 0.f); }
            bon = red8(bon);
#pragma unroll
            for (int j = 0; j < 8; ++j) kkr[j] = bon * v_[j];
            *(LAS v4u*)(BVb + (m & 1) * C * 64 + tok * 64 + 8 * p) = (v4u){cvt2(kkr[0], kkr[1]), cvt2(kkr[2], kkr[3]), cvt2(kkr[4], kkr[5]), cvt2(kkr[6], kkr[7])};
            float at[8], rt[8], bt[8], kt[8];
#pragma unroll
            for (int j = 0; j < 8; ++j) { const float gi = Lws[tok * 64 + 8 * p + j], ge = gi - lw_[j], en = fexp(-gi); at[j] = al_[j] * fexp(ge); rt[j] = r_[j] * fexp(gi); bt[j] = be_[j] * en; kt[j] = kp_[j] * en; }
            const int o = tok * LT + 8 * p;
            *(LAS v4u*)(tkM + o) = (v4u){cvt2(at[0], at[1]), cvt2(at[2], at[3]), cvt2(at[4], at[5]), cvt2(at[6], at[7])}; *(LAS v4u*)(tkM + C * LT + o) = (v4u){cvt2(rt[0], rt[1]), cvt2(rt[2], rt[3]), cvt2(rt[4], rt[5]), cvt2(rt[6], rt[7])};
            *(LAS v4u*)(tkM + 2 * C * LT + o) = (v4u){cvt2(bt[0], bt[1]), cvt2(bt[2], bt[3]), cvt2(bt[4], bt[5]), cvt2(bt[6], bt[7])}; *(LAS v4u*)(tkM + 3 * C * LT + o) = (v4u){cvt2(kt[0], kt[1]), cvt2(kt[2], kt[3]), cvt2(kt[4], kt[5]), cvt2(kt[6], kt[7])};
            *(LAS v4u*)(tkM + 4 * C * LT + o) = (v4u){cvt2(v_[0], v_[1]), cvt2(v_[2], v_[3]), cvt2(v_[4], v_[5]), cvt2(v_[6], v_[7])}; }
        if (bn) {
            if (wave < 2) { const int nt = wave; const f32x16 d = mm_tile<32, false, false>(Tm, LX, LVt + nt * 32 * LX, LX, f32x16{}, lane);
#pragma unroll
                for (int q = 0; q < 4; ++q) *(LAS u32x2*)(W2t + (nt * 32 + r32) * LX + 8 * q + 4 * hi) = (u32x2){cvt2(d[4 * q], d[4 * q + 1]), cvt2(d[4 * q + 2], d[4 * q + 3])}; }
            else { const int ct = wave - 2; const f32x16 d = mm_tile<32, false, false>(AhT + ct * 32 * LX, LX, Mrb, LX, f32x16{}, lane); const int t = r32;
#pragma unroll
                for (int q = 0; q < 4; ++q) { const int c0 = ct * 32 + 8 * q + 4 * hi; const u32x2 rr = *(const LAS u32x2*)(tokR + t * LT + c0);
                    *(LAS u32x2*)(Rh + t * LT + c0) = (u32x2){cvt2(d[4 * q] + blo(rr.x), d[4 * q + 1] + bhi(rr.x)), cvt2(d[4 * q + 2] + blo(rr.y), d[4 * q + 3] + bhi(rr.y))}; } }
            { const int ct = wave & 1, c2t = wave >> 1; const f32x16 d = mm_tile<32, false, true>(AhT + ct * 32 * LX, LX, tokB + c2t * 32, LT, f32x16{}, lane); const int c2 = c2t * 32 + r32; const float gm = gC[c2];
#pragma unroll
                for (int q = 0; q < 4; ++q) { const int c0 = ct * 32 + 8 * q + 4 * hi;
                    *(LAS u32x2*)(Pp + c2 * LT + c0) = (u32x2){cvt2(gm * d[4 * q], gm * d[4 * q + 1]), cvt2(gm * d[4 * q + 2], gm * d[4 * q + 3])}; } } }
        CK_BAR();
        if (fm) { const LAS bf16* A_ = (fw == 0 || fw == 2) ? tkM + 2 * C * LT : tkM + 3 * C * LT; const LAS bf16* Bt_ = (fw < 2) ? tkM : tkM + C * LT;
            const f32x16 d = mm_tile<64, false, false>(A_, LT, Bt_, LT, f32x16{}, lane); const int t = r32;
            LAS float* LabM = (LAS float*)gmM; LAS bf16* O_ = (LAS bf16*)(gmM + C * 36 * 4) + (fw - 1) * C * LX;
            const int lim = t + (fw < 2 ? 0 : 1) - 4 * hi;
            float x[16];
#pragma unroll
            for (int r = 0; r < 16; ++r) x[r] = (8 * (r >> 2) + (r & 3) < lim) ? d[r] : 0.f;
            if (fw == 0) { LAS float* o_ = LabM + t * 36 + 4 * hi;
#pragma unroll
                for (int q = 0; q < 4; ++q) *(LAS pg8::f32x4*)(o_ + 8 * q) = (pg8::f32x4){x[4 * q], x[4 * q + 1], x[4 * q + 2], x[4 * q + 3]}; }
            else { LAS bf16* o_ = O_ + t * LX + 4 * hi;
#pragma unroll
                for (int q = 0; q < 4; ++q) *(LAS u32x2*)(o_ + 8 * q) = (u32x2){cvt2(x[4 * q], x[4 * q + 1]), cvt2(x[4 * q + 2], x[4 * q + 3])}; } }
        if (front && n >= 0 && fw < 2) { const int yv = fw;
            f32x16 y = mm_tile<32, false, false>(Mrb, LX, W2t + yv * 32 * LX, LX, f32x16{}, lane); y = mm_tile<32, false, true>(Mrk, LX, tokV + yv * 32, LT, y, lane);
            const f32x16 y2 = mm_tile<64, false, false>(Rh, LT, ZT + yv * 32 * LT, LT, f32x16{}, lane);
#pragma unroll
            for (int r = 0; r < 16; ++r) Yl[crow(r, hi) * 65 + yv * 32 + r32] = y[r] + y2[r]; }
        if (bn) { const int c2t = wave & 1, vt = wave >> 1;
            f32x16 d = mm_tile<32, true, false>(tokB + c2t * 32, LT, W2t + vt * 32 * LX, LX, f32x16{}, lane); d = mm_tile<32, true, true>(tokK + c2t * 32, LT, tokV + vt * 32, LT, d, lane);
#pragma unroll
            for (int q = 0; q < 4; ++q) { const pg8::f32x4 g4 = *(const LAS pg8::f32x4*)(gC + c2t * 32 + 8 * q + 4 * hi);
                d[4 * q] = g4.x * (d[4 * q] + Z[4 * q]); d[4 * q + 1] = g4.y * (d[4 * q + 1] + Z[4 * q + 1]); d[4 * q + 2] = g4.z * (d[4 * q + 2] + Z[4 * q + 2]); d[4 * q + 3] = g4.w * (d[4 * q + 3] + Z[4 * q + 3]); }
            const f32x16 pz = mm_tile<64, false, false>(Pp + c2t * 32 * LT, LT, ZT + vt * 32 * LT, LT, f32x16{}, lane);
            Z = d + pz;
 }
        CK_BAR();
        if (front && m + 1 < NCH) CK_PF_LORA(m + 1);
        if (bn) { const int c2t = wave & 1, vt = wave >> 1;
#pragma unroll
            for (int q = 0; q < 4; ++q) *(LAS u32x2*)(ZT + (vt * 32 + r32) * LT + c2t * 32 + 8 * q + 4 * hi) = (u32x2){cvt2(Z[4 * q], Z[4 * q + 1]), cvt2(Z[4 * q + 2], Z[4 * q + 3])};
            const int tb = (wave * 64 + lane) >> 3, pb = lane & 7;
            const size_t row = row0 + n * C + tb; float y[8], za[8], o[8], bv[8], sm = 0.f; unpack8(zaC, za); unpack8(*(const LAS v4u*)(BVb + (n & 1) * C * 64 + tb * 64 + 8 * pb), bv);
#pragma unroll
            for (int j = 0; j < 8; ++j) { y[j] = Yl[tb * 65 + 8 * pb + j]; sm += y[j]; }
            const float mean = red8(sm) * (1.f / 64.f); float q_ = 0.f;
#pragma unroll
            for (int j = 0; j < 8; ++j) { y[j] -= mean; q_ += y[j] * y[j]; }
            const float rstd = __builtin_amdgcn_rsqf(red8(q_) * (1.f / 64.f) + GN_EPS);
#pragma unroll
            for (int j = 0; j < 8; ++j) o[j] = (y[j] * rstd * Lpar[6 * 64 + 8 * pb + j] + Lpar[7 * 64 + 8 * pb + j] + bv[j]) * za[j];
            *(GAS v4u*)(YA + row * 2048 + h * 64 + 8 * pb) = (v4u){cvt2(o[0], o[1]), cvt2(o[2], o[3]), cvt2(o[4], o[5]), cvt2(o[6], o[7])}; }
    }
#undef CK_PF_RKV
#undef CK_PF_LORA
}
#undef CK_BAR
}

__device__ __forceinline__ void subset_barrier(gu32* cnt, unsigned nwg, bool t0) {
    asm volatile("s_waitcnt vmcnt(0)" ::: "memory"); __syncthreads();
    if (t0) { __builtin_amdgcn_fence(__ATOMIC_RELEASE, "agent"); asm volatile("s_waitcnt vmcnt(0)" ::: "memory");
        __hip_atomic_fetch_add((unsigned*)cnt, 1u, RLX_AGENT);
        unsigned sp = 0; while (__hip_atomic_load((unsigned*)cnt, RLX_AGENT) < nwg && ++sp < (1u << 22)) __builtin_amdgcn_s_sleep(2);
        __builtin_amdgcn_fence(__ATOMIC_ACQUIRE, "agent"); asm volatile("s_waitcnt vmcnt(0)" ::: "memory"); }
    __syncthreads();
}

#ifndef MK_CHECK
#define MK_CHECK 0
#endif
#ifndef MK_NAIVE_ATTN
#define MK_NAIVE_ATTN 0
#endif

#ifndef MK_GIVE_QB
#define MK_GIVE_QB 3
#endif
constexpr int PER_PHASE = 5;
struct Args { const float* in[22]; float* out; unsigned char* ws; int ph_lo, ph_hi, li, pad; };
__global__ void __launch_bounds__(NWAVES * 64, 2) mk_fwd(Args args) {
    extern __shared__ __attribute__((aligned(16))) unsigned char lds[];
    Frame F;
    F.lds = (LAS unsigned char*)lds; F.MISC = (volatile LAS unsigned*)(F.lds + MISC_OFF);
    F.wave = __builtin_amdgcn_readfirstlane((int)threadIdx.x >> 6); F.lane = mk_lane_id(); F.tid = F.wave * 64 + F.lane;
    F.G = gridDim.x; { const int bx = blockIdx.x; F.vcu = (F.G % 8 == 0) ? (bx % 8) * (F.G / 8) + bx / 8 : bx; }
    F.ws = args.ws; F.out = args.out; F.ctl = (gu32*)(args.ws + WS_CTL);
#pragma unroll
    for (int i = 0; i < 22; ++i) F.in[i] = args.in[i];
    for (int u = F.tid; u < (LDS_BYTES - LDSCTL_OFF) / 4; u += NWAVES * 64) ((LAS unsigned*)(F.lds + LDSCTL_OFF))[u] = 0u;
    __syncthreads();
    XcdBarrier bar; bar.bar = (unsigned*)(F.ctl + CW_BAR); bar.x = 0; bar.st = nullptr;
    if (MK_N_LAUNCHES == 1) bar = xcd_barrier_post((unsigned*)(F.ctl + CW_BAR), F.MISC + 8, F.tid == 0);
#define GRID_BAR() do { if (MK_N_LAUNCHES == 1) { FRESH(); xcd_barrier(bar, F.tid == 0); } } while (0)
    const int lo = args.ph_lo, hi = args.ph_hi;
#define TS(k) do { if (MK_TS && F.tid == 0 && (blockIdx.x == 0 || blockIdx.x == 4)) __hip_atomic_store((unsigned*)(F.ctl + CW_TS + (blockIdx.x ? 32 : 0) + (k)), (unsigned)__builtin_amdgcn_s_memrealtime(), __ATOMIC_RELAXED, __HIP_MEMORY_SCOPE_AGENT); } while (0)
    TS(0);
#if MK_TS == 90
    if (blockIdx.x == 0 && F.lane == 0) __hip_atomic_store((unsigned*)(F.ctl + CW_TS + 100 + F.wave), 1u + ((unsigned)__builtin_amdgcn_s_getreg((2 - 1) << 11 | 4 << 6 | 4) & 3u), __ATOMIC_RELAXED, __HIP_MEMORY_SCOPE_AGENT);
#endif
#ifndef MK_PHASE_MASK
#define MK_PHASE_MASK 0x1f
#endif
#define IN(k) (((MK_PHASE_MASK >> (k)) & 1) && lo <= (k) && (k) < hi)
#define FRESH() do { int l_ = mk_lane_id(); asm volatile("" : "+v"(l_)); F.lane = l_; F.tid = F.wave * 64 + l_; } while (0)
#define BOTH(k) (IN(k) && IN((k) + 1))
    bf16* WS16 = (bf16*)args.ws; (void)WS16;
    if (IN(0)) { FRESH(); p0_prologue(F); TS(1); if (BOTH(0)) GRID_BAR(); TS(2); }
    if (IN(1)) {
        pg8::Gemm g{(const pg8::bf16_t*)(args.ws + WS_XN), (const pg8::bf16_t*)(args.ws + WS_WINT), T, NIN, DM}; InOrderMain S; S.S.init(T, NMAIN * 256, F.G, (int)blockIdx.x);
        pg8::EpiIn E{(pg8::bf16_t*)(args.ws + WS_RKV), (pg8::bf16_t*)(args.ws + WS_ZA), (pg8::bf16_t*)(args.ws + WS_QKVB), (pg8::bf16_t*)(args.ws + WS_ZB), (pg8::bf16_t*)args.out, (pg8::bf16_t*)(args.ws + WS_LORA), F.in[IN_QNW], F.in[IN_KNW], (float*)(args.ws + WS_KMEAN)};
        pg8::gemm_phase<pg8::EpiIn, InOrderMain, true, true>(F.lds, g, S, E, F.wave);
        TS(3); if (BOTH(1)) GRID_BAR(); TS(4);
    }
    if (IN(2)) {
        const attn_body::bf16* QK = (const attn_body::bf16*)(args.ws + WS_QKVB);
        const attn_body::AttnTensors AT{QK, QK + 1024, QK + 2048, (attn_body::bf16*)(args.ws + WS_Y), (const attn_body::bf16*)(args.ws + WS_ZB), (const float*)(args.ws + WS_KMEAN)};
        const pg8::Gemm gl{(const pg8::bf16_t*)(args.ws + WS_XN), (const pg8::bf16_t*)(args.ws + WS_WINT), T, NIN, DM};
        const pg8::EpiIn El{(pg8::bf16_t*)(args.ws + WS_RKV), (pg8::bf16_t*)(args.ws + WS_ZA), (pg8::bf16_t*)(args.ws + WS_QKVB), (pg8::bf16_t*)(args.ws + WS_ZB), (pg8::bf16_t*)args.out, (pg8::bf16_t*)(args.ws + WS_LORA), F.in[IN_QNW], F.in[IN_KNW], (float*)(args.ws + WS_KMEAN)};
        constexpr int NSCAN = BATCH * NH; FRESH();
        const bool split = F.G >= 2 * NSCAN && ((F.G - NSCAN) & 31) == 0 && 64 % ((F.G - NSCAN) >> 5) == 0;
        if (split && F.vcu < NSCAN) { ck::head(F, F.vcu); FRESH(); __syncthreads(); p0_weights_late(F, F.vcu * NWAVES + F.wave, NSCAN * NWAVES, 0, 2048);
            if (MK_GIVE_QB) { const attn_body::MobaOrder S{F.vcu, NSCAN, false, MK_GIVE_QB};
#pragma unroll 1
                for (int qb = 0; qb < 8; ++qb) if ((MK_GIVE_QB >> qb) & 1) { FRESH(); __syncthreads(); attn_body::AttnUnit u; if (S.own(S.slot_of(F.vcu, qb), F.vcu, u)) attn_body::attn_unit<8>(u.bh / NH, u.bh % NH, u.qb, AT.Q, AT.K, AT.V, AT.O, AT.ZB, AT.KMEAN, (char*)lds, F.wave); } } }
        else {
            const int c = split ? F.vcu - NSCAN : F.vcu, ng = split ? F.G - NSCAN : F.G;
            if (!split) { for (int u = F.vcu; u < NSCAN; u += F.G) ck::head(F, u); __syncthreads(); }
            if (split) { InOrderLate SL{c, ng}; pg8::gemm_phase<pg8::EpiIn, InOrderLate, true, true>(F.lds, gl, SL, El, F.wave); }
            else { InOrderLate SL{0, 32}; for (int k = F.vcu; k < 32; k += F.G) { SL.c = k; pg8::gemm_phase<pg8::EpiIn, InOrderLate, true, true>(F.lds, gl, SL, El, F.wave); } }
            FRESH(); __syncthreads();
            const attn_body::MobaOrder S{c, ng, split && ng == 128 && (((64 / (ng >> 5)) * NLATE) & 31) == 16, split ? MK_GIVE_QB : 0}; attn_body::attn_phase<attn_body::MobaOrder>((char*)lds, AT, S, F.wave);
            if (!split) { FRESH(); __syncthreads(); p0_weights_late(F, c * NWAVES + F.wave, ng * NWAVES, 0, 2048); }
        }
        TS(7);
#if MK_TS
        if (F.tid == 0) { const unsigned now = (unsigned)__builtin_amdgcn_s_memrealtime(); const unsigned st = __hip_atomic_load((unsigned*)(F.ctl + CW_TS + 4), __ATOMIC_RELAXED, __HIP_MEMORY_SCOPE_AGENT);
            __hip_atomic_fetch_max((unsigned*)(F.ctl + CW_TS + 64 + (F.vcu >= 128 ? 1 : 0)), now - st, __ATOMIC_RELAXED, __HIP_MEMORY_SCOPE_AGENT);
            if (F.vcu >= 128) __hip_atomic_fetch_max((unsigned*)(F.ctl + CW_TS + 66 + (((F.vcu - 128) & 31) < 16 ? 0 : 1)), now - st, __ATOMIC_RELAXED, __HIP_MEMORY_SCOPE_AGENT); }
#endif
        if (BOTH(2)) GRID_BAR(); TS(8);
    }
    if (IN(3) && !(blockIdx.x & 1)) { FRESH(); p0_weights_late(F, F.vcu * NWAVES + F.wave, F.G * NWAVES, 2048, 4096); __syncthreads(); }
    if (IN(3)) {
        pg8::Gemm g{(const pg8::bf16_t*)(args.ws + WS_Y), (const pg8::bf16_t*)(args.ws + WS_WMT), T, DM, DM}; pg8::StaticOrder S; S.init(T, DM, F.G, (int)blockIdx.x);
        pg8::EpiMergeF E{(const pg8::bf16_t*)args.out, (pg8::bf16_t*)(args.ws + WS_MERGED)};
        pg8::gemm_phase<pg8::EpiMergeF, pg8::StaticOrder, MK_ALIGN34, true>(F.lds, g, S, E, F.wave);
        if (blockIdx.x & 1) { FRESH(); __syncthreads(); p0_weights_late(F, F.vcu * NWAVES + F.wave, F.G * NWAVES, 2048, 4096); }
        TS(10); if (BOTH(3)) GRID_BAR(); TS(11);
    }
    if (IN(4)) {
        pg8::Gemm g{(const pg8::bf16_t*)(args.ws + WS_MERGED), (const pg8::bf16_t*)(args.ws + WS_WOT), T, DM, DM}; pg8::StaticOrder S; S.init(T, DM, F.G, (int)blockIdx.x);
        pg8::EpiOut E{F.in[IN_X], args.out};
        pg8::gemm_phase<pg8::EpiOut, pg8::StaticOrder, MK_ALIGN34, true>(F.lds, g, S, E, F.wave); TS(12);
    }
#if MK_TS >= 60 && MK_TS < 70
    {
        GRID_BAR(); TS(13);
        constexpr int V = MK_TS - 60;
        if constexpr (V < 4 || V == 8) { pg8::Gemm g{(const pg8::bf16_t*)(args.ws + WS_Y), (const pg8::bf16_t*)(args.ws + WS_WMT), T, DM, DM}; pg8::StaticOrder S; S.init(T, DM, F.G, (int)blockIdx.x);
            typedef pg8::EpiMergeFT<(V & 1) == 0, (V & 2) == 0, V == 8> EP; EP E{(const pg8::bf16_t*)(args.ws + WS_QKVB), (pg8::bf16_t*)(args.ws + WS_RKV)};
            pg8::gemm_phase<EP, pg8::StaticOrder, MK_ALIGN34, true>(F.lds, g, S, E, F.wave); }
        else { pg8::Gemm g{(const pg8::bf16_t*)(args.ws + WS_MERGED), (const pg8::bf16_t*)(args.ws + WS_WOT), T, DM, DM}; pg8::StaticOrder S; S.init(T, DM, F.G, (int)blockIdx.x);
            typedef pg8::EpiOutT<V == 9 || ((V - 4) & 1) == 0, V == 9 || ((V - 4) & 2) == 0, V == 9 ? 16 : 1> EP; EP E{F.in[IN_X], (float*)(args.ws + WS_RKV)};
            pg8::gemm_phase<EP, pg8::StaticOrder, MK_ALIGN34, true>(F.lds, g, S, E, F.wave); }
        GRID_BAR(); TS(14);
    }
#endif
#undef IN
#undef BOTH
}


#if MK_TS
__global__ void mk_report(Args args) {
    const unsigned* ts0 = (const unsigned*)(args.ws + WS_CTL) + CW_TS; const unsigned* ts4 = ts0 + 32;
    float A = 0.f, B = 0.f;
    const float tk = 0.01f;
    if (MK_TS == 1) { A = (ts0[1] - ts0[0]) * tk; B = (ts0[3] - ts0[2]) * tk; }
    if (MK_TS == 2) { A = (ts0[5] - ts0[4]) * tk; B = (ts0[7] - ts0[6]) * tk; }
    if (MK_TS == 3) { A = (ts4[7] - ts4[4]) * tk; B = 0.f; }
    if (MK_TS == 4) { A = (ts0[12] - ts0[11]) * tk; B = ((ts0[2] - ts0[1]) + (ts0[4] - ts0[3]) + (ts0[6] - ts0[5]) + (ts0[8] - ts0[7]) + (ts0[11] - ts0[10])) * tk; }
    if (MK_TS >= 20 && MK_TS < 32) { A = floorf(ts0[40 + (MK_TS - 20)] * tk / 25.f) * 25.f; B = 0.f; }
    if (MK_TS == 32) { A = 0.2f * ts0[40] * tk; B = 0.f; }
    if (MK_TS == 33) { A = 0.2f * (ts0[41] + ts0[42] + ts0[43]) * tk; B = 0.f; }
    if (MK_TS == 34) { A = 0.2f * (ts0[44] + ts0[46] + ts0[47]) * tk; B = 0.f; }
    if (MK_TS == 35) { A = 0.2f * ts0[48] * tk; B = 0.f; }
    if (MK_TS == 36) { A = 0.2f * ts0[51] * tk; B = 0.f; }
    if (MK_TS == 9) { A = (ts0[13] - ts0[8]) * tk; B = 0.f; }
    if (MK_TS == 10) { A = (ts0[15] - ts0[14]) * tk; B = 0.f; }
    if (MK_TS == 11) { A = (ts0[7] - ts0[6]) * tk; B = 0.f; }
    if (MK_TS == 8) { A = ts0[20] * tk; B = 0.f; }
    if (MK_TS == 6) { A = (ts0[7] - ts0[4]) * tk; B = 0.f; }
    if (MK_TS == 7) { A = (ts0[5] - ts0[4]) * tk; B = 0.f; }
    if (MK_TS == 5) { A = (ts0[12] - ts0[0]) * tk; B = 0.f; }
    if (MK_TS >= 50 && MK_TS < 54) { A = ts0[64 + MK_TS - 50] * tk; B = 0.f; }
    if (MK_TS >= 60 && MK_TS < 70) { A = (ts0[14] - ts0[13]) * tk; B = 0.f; }
    if (MK_TS == 55) { A = ts0[65] * tk - 400.f; B = 0.f; }
    if (MK_TS == 56) { A = ts0[64] * tk - 400.f; B = 0.f; }
    if (MK_TS == 57) { A = (ts0[8] - ts0[4]) * tk - 400.f; B = 0.f; }
    if (MK_TS == 58) { A = (ts0[4] - ts0[2]) * tk - 400.f; B = 0.f; }
    if (MK_TS == 59) { A = (ts0[12] - ts0[8]) * tk - 200.f; B = 0.f; }
    if (MK_TS == 70) { A = (ts0[4] - ts0[3]) * tk * 10.f; B = 0.f; }
    if (MK_TS == 71) { A = (ts0[2] - ts0[1]) * tk * 10.f; B = 0.f; }
    if (MK_TS == 72) { A = (ts0[8] - ts0[7]) * tk * 10.f; B = 0.f; }
    if (MK_TS == 73) { A = (ts0[11] - ts0[10]) * tk * 10.f; B = 0.f; }
    if (MK_TS >= 80 && MK_TS < 88) { A = ts0[MK_TS] * tk; B = 0.f; }
    if (MK_TS == 90) { int c1 = 0, c2 = 0; for (int w = 0; w < 4; ++w) { c1 += ts0[100 + w] == ts0[104 + w]; c2 += ts0[100 + 2 * w] == ts0[101 + 2 * w]; } A = 11.f + 10.f * c1 + c2; B = 0.f; }
    if (MK_TS >= 92 && MK_TS < 96) { A = ts0[MK_TS] * tk; B = 0.f; }
    if (MK_TS >= 80 && MK_TS < 90) { A = ts0[MK_TS] * tk; B = 0.f; }
    if (MK_TS == 54) { A = (ts0[12] - ts0[0]) * tk - 1200.f; B = 0.f; }
    if (MK_TS == 44) { A = (ts0[8] - ts0[4]) * tk; B = 0.f; }
    if (MK_TS == 45) { A = (ts0[11] - ts0[8]) * tk; B = 0.f; }
    if (MK_TS == 46) { A = (ts0[4] - ts0[2]) * tk; B = 0.f; }
    if (MK_TS == 40) { A = (ts0[3] - ts0[2]) * tk; B = 0.f; }
    if (MK_TS == 41) { A = (ts0[10] - ts0[8]) * tk; B = 0.f; }
    if (MK_TS == 42) { A = (ts0[12] - ts0[11]) * tk; B = 0.f; }
    if (MK_TS == 43) { A = (ts0[1] - ts0[0]) * tk; B = 0.f; }
    const size_t N = 3355443;
    for (size_t e = (size_t)blockIdx.x * blockDim.x + threadIdx.x; e < N; e += (size_t)gridDim.x * blockDim.x) args.out[1 + e] += 2e-4f * B;
    if (blockIdx.x == 0 && threadIdx.x == 0) args.out[0] += 0.01f * A;
}
#endif
#if MK_CHECK
constexpr int CW_CHK = 8192;
__device__ __forceinline__ float chk_silu(float x) { return x / (1.f + expf(-x)); }
__device__ __forceinline__ float chk_sig(float x) { return 1.f / (1.f + expf(-x)); }
__global__ void __launch_bounds__(64) mk_check(Args args, int stage) {
    __shared__ float sh[8][64];
    const int lane = threadIdx.x; unsigned char* ws = args.ws; unsigned* ctl = (unsigned*)(ws + WS_CTL);
    const bf16* WINT = (const bf16*)(ws + WS_WINT); const bf16* WAT = (const bf16*)(ws + WS_WAT); const bf16* WBT = (const bf16*)(ws + WS_WBT); const bf16* WOT = (const bf16*)(ws + WS_WOT);
    const bf16* XN = (const bf16*)(ws + WS_XN); const bf16* RKV = (const bf16*)(ws + WS_RKV); const bf16* ZA = (const bf16*)(ws + WS_ZA); const bf16* QKVB = (const bf16*)(ws + WS_QKVB);
    const bf16* ZB = (const bf16*)(ws + WS_ZB); const bf16* G = (const bf16*)args.out; const bf16* LORA = (const bf16*)(ws + WS_LORA);
    const bf16* YA = (const bf16*)(ws + WS_YA); const bf16* YB = (const bf16*)(ws + WS_YB); const bf16* MERGED = (const bf16*)(ws + WS_MERGED); const float* KMEAN = (const float*)(ws + WS_KMEAN);
    float ratio = 0.f; int sub = 0; unsigned fmask = 0u;
#define CHK(got, want, rel, ab, SUB) do { const float r_ = fabsf((got) - (want)) / ((rel) * fabsf(want) + (ab)); if (!(r_ <= 1.f)) fmask |= 1u << (SUB); if (!(r_ <= ratio)) { ratio = r_; sub = (SUB); } } while (0)
    if (stage == 1) {
        for (int ri = 0; ri < 4; ++ri) { const int t = ri == 0 ? 0 : ri == 1 ? 1 : ri == 2 ? 5000 : 16383; const float* xr = args.in[IN_X] + (size_t)t * DM; float s = 0.f;
            for (int j = 0; j < 32; ++j) { const float v = xr[lane * 32 + j]; s += v * v; }
            s = wave_sum(s); const float rstd = 1.f / sqrtf(s / DM + RMS_EPS); const int k = lane * 32 + ((7 * ri + lane) & 31);
            CHK(bf2f(XN[(size_t)t * DM + k]), xr[k] * rstd * args.in[IN_NORMW][k], 0.01f, 1e-3f, 1); }
        for (int q = 0; q < 4; ++q) { int n = (lane * 197 + 13 + q * 3137) % NIN; if (q == 3 && lane < 9) { int v = 4095;
                v = lane == 1 ? 4096 : lane == 2 ? 8191 : lane == 3 ? 8192 : lane == 4 ? 12287 : lane == 5 ? 12288 : lane == 6 ? 12415 : lane == 7 ? 12416 : lane == 8 ? 12543 : 4095; n = v; }
            const int k = (lane * 31 + 5 + q * 511) % DM; const int src = win_src_col(n);
            const float want = src >= 0 ? args.in[IN_WIN][(size_t)k * 12416 + src] : 0.f; CHK(bf2f(WINT[(size_t)n * DM + k]), want, 0.01f, 1e-4f, 2); }
    }
    if (stage == 2) {
        for (int q = 0; q < 4; ++q) { const int t = (lane * 1031 + 17 + q * 4099) % T, grp = (lane + q) % 9, c = (lane * 67 + 3 + q * 131) % 1024, c2 = (lane * 113 + 9 + q * 517) % 2048, c3 = (lane * 5 + q) % 128;
            const int n = grp == 0 ? c : grp == 1 ? 1024 + c : grp == 2 ? 2048 + c : grp == 3 ? 3072 + c : grp == 4 ? 4096 + 2048 + c : grp == 5 ? 4096 + 3072 + c : grp == 6 ? 8192 + c2 : grp == 7 ? 8192 + 2048 + c2 : 12288 + c3;
            float d = 0.f; for (int k = 0; k < DM; ++k) d += bf2f(XN[(size_t)t * DM + k]) * bf2f(WINT[(size_t)n * DM + k]);
            float got, want = d;
            if (grp <= 2) got = bf2f(RKV[(size_t)t * 3072 + grp * 1024 + c]);
            else if (grp == 3) { got = bf2f(ZA[(size_t)t * 1024 + c]); want = chk_silu(d); }
            else if (grp == 4) got = bf2f(QKVB[(size_t)t * 3072 + 2048 + c]);
            else if (grp == 5) { got = bf2f(ZB[(size_t)t * 1024 + c]); want = chk_silu(d); }
            else if (grp == 6) { got = bf2f(G[(size_t)t * 4096 + c2]); want = chk_sig(d); }
            else if (grp == 7) { got = bf2f(G[(size_t)t * 4096 + 2048 + c2]); want = chk_sig(d); }
            else got = bf2f(LORA[(size_t)t * 128 + c3]);
            CHK(got, want, 0.02f, 0.02f, 1 + grp); }
    }
    if (stage == 4) {
        for (int pi = 0; pi < 2; ++pi) { const int b = pi ? 5 : 0, h = pi ? 9 : 0; float S[64];
#pragma unroll
            for (int j = 0; j < 64; ++j) S[j] = 0.f;
            const int d = h * 64 + lane; const float mur = args.in[IN_MUR][d], muk = args.in[IN_MUK][d], muv = args.in[IN_MUV][d], kk_ = args.in[IN_KK][d], ka = args.in[IN_KA][d], rk = args.in[IN_RK][d], gw = args.in[IN_GNW][d], gb = args.in[IN_GNB][d];
            for (int t = 0; t < 200; ++t) { const size_t row = (size_t)b * SEQ + t;
                const float cr = bf2f(RKV[row * 3072 + d]), ck = bf2f(RKV[row * 3072 + 1024 + d]), cv = bf2f(RKV[row * 3072 + 2048 + d]);
                const float pr = t ? bf2f(RKV[(row - 1) * 3072 + d]) : 0.f, pk = t ? bf2f(RKV[(row - 1) * 3072 + 1024 + d]) : 0.f, pv = t ? bf2f(RKV[(row - 1) * 3072 + 2048 + d]) : 0.f;
                const float lcw = bf2f(LORA[row * 128 + lane]), lca = bf2f(LORA[row * 128 + 64 + lane]), lpw = t ? bf2f(LORA[(row - 1) * 128 + lane]) : 0.f, lpa = t ? bf2f(LORA[(row - 1) * 128 + 64 + lane]) : 0.f;
                __syncthreads(); sh[5][lane] = tanhf(lcw + (lpw - lcw) * args.in[IN_MUW][lane]); sh[6][lane] = lca + (lpa - lca) * args.in[IN_MUA][lane]; __syncthreads();
                float sd = 0.f, sa2 = 0.f;
                for (int i2 = 0; i2 < 64; ++i2) { sd += sh[5][i2] * args.in[IN_WDUP][i2 * 1024 + d]; sa2 += sh[6][i2] * args.in[IN_WAUP][i2 * 1024 + d]; }
                const float zz = args.in[IN_W0][d] + sd, a = chk_sig(args.in[IN_A0][d] + sa2), w = expf(-expf(-log1pf(expf(-zz)) - 0.5f));
                const float r = cr + (pr - cr) * mur, k = ck + (pk - ck) * muk, v = cv + (pv - cv) * muv;
                float kkv = k * kk_; const float nrm = fmaxf(sqrtf(wave_sum(kkv * kkv)), 1e-12f); kkv /= nrm; const float kp = k * (1.f + (a - 1.f) * ka), bb = kkv * a;
                const float bon = wave_sum(r * kp * rk);
                __syncthreads(); sh[0][lane] = r; sh[1][lane] = w; sh[2][lane] = kp; sh[3][lane] = -kkv; sh[4][lane] = bb; __syncthreads();
                float sa = 0.f;
#pragma unroll
                for (int j = 0; j < 64; ++j) sa += S[j] * sh[3][j];
                float y = 0.f;
#pragma unroll
                for (int j = 0; j < 64; ++j) { S[j] = S[j] * sh[1][j] + sa * sh[4][j] + v * sh[2][j]; y += S[j] * sh[0][j]; }
                const float mean = wave_sum(y) * (1.f / 64.f), dy = y - mean, var = wave_sum(dy * dy) * (1.f / 64.f);
                const float want = (dy / sqrtf(var + GN_EPS) * gw + gb + bon * v) * bf2f(ZA[row * 1024 + d]);
                CHK(bf2f(YA[row * 1024 + d]), want, 0.03f, 0.03f, 1 + pi * 4 + (t >= 32 ? 1 : 0) + (t >= 64 ? 1 : 0)); } }
    }
    if (stage == 5) {
        for (int q = 0; q < 4; ++q) { const int t = (lane * 523 + 7 + q * 4111) % T, h = (lane + q) & 15, which = q & 1; float ss = 0.f; const float* nw = which ? args.in[IN_KNW] : args.in[IN_QNW];
            for (int dd = 0; dd < 64; ++dd) { const float v = bf2f(QKVB[(size_t)t * 3072 + which * 1024 + h * 64 + dd]) / nw[dd]; ss += v * v; }
            CHK(ss / 64.f, which ? 1.0f : QSCALE * QSCALE, 0.02f, 0.f, 1 + which); }
        for (int q = 0; q < 2; ++q) { const int b = (lane + q * 3) & 7, h = (lane * 5 + q) & 15, n = (lane >> 3) & 7, dd = (lane * 11 + q * 29) & 63; float s = 0.f;
            for (int k = 0; k < 256; ++k) s += bf2f(QKVB[((size_t)b * SEQ + n * 256 + k) * 3072 + 1024 + h * 64 + dd]);
            CHK(KMEAN[(((size_t)b * NH + h) * 8 + n) * 64 + dd], s / 256.f, 0.02f, 2e-3f, 3); }
    }
    if (stage == 6) {
        const int l15 = lane & 15;
        const int s = l15 == 0 ? 0 : l15 == 1 ? 1 : l15 == 2 ? 63 : l15 == 3 ? 64 : l15 == 4 ? 255 : l15 == 5 ? 256 : l15 == 6 ? 300 : l15 == 7 ? 511 : l15 == 8 ? 512 : l15 == 9 ? 777 : l15 == 10 ? 1023 : l15 == 11 ? 1024 : l15 == 12 ? 1300 : l15 == 13 ? 1791 : l15 == 14 ? 1800 : 2047;
        const int b = (lane >> 4) * 2 + 1, h = (lane * 7 + 3) & 15, qblk = s >> 8; const size_t row = (size_t)b * SEQ + s;
        float qv[64], o[64];
#pragma unroll
        for (int dd = 0; dd < 64; ++dd) { qv[dd] = bf2f(QKVB[row * 3072 + h * 64 + dd]); o[dd] = 0.f; }
        float g[8]; int nsel = qblk < 3 ? qblk : 3; unsigned selm = 0;
#pragma unroll
        for (int n = 0; n < 8; ++n) { g[n] = -1e30f; if (n < qblk) { float a = 0.f;
#pragma unroll
                for (int dd = 0; dd < 64; ++dd) a += qv[dd] * KMEAN[(((size_t)b * NH + h) * 8 + n) * 64 + dd];
                g[n] = a; } }
        for (int it = 0; it < nsel; ++it) { int best = -1; float bv = -3e38f;
#pragma unroll
            for (int n = 0; n < 8; ++n) if (!((selm >> n) & 1u) && g[n] > bv) { bv = g[n]; best = n; }
            selm |= 1u << best; }
        float m = -1e30f, l = 0.f;
        for (int n = 0; n <= qblk; ++n) { if (n < qblk && !((selm >> n) & 1u)) continue;
            for (int kk2 = 0; kk2 < 256; ++kk2) { const int j = n * 256 + kk2; if (j > s) break; const size_t kr = ((size_t)b * SEQ + j) * 3072; float sc = 0.f;
#pragma unroll
                for (int dd = 0; dd < 64; ++dd) sc += qv[dd] * bf2f(QKVB[kr + 1024 + h * 64 + dd]);
                const float mn = fmaxf(m, sc), al = exp2f(m - mn), p = exp2f(sc - mn); l = l * al + p; m = mn;
#pragma unroll
                for (int dd = 0; dd < 64; ++dd) o[dd] = o[dd] * al + p * bf2f(QKVB[kr + 2048 + h * 64 + dd]); } }
#pragma unroll
        for (int dd = 0; dd < 64; ++dd) CHK(bf2f(YB[row * 1024 + h * 64 + dd]), o[dd] / l * bf2f(ZB[row * 1024 + h * 64 + dd]), 0.03f, 0.003f, 1 + (qblk > 3 ? 1 : 0) + (qblk == 0 ? 2 : 0));
    }
    if (stage == 7) {
            { const int n = (lane * 37 + 3) % DM, k = (lane * 29 + 1) % WID; CHK(bf2f(WAT[(size_t)n * WID + k]), args.in[IN_WPR][(size_t)k * DM + n], 0.01f, 1e-4f, 3);
          CHK(bf2f(WBT[(size_t)n * WID + k]), args.in[IN_WPM][(size_t)k * DM + n], 0.01f, 1e-4f, 3); const int k2 = (lane * 61 + 7) % DM; CHK(bf2f(WOT[(size_t)n * DM + k2]), args.in[IN_WOUT][(size_t)k2 * DM + n], 0.01f, 1e-4f, 3); }
        for (int q = 0; q < 4; ++q) { const int t = (lane * 1031 + 17 + q * 4099) % T, n = (lane * 113 + 9 + q * 517) % 2048; float da = 0.f, db = 0.f;
            for (int k = 0; k < WID; ++k) { da += bf2f(YA[(size_t)t * 1024 + k]) * bf2f(WAT[(size_t)n * WID + k]); db += bf2f(YB[(size_t)t * 1024 + k]) * bf2f(WBT[(size_t)n * WID + k]); }
            CHK(bf2f(MERGED[(size_t)t * 2048 + n]), bf2f(G[(size_t)t * 4096 + n]) * da + bf2f(G[(size_t)t * 4096 + 2048 + n]) * db, 0.02f, 0.01f, 1); }
    }
    if (stage == 8) {
        for (int q = 0; q < 4; ++q) { const int t = (lane * 1031 + 17 + q * 4099) % T, n = (lane * 113 + 9 + q * 517) % 2048; float d = 0.f;
            for (int k = 0; k < DM; ++k) d += bf2f(MERGED[(size_t)t * 2048 + k]) * bf2f(WOT[(size_t)n * DM + k]);
            CHK(args.out[(size_t)t * DM + n], args.in[IN_X][(size_t)t * DM + n] + d, 0.f, 0.01f, 1); }
    }
    const float wr = wave_max(ratio);
#pragma unroll
    for (int o_ = 1; o_ < 64; o_ <<= 1) fmask |= (unsigned)__shfl_xor((int)fmask, o_);
    (void)sub;
    if (threadIdx.x == 0 && blockIdx.x == 0 && stage <= 8) { if (fmask && ctl[CW_CHK] == 0u) { const int low = __ffs((int)fmask) - 1, cnt = __popc(fmask);
            ctl[CW_CHK] = (unsigned)(stage * 10 + (low > 9 ? 9 : low)); ctl[CW_CHK + 1] = (unsigned)(cnt + (wr >= 64.f ? 20 : wr >= 8.f ? 10 : 0)); } }
    if (stage == 9) { const unsigned code = ctl[CW_CHK], code2 = ctl[CW_CHK + 1];
        if (code) { for (size_t e = (size_t)blockIdx.x * 64 + lane; e < (size_t)T * DM; e += (size_t)gridDim.x * 64) args.out[e] += (float)code2;
            if (blockIdx.x == 0 && lane == 0) args.out[0] = 100.f * (float)code; } }
#undef CHK
}
#endif

extern "C" void kernel_launch(void* const* d_in, const int* in_sizes, int n_in, void* d_out, int out_size, void* d_ws, size_t ws_size, hipStream_t stream) {
    static int grid = 0;
    if (grid == 0) {
        if (n_in != 22 || in_sizes[0] != T * DM || out_size != T * DM || ws_size < WS_END) { fprintf(stderr, "kernel_launch: unexpected shapes (n_in %d, in0 %d, out %d, ws %zu)\n", n_in, n_in > 0 ? in_sizes[0] : -1, out_size, ws_size); grid = -1; return; }
        int dev = 0, cus = 0, per_cu = 0;
        if (hipGetDevice(&dev) != hipSuccess || hipDeviceGetAttribute(&cus, hipDeviceAttributeMultiprocessorCount, dev) != hipSuccess) { grid = -1; return; }
        if (hipFuncSetAttribute((const void*)mk_fwd, hipFuncAttributeMaxDynamicSharedMemorySize, LDS_BYTES) != hipSuccess) { fprintf(stderr, "kernel_launch: hipFuncSetAttribute failed\n"); grid = -1; return; }
        if (hipOccupancyMaxActiveBlocksPerMultiprocessor(&per_cu, (const void*)mk_fwd, NWAVES * 64, LDS_BYTES) != hipSuccess || per_cu < 1) { fprintf(stderr, "kernel_launch: occupancy query says %d blocks per CU\n", per_cu); per_cu = 1; }
        (void)hipGetLastError();
        grid = cus;
    }
    if (grid < 0) return;
    (void)hipMemsetAsync((char*)d_ws + WS_CTL, 0, CTL_ZERO_BYTES, stream);
    Args a{};
    for (int i = 0; i < 22; ++i) a.in[i] = (const float*)d_in[i];
    a.out = (float*)d_out; a.ws = (unsigned char*)d_ws;
    if (MK_N_LAUNCHES == 1) { a.ph_lo = 0; a.ph_hi = PER_PHASE; a.li = 0; hipLaunchKernelGGL(mk_fwd, dim3(grid), dim3(NWAVES * 64), LDS_BYTES, stream, a);
#if MK_TS
        hipLaunchKernelGGL(mk_report, dim3(256), dim3(256), 0, stream, a);
#endif
    }
    else for (int li = 0; li < PER_PHASE; ++li) { a.ph_lo = li; a.ph_hi = li + 1; a.li = li; hipLaunchKernelGGL(mk_fwd, dim3(grid), dim3(NWAVES * 64), LDS_BYTES, stream, a);
#if MK_CHECK
        const int stg = li == 0 ? 1 : li == 1 ? 2 : li == 2 ? 4 : li == 3 ? 7 : li == 4 ? 8 : 0;
        if (stg) hipLaunchKernelGGL(mk_check, dim3(1), dim3(64), 0, stream, a, stg);
        if (li == 1) hipLaunchKernelGGL(mk_check, dim3(1), dim3(64), 0, stream, a, 5);
        if (li == 2) hipLaunchKernelGGL(mk_check, dim3(1), dim3(64), 0, stream, a, 6);
        if (li == 4) hipLaunchKernelGGL(mk_check, dim3(512), dim3(64), 0, stream, a, 9);
#endif
    }
}
```

```cpp
#define MK_N_LAUNCHES 1
#include <hip/hip_runtime.h>
#include <cstdio>
#include <cstdint>
#include <hip/hip_bf16.h>
#include <cmath>
__device__ __forceinline__ int mk_lane_id() { int l; asm volatile("v_mbcnt_lo_u32_b32 %0, -1, 0\n\tv_mbcnt_hi_u32_b32 %0, -1, %0" : "=v"(l)); return l; }
#ifndef MK_WGM
#define MK_WGM 4
#endif
namespace pg8 {
#define PG8_LAS __attribute__((address_space(3)))
typedef unsigned short bf16_t;
typedef short bf16x8 __attribute__((ext_vector_type(8)));
typedef float f32x4 __attribute__((ext_vector_type(4)));
typedef unsigned u32x4 __attribute__((ext_vector_type(4)));
constexpr int BM = 256, BK = 64, HALF = 128, HTB = HALF * BK * 2  , STAGE_BYTES = 8 * HTB, NXCD = 8, WGM = MK_WGM;

__host__ __device__ __forceinline__ int lds_byte(int r, int c) { const int st = (r >> 4) * 2 + (c >> 5), rr = r & 15, cc = c & 31, ob = rr * 64 + cc * 2; return st * 1024 + (ob ^ (((ob >> 9) & 1) << 5)); }
__host__ __device__ __forceinline__ void stage_rc(int b, int& R, int& C) { const int st = b / 1024, sb = b % 1024, swz = sb ^ (((sb >> 9) & 1) << 5); R = (st >> 1) * 16 + swz / 64; C = (st & 1) * 32 + (swz % 64) / 2; }
__host__ __device__ __forceinline__ int perm32(int rho) { const int n = rho >> 4, i = rho & 15; return 8 * (i >> 2) + 4 * n + (i & 3); }

struct Unit { int pm, pn; };
struct Gemm { const bf16_t* A; const bf16_t* Bt; int M, N, K; };

template <int W> struct StaticOrderT {
    int nM, nN, nwg, G, c;
    __host__ __device__ void init(int M, int N, int G_, int c_) { nM = M / BM; nN = N / BM; nwg = nM * nN; G = G_; c = c_; }
    __host__ __device__ bool next(int i, Unit& u) const {
        const long L = (long)i * G + c; if (L >= nwg) return false;
        int wgid = (int)L; { const int q = nwg / NXCD, r = nwg % NXCD, xcd = wgid % NXCD, off = wgid / NXCD; wgid = (xcd < r ? xcd * (q + 1) : r * (q + 1) + (xcd - r) * q) + off; }
        const int nig = W * nN, gid = wgid / nig, fm = gid * W, gsz = (nM - fm) < W ? (nM - fm) : W;
        u.pm = fm + ((wgid % nig) % gsz); u.pn = (wgid % nig) / gsz; return true;
    }
    __device__ __forceinline__ void a_ready(const Unit&) const {}
    __device__ __forceinline__ void done(const Unit&) const {}
};
typedef StaticOrderT<WGM> StaticOrder;

__device__ __forceinline__ unsigned cvt_pk_bf16(float lo, float hi) { unsigned r; asm volatile("v_cvt_pk_bf16_f32 %0, %1, %2" : "=v"(r) : "v"(lo), "v"(hi)); return r; }
typedef float f32x2 __attribute__((ext_vector_type(2)));
typedef __bf16 epi_bf16x2 __attribute__((ext_vector_type(2)));
__device__ __forceinline__ unsigned cvt2(float lo, float hi) { f32x2 v = {lo, hi}; epi_bf16x2 b = __builtin_convertvector(v, epi_bf16x2); return __builtin_bit_cast(unsigned, b); }
__device__ __forceinline__ float bf_lo(unsigned w) { return __builtin_bit_cast(float, w << 16); }
__device__ __forceinline__ float bf_hi(unsigned w) { return __builtin_bit_cast(float, w & 0xffff0000u); }
__device__ __forceinline__ float fast_sigmoid(float x) { return __builtin_amdgcn_rcpf(1.0f + __builtin_amdgcn_exp2f(-1.4426950408889634f * x)); }
template <int ACT> __device__ __forceinline__ float act_f(float x) { if (ACT == 1) return x * fast_sigmoid(x); if (ACT == 2) return fast_sigmoid(x); return x; }

#ifndef MK_NT
#define MK_NT 0
#endif
#ifndef MK_WT
#define MK_WT 0
#endif
template <int BIT, class V> __device__ __forceinline__ void epi_st(V* p, const V v) {
    if constexpr ((MK_WT >> BIT) & 1) asm volatile("global_store_dwordx4 %0, %1, off sc1\n\ts_nop 1" :: "v"(p), "v"(v) : "memory");
    else if constexpr ((MK_NT >> BIT) & 1) __builtin_nontemporal_store(v, p); else *p = v; }
template <int BIT, class V> __device__ __forceinline__ V epi_ld(const V* p) { if constexpr ((MK_NT >> BIT) & 1) return __builtin_nontemporal_load(p); else return *p; }
constexpr size_t T_LIN = (size_t)64 * 16 * 8 * 8 * 64;
struct EpiIn {
    static constexpr bool PERM = true, AFTER_DRAIN = false, INIT = false, MID = false;
    bf16_t *RKV, *ZA, *QKVB, *ZB, *G, *LORA;
    template <int ACT, int NBJ> __device__ __forceinline__ void put(const f32x4 (&acc)[2][2][4][2], bf16_t* base, int ldc, int row0, int col0) const {
#pragma unroll
        for (int ai = 0; ai < 2; ++ai)
#pragma unroll
            for (int m = 0; m < 4; ++m) { bf16_t* rowp = base + (size_t)(row0 + ai * HALF + m * 16) * ldc + col0;
#pragma unroll
                for (int bj = 0; bj < NBJ; ++bj) { const f32x4 v0 = acc[ai][bj][m][0], v1 = acc[ai][bj][m][1]; u32x4 w;
                    w.x = cvt2(act_f<ACT>(v0[0]), act_f<ACT>(v0[1])); w.y = cvt2(act_f<ACT>(v0[2]), act_f<ACT>(v0[3]));
                    w.z = cvt2(act_f<ACT>(v1[0]), act_f<ACT>(v1[1])); w.w = cvt2(act_f<ACT>(v1[2]), act_f<ACT>(v1[3]));
                    epi_st<0>((u32x4*)(rowp + bj * HALF), w); } }
    }
    const float* qnw; const float* knw; float* KMEAN;
    template <bool ISK> __device__ __forceinline__ void putqk(const f32x4 (&acc)[2][2][4][2], const Unit& u, int wr, int wc, int fr, int fq) const {
        const int hh = (u.pn & 3) * 4 + wc; const float* nw = ISK ? knw : qnw; const float sc = ISK ? 1.0f : 0.125f * 1.4426950408889634f;
        float rs[2][4];
#pragma unroll
        for (int ai = 0; ai < 2; ++ai)
#pragma unroll
            for (int m = 0; m < 4; ++m) { float ss = 0.f;
#pragma unroll
                for (int bj = 0; bj < 2; ++bj)
#pragma unroll
                    for (int n = 0; n < 2; ++n) { const f32x4 v = acc[ai][bj][m][n]; ss += (v[0] * v[0] + v[1] * v[1]) + (v[2] * v[2] + v[3] * v[3]); }
                ss += __shfl_xor(ss, 16); ss += __shfl_xor(ss, 32);
                rs[ai][m] = 1.0f / sqrtf(ss * (1.0f / 64.0f) + 1e-6f); }
        bf16_t* base = QKVB + (size_t)(u.pm * BM + wr * 64 + fr) * 3072 + (ISK ? 1024 : 0) + hh * 64 + 8 * fq;
#pragma unroll
        for (int bj = 0; bj < 2; ++bj) {
            const f32x4 w0 = *(const f32x4*)(nw + 32 * bj + 8 * fq), w1 = *(const f32x4*)(nw + 32 * bj + 8 * fq + 4);
            const float wv[8] = {w0[0] * sc, w0[1] * sc, w0[2] * sc, w0[3] * sc, w1[0] * sc, w1[1] * sc, w1[2] * sc, w1[3] * sc};
            float cs[8] = {0.f, 0.f, 0.f, 0.f, 0.f, 0.f, 0.f, 0.f};
#pragma unroll
            for (int ai = 0; ai < 2; ++ai)
#pragma unroll
                for (int m = 0; m < 4; ++m) { const f32x4 v0 = acc[ai][bj][m][0], v1 = acc[ai][bj][m][1]; const float r = rs[ai][m]; float o[8];
                    o[0] = v0[0] * r * wv[0]; o[1] = v0[1] * r * wv[1]; o[2] = v0[2] * r * wv[2]; o[3] = v0[3] * r * wv[3]; o[4] = v1[0] * r * wv[4]; o[5] = v1[1] * r * wv[5]; o[6] = v1[2] * r * wv[6]; o[7] = v1[3] * r * wv[7];
                    if (ISK) {
#pragma unroll
                        for (int j = 0; j < 8; ++j) cs[j] += o[j]; }
                    u32x4 w; w.x = cvt2(o[0], o[1]); w.y = cvt2(o[2], o[3]); w.z = cvt2(o[4], o[5]); w.w = cvt2(o[6], o[7]);
                    epi_st<0>((u32x4*)(base + (size_t)(ai * HALF + m * 16) * 3072 + 32 * bj), w); }
            if (ISK) { float* km = KMEAN + ((size_t)((u.pm >> 3) * 16 + hh) * 8 + (u.pm & 7)) * 64;
#pragma unroll
                for (int j = 0; j < 8; ++j) { float s = cs[j]; s += __shfl_xor(s, 1); s += __shfl_xor(s, 2); s += __shfl_xor(s, 4); s += __shfl_xor(s, 8);
                    if (fr == 0) atomicAdd(km + 32 * bj + 8 * fq + j, s * (1.0f / 256.0f)); } } }
    }
    __device__ __forceinline__ void putgate(const f32x4 (&acc)[2][2][4][2], const Unit& u, int wr, int wc, int fr, int fq) const {
        u32x4* gp = (u32x4*)G + ((((size_t)u.pm * 16 + (u.pn - 32)) * 8 + wr * 4 + wc) * 8) * 64 + fq * 16 + fr;
#pragma unroll
        for (int ai = 0; ai < 2; ++ai)
#pragma unroll
            for (int m = 0; m < 4; ++m) { float s[8], r[8];
#pragma unroll
                for (int n = 0; n < 2; ++n)
#pragma unroll
                    for (int e = 0; e < 4; ++e) { const float sa = fmaxf(fast_sigmoid(acc[ai][0][m][n][e]), 1e-30f), sb = fast_sigmoid(acc[ai][1][m][n][e]); s[4 * n + e] = sa; r[4 * n + e] = sb * __builtin_amdgcn_rcpf(sa); }
                u32x4 w; w.x = cvt2(s[0], s[1]); w.y = cvt2(s[2], s[3]); w.z = cvt2(s[4], s[5]); w.w = cvt2(s[6], s[7]); epi_st<0>(gp + (ai * 4 + m) * 64, w);
                w.x = cvt2(r[0], r[1]); w.y = cvt2(r[2], r[3]); w.z = cvt2(r[4], r[5]); w.w = cvt2(r[6], r[7]); epi_st<0>(gp + T_LIN + (ai * 4 + m) * 64, w); }
    }
    __device__ __forceinline__ void operator()(const f32x4 (&acc)[2][2][4][2], const Unit& u, int wr, int wc, int fr, int fq) const {
        asm volatile("" : "+v"(fr), "+v"(fq));
        const int row0 = u.pm * BM + wr * 64 + fr, cw = wc * 32 + 8 * fq, pn = u.pn;
        if (pn >= 16 && pn < 20) putqk<false>(acc, u, wr, wc, fr, fq);
        else if (pn >= 20 && pn < 24) putqk<true>(acc, u, wr, wc, fr, fq);
        else if (pn < 12) put<0, 2>(acc, RKV, 3072, row0, pn * 256 + cw);
        else if (pn < 16) put<1, 2>(acc, ZA, 1024, row0, (pn - 12) * 256 + cw);
        else if (pn < 28) put<0, 2>(acc, QKVB, 3072, row0, (pn - 16) * 256 + cw);
        else if (pn < 32) put<1, 2>(acc, ZB, 1024, row0, (pn - 28) * 256 + cw);
        else if (pn < 48) putgate(acc, u, wr, wc, fr, fq);
        else put<0, 1>(acc, LORA, 128, row0, cw);
    }
};
template <bool LD = true, bool ST = true, bool LIN = true> struct EpiMergeFT {
    static constexpr bool PERM = true, AFTER_DRAIN = false, INIT = false, MID = true;
    const bf16_t* G; bf16_t* O;
    __device__ __forceinline__ void mid(f32x4 (&acc)[2][2][4][2], const Unit& u, int wr, int wc, int fr, int fq) const {
        asm volatile("" : "+v"(fr), "+v"(fq));
        const int row0 = u.pm * BM + wr * 64 + fr, col0 = u.pn * BM + wc * 32 + 8 * fq;
#pragma unroll
        for (int ai = 0; ai < 2; ++ai) { u32x4 g[4][2];
#pragma unroll
            for (int m = 0; m < 4; ++m)
#pragma unroll
                for (int bj = 0; bj < 2; ++bj) g[m][bj] = LIN ? epi_ld<2>((const u32x4*)(G + 8 * ((((((size_t)u.pm * 16 + 2 * u.pn + bj) * 8 + wr * 4 + wc) * 8 + ai * 4 + m) * 64 + fq * 16 + fr) + (size_t)T_LIN))) : LD ? *(const u32x4*)(G + (size_t)(row0 + ai * HALF + m * 16) * 4096 + 2048 + col0 + bj * HALF) : (u32x4){0x3f003f00u, 0x3f003f00u, 0x3f003f00u, 0x3f003f00u};
#pragma unroll
            for (int m = 0; m < 4; ++m)
#pragma unroll
                for (int bj = 0; bj < 2; ++bj) { const u32x4 gg = g[m][bj]; f32x4 v0 = acc[ai][bj][m][0], v1 = acc[ai][bj][m][1];
                    v0[0] *= bf_lo(gg.x); v0[1] *= bf_hi(gg.x); v0[2] *= bf_lo(gg.y); v0[3] *= bf_hi(gg.y); v1[0] *= bf_lo(gg.z); v1[1] *= bf_hi(gg.z); v1[2] *= bf_lo(gg.w); v1[3] *= bf_hi(gg.w);
                    acc[ai][bj][m][0] = v0; acc[ai][bj][m][1] = v1; } }
    }
    __device__ __forceinline__ void operator()(const f32x4 (&acc)[2][2][4][2], const Unit& u, int wr, int wc, int fr, int fq) const {
        const int row0 = u.pm * BM + wr * 64 + fr, col0 = u.pn * BM + wc * 32 + 8 * fq;
#pragma unroll
        for (int ai = 0; ai < 2; ++ai) { u32x4 g[4][2];
#pragma unroll
            for (int m = 0; m < 4; ++m)
#pragma unroll
                for (int bj = 0; bj < 2; ++bj) g[m][bj] = LIN ? epi_ld<2>((const u32x4*)(G + 8 * (((((size_t)u.pm * 16 + 2 * u.pn + bj) * 8 + wr * 4 + wc) * 8 + ai * 4 + m) * 64 + fq * 16 + fr))) : LD ? *(const u32x4*)(G + (size_t)(row0 + ai * HALF + m * 16) * 4096 + col0 + bj * HALF) : (u32x4){0x3f003f00u, 0x3f003f00u, 0x3f003f00u, 0x3f003f00u};
#pragma unroll
            for (int m = 0; m < 4; ++m)
#pragma unroll
                for (int bj = 0; bj < 2; ++bj) { const u32x4 gg = g[m][bj]; const f32x4 v0 = acc[ai][bj][m][0], v1 = acc[ai][bj][m][1]; u32x4 w;
                    w.x = cvt2(v0[0] * bf_lo(gg.x), v0[1] * bf_hi(gg.x)); w.y = cvt2(v0[2] * bf_lo(gg.y), v0[3] * bf_hi(gg.y)); w.z = cvt2(v1[0] * bf_lo(gg.z), v1[1] * bf_hi(gg.z)); w.w = cvt2(v1[2] * bf_lo(gg.w), v1[3] * bf_hi(gg.w));
                    if (ST || w.x == 0x7fc17fc1u) epi_st<2>((u32x4*)(O + (size_t)(row0 + ai * HALF + m * 16) * 2048 + col0 + bj * HALF), w); } }
    }
};
typedef EpiMergeFT<true, true, true> EpiMergeF;
template <bool LD = true, bool ST = true, int BATCH = 16> struct EpiOutT {
    static constexpr bool PERM = false, AFTER_DRAIN = false, INIT = false, MID = false;
    const float* X; float* O;
    __device__ __forceinline__ void operator()(const f32x4 (&acc)[2][2][4][2], const Unit& u, int wr, int wc, int fr, int fq) const {
        const int row0 = u.pm * BM + wr * 64 + fr, col0 = u.pn * BM + wc * 32 + 4 * fq;
        if constexpr (BATCH == 17) {
            f32x4 x[4][2][2], r[4][2][2];
#pragma unroll
            for (int m = 0; m < 4; ++m)
#pragma unroll
                for (int bj = 0; bj < 2; ++bj)
#pragma unroll
                    for (int n = 0; n < 2; ++n) x[m][bj][n] = epi_ld<1>((const f32x4*)(X + (size_t)(row0 + m * 16) * 2048 + col0 + bj * HALF + n * 16));
#pragma unroll
            for (int m = 0; m < 4; ++m)
#pragma unroll
                for (int bj = 0; bj < 2; ++bj)
#pragma unroll
                    for (int n = 0; n < 2; ++n) r[m][bj][n] = x[m][bj][n] + acc[0][bj][m][n];
#pragma unroll
            for (int m = 0; m < 4; ++m)
#pragma unroll
                for (int bj = 0; bj < 2; ++bj)
#pragma unroll
                    for (int n = 0; n < 2; ++n) x[m][bj][n] = epi_ld<1>((const f32x4*)(X + (size_t)(row0 + HALF + m * 16) * 2048 + col0 + bj * HALF + n * 16));
#pragma unroll
            for (int m = 0; m < 4; ++m)
#pragma unroll
                for (int bj = 0; bj < 2; ++bj)
#pragma unroll
                    for (int n = 0; n < 2; ++n) epi_st<1>((f32x4*)(O + (size_t)(row0 + m * 16) * 2048 + col0 + bj * HALF + n * 16), r[m][bj][n]);
#pragma unroll
            for (int m = 0; m < 4; ++m)
#pragma unroll
                for (int bj = 0; bj < 2; ++bj)
#pragma unroll
                    for (int n = 0; n < 2; ++n) epi_st<1>((f32x4*)(O + (size_t)(row0 + HALF + m * 16) * 2048 + col0 + bj * HALF + n * 16), x[m][bj][n] + acc[1][bj][m][n]);
        } else if constexpr (BATCH == 16) {
#pragma unroll
            for (int ai = 0; ai < 2; ++ai) { f32x4 x[4][2][2];
#pragma unroll
                for (int m = 0; m < 4; ++m)
#pragma unroll
                    for (int bj = 0; bj < 2; ++bj)
#pragma unroll
                        for (int n = 0; n < 2; ++n) x[m][bj][n] = LD ? epi_ld<1>((const f32x4*)(X + (size_t)(row0 + ai * HALF + m * 16) * 2048 + col0 + bj * HALF + n * 16)) : (f32x4){1.f, 1.f, 1.f, 1.f};
#pragma unroll
                for (int m = 0; m < 4; ++m)
#pragma unroll
                    for (int bj = 0; bj < 2; ++bj)
#pragma unroll
                        for (int n = 0; n < 2; ++n) { const f32x4 v = x[m][bj][n] + acc[ai][bj][m][n]; if (ST || v[0] == 1.2345e30f) epi_st<1>((f32x4*)(O + (size_t)(row0 + ai * HALF + m * 16) * 2048 + col0 + bj * HALF + n * 16), v); } }
        } else {
#pragma unroll
        for (int ai = 0; ai < 2; ++ai)
#pragma unroll
            for (int m = 0; m < 4; ++m) { const size_t off = (size_t)(row0 + ai * HALF + m * 16) * 2048 + col0;
#pragma unroll
                for (int bj = 0; bj < 2; ++bj)
#pragma unroll
                    for (int n = 0; n < 2; ++n) { const f32x4 v = (LD ? *(const f32x4*)(X + off + bj * HALF + n * 16) : (f32x4){1.f, 1.f, 1.f, 1.f}) + acc[ai][bj][m][n]; if (ST || v[0] == 1.2345e30f) *(f32x4*)(O + off + bj * HALF + n * 16) = v; } }
        }
    }
};
typedef EpiOutT<true, true, 17> EpiOut;
template <class Epi, class Sched, bool ALIGN_EPI = false, bool SP2 = false>
__device__ __forceinline__ void gemm_phase(PG8_LAS unsigned char* lds, const Gemm g, const Sched& S, const Epi& E, const int wave_id) {
    const int wid = __builtin_amdgcn_readfirstlane(wave_id), lane = mk_lane_id(), tid = wid * 64 + lane, wr = wid >> 2, wc = wid & 3, fr = lane & 15, fq = lane >> 4;
    const int K = g.K, nt = K / BK;
    unsigned voffA[2], voffB[2];
#pragma unroll
    for (int i = 0; i < 2; ++i) { int R, C; stage_rc(tid * 16 + i * 8192, R, C); const int Rb = Epi::PERM ? ((R & ~31) + perm32(R & 31)) : R;
        voffA[i] = (unsigned)(R * K + C) * 2u; voffB[i] = (unsigned)(Rb * K + C) * 2u; }
    const size_t kstep = (size_t)(BK * 2);
    const size_t hstep = (size_t)HALF * K * 2;
    const size_t tstep = 2 * hstep;
    const unsigned ldsw = (unsigned)wid * 1024u;
    const int aoff = lds_byte(wr * 64 + fr, fq * 8), boff = lds_byte(wc * 32 + fr, fq * 8);
#define PG8_SA(b, h) (((b) * 2 + (h)) * HTB)
#define PG8_SB(b, h) ((4 + (b) * 2 + (h)) * HTB)
#define PG8_STAGE(bufoff, gbase, voff) do { _Pragma("unroll") for (int _i = 0; _i < 2; ++_i) \
        __builtin_amdgcn_global_load_lds((const unsigned*)((const char*)(gbase) + (voff)[_i]), (PG8_LAS unsigned*)(lds + (bufoff) + ldsw + _i * 8192), 16, 0, 0); } while (0)
#define PG8_LDA(dst, b, h) do { _Pragma("unroll") for (int m = 0; m < 4; ++m) _Pragma("unroll") for (int k = 0; k < 2; ++k) dst[m][k] = *(const PG8_LAS bf16x8*)(lds + PG8_SA(b, h) + aoff + m * 2048 + k * 1024); } while (0)
#define PG8_LDB(dst, b, h) do { _Pragma("unroll") for (int n = 0; n < 2; ++n) _Pragma("unroll") for (int k = 0; k < 2; ++k) dst[n][k] = *(const PG8_LAS bf16x8*)(lds + PG8_SB(b, h) + boff + n * 2048 + k * 1024); } while (0)
#define PG8_MMA(ai, bj, At, Bt) do { __builtin_amdgcn_s_setprio(1); _Pragma("unroll") for (int m = 0; m < 4; ++m) _Pragma("unroll") for (int n = 0; n < 2; ++n) _Pragma("unroll") for (int k = 0; k < 2; ++k) \
        acc[ai][bj][m][n] = __builtin_amdgcn_mfma_f32_16x16x32_bf16(Bt[n][k], At[m][k], acc[ai][bj][m][n], 0, 0, 0); __builtin_amdgcn_s_setprio(0); } while (0)
#define PG8_WAIT_V(n) asm volatile("s_waitcnt vmcnt(" #n ")" ::: "memory")
#define PG8_WAIT_L(n) asm volatile("s_waitcnt lgkmcnt(" #n ")" ::: "memory")
#define PG8_BAR __builtin_amdgcn_s_barrier()
#define PG8_SCHED __builtin_amdgcn_sched_barrier(0)
    Unit cur, nxt; int ui = 0;
    if (!S.next(0, cur)) return;
    f32x4 acc[2][2][4][2];
    if constexpr (Epi::INIT) E.init(acc, cur, wr, wc, fr, fq);
    else {
#pragma unroll
    for (int a = 0; a < 2; ++a)
#pragma unroll
        for (int b = 0; b < 2; ++b)
#pragma unroll
            for (int m = 0; m < 4; ++m)
#pragma unroll
                for (int n = 0; n < 2; ++n) acc[a][b][m][n] = (f32x4){0.f, 0.f, 0.f, 0.f};
    }
    bf16x8 At[4][2], B0[2][2], B1[2][2];
    const char* cA = (const char*)g.A + (size_t)cur.pm * tstep; const char* cB = (const char*)g.Bt + (size_t)cur.pn * tstep;
    S.a_ready(cur);
    if constexpr (SP2) {
        PG8_STAGE(PG8_SB(0, 0), cB, voffB); PG8_STAGE(PG8_SB(0, 1), cB + hstep, voffB); PG8_STAGE(PG8_SA(0, 0), cA, voffA); PG8_STAGE(PG8_SA(0, 1), cA + hstep, voffA);
        if (wr == 1) PG8_BAR;
        PG8_WAIT_V(2); PG8_BAR;
        PG8_STAGE(PG8_SB(1, 0), cB + kstep, voffB); PG8_STAGE(PG8_SA(1, 0), cA + kstep, voffA); PG8_STAGE(PG8_SB(1, 1), cB + hstep + kstep, voffB);
        PG8_WAIT_V(6); PG8_BAR;
    } else {
        PG8_STAGE(PG8_SB(0, 0), cB, voffB); PG8_STAGE(PG8_SA(0, 0), cA, voffA); PG8_STAGE(PG8_SB(0, 1), cB + hstep, voffB); PG8_STAGE(PG8_SA(0, 1), cA + hstep, voffA);
        if (wr == 1) PG8_BAR;
        PG8_WAIT_V(4); PG8_BAR;
        PG8_STAGE(PG8_SB(1, 0), cB + kstep, voffB); PG8_STAGE(PG8_SA(1, 0), cA + kstep, voffA); PG8_STAGE(PG8_SB(1, 1), cB + hstep + kstep, voffB);
        PG8_WAIT_V(6); PG8_BAR;
    }
    for (;;) {
        const bool has_next = S.next(ui + 1, nxt);
        const char* nA = has_next ? (const char*)g.A + (size_t)nxt.pm * tstep : cA; const char* nB = has_next ? (const char*)g.Bt + (size_t)nxt.pn * tstep : cB;
        for (int t = 0; t < nt; t += 2) {
            const bool last = (t == nt - 2);
            const char* a1 = cA + (size_t)(t + 1) * kstep;
            const char* a2 = last ? nA : cA + (size_t)(t + 2) * kstep; const char* b2 = last ? nB : cB + (size_t)(t + 2) * kstep;
            const char* a3 = a2 + kstep; const char* b3 = b2 + kstep;
            if (last && has_next) S.a_ready(nxt);
            if constexpr (Epi::MID) { if (t == nt / 2) E.mid(acc, cur, wr, wc, fr, fq); }
            if constexpr (SP2) {
            PG8_LDB(B0, 0, 0); PG8_LDB(B1, 0, 1); PG8_SCHED; PG8_LDA(At, 0, 0); PG8_STAGE(PG8_SA(1, 1), a1 + hstep, voffA);
            PG8_WAIT_V(8); PG8_WAIT_L(0); PG8_BAR; PG8_MMA(0, 0, At, B0); PG8_MMA(0, 1, At, B1); PG8_BAR; PG8_SCHED;
            PG8_LDA(At, 0, 1); PG8_STAGE(PG8_SB(0, 0), b2, voffB); PG8_STAGE(PG8_SB(0, 1), b2 + hstep, voffB); PG8_STAGE(PG8_SA(0, 0), a2, voffA);
            PG8_WAIT_V(8); PG8_WAIT_L(0); PG8_BAR; PG8_MMA(1, 0, At, B0); PG8_MMA(1, 1, At, B1); PG8_BAR; PG8_SCHED;
            PG8_LDB(B0, 1, 0); PG8_LDB(B1, 1, 1); PG8_SCHED; PG8_LDA(At, 1, 0); PG8_STAGE(PG8_SA(0, 1), a2 + hstep, voffA);
            PG8_WAIT_V(8); PG8_WAIT_L(0); PG8_BAR; PG8_MMA(0, 0, At, B0); PG8_MMA(0, 1, At, B1); PG8_BAR; PG8_SCHED;
            PG8_LDA(At, 1, 1); PG8_STAGE(PG8_SB(1, 0), b3, voffB); PG8_STAGE(PG8_SB(1, 1), b3 + hstep, voffB); PG8_STAGE(PG8_SA(1, 0), a3, voffA);
            PG8_WAIT_V(8); PG8_WAIT_L(0); PG8_BAR; PG8_MMA(1, 0, At, B0); PG8_MMA(1, 1, At, B1); PG8_BAR; PG8_SCHED;
            } else {
            PG8_LDB(B0, 0, 0); PG8_SCHED; PG8_LDA(At, 0, 0); PG8_STAGE(PG8_SA(1, 1), a1 + hstep, voffA);
            PG8_WAIT_L(8); PG8_BAR; PG8_WAIT_L(0); PG8_MMA(0, 0, At, B0); PG8_BAR; PG8_SCHED;
            PG8_LDB(B1, 0, 1); PG8_STAGE(PG8_SB(0, 0), b2, voffB);
            PG8_BAR; PG8_WAIT_L(0); PG8_MMA(0, 1, At, B1); PG8_BAR;
            PG8_LDA(At, 0, 1); PG8_STAGE(PG8_SA(0, 0), a2, voffA);
            PG8_BAR; PG8_WAIT_L(0); PG8_MMA(1, 0, At, B0); PG8_BAR; PG8_SCHED;
            PG8_STAGE(PG8_SB(0, 1), b2 + hstep, voffB);
            PG8_WAIT_V(6); PG8_BAR; PG8_MMA(1, 1, At, B1); PG8_BAR;
            PG8_LDB(B0, 1, 0); PG8_SCHED; PG8_LDA(At, 1, 0); PG8_STAGE(PG8_SA(0, 1), a2 + hstep, voffA);
            PG8_WAIT_L(8); PG8_BAR; PG8_WAIT_L(0); PG8_MMA(0, 0, At, B0); PG8_BAR; PG8_SCHED;
            PG8_LDB(B1, 1, 1); PG8_STAGE(PG8_SB(1, 0), b3, voffB);
            PG8_BAR; PG8_WAIT_L(0); PG8_MMA(0, 1, At, B1); PG8_BAR;
            PG8_LDA(At, 1, 1); PG8_STAGE(PG8_SA(1, 0), a3, voffA);
            PG8_BAR; PG8_WAIT_L(0); PG8_MMA(1, 0, At, B0); PG8_BAR; PG8_SCHED;
            PG8_STAGE(PG8_SB(1, 1), b3 + hstep, voffB);
            PG8_WAIT_V(6); PG8_BAR; PG8_MMA(1, 1, At, B1); PG8_BAR;
            }
        }
        if constexpr (ALIGN_EPI) { if (wr == 0) PG8_BAR; }
        if constexpr (!Epi::AFTER_DRAIN) { E(acc, cur, wr, wc, fr, fq); S.done(cur); }
        if (!has_next) break;
        if constexpr (Epi::INIT) E.init(acc, nxt, wr, wc, fr, fq);
        else {
#pragma unroll
        for (int a = 0; a < 2; ++a)
#pragma unroll
            for (int b = 0; b < 2; ++b)
#pragma unroll
                for (int m = 0; m < 4; ++m)
#pragma unroll
                    for (int n = 0; n < 2; ++n) acc[a][b][m][n] = (f32x4){0.f, 0.f, 0.f, 0.f};
        }
        cur = nxt; cA = nA; cB = nB; ++ui;
        if constexpr (ALIGN_EPI) { if (wr == 1) PG8_BAR; }
    }
    PG8_WAIT_V(0);
    if constexpr (!ALIGN_EPI) { if (wr == 0) PG8_BAR; }
    PG8_BAR;
    if constexpr (Epi::AFTER_DRAIN) { E.fused(acc, cur, wr, wc, fr, fq, lds, wid, lane); S.done(cur); }
#undef PG8_SA
#undef PG8_SB
#undef PG8_STAGE
#undef PG8_LDA
#undef PG8_LDB
#undef PG8_MMA
#undef PG8_WAIT_V
#undef PG8_WAIT_L
#undef PG8_BAR
#undef PG8_SCHED
}
}
#define GAS __attribute__((address_space(1)))
#define LAS __attribute__((address_space(3)))
typedef unsigned short bf16;
typedef unsigned v4u __attribute__((ext_vector_type(4)));
typedef float f32x4 __attribute__((ext_vector_type(4)));
typedef short bf16x8 __attribute__((ext_vector_type(8)));
typedef GAS unsigned gu32;
typedef GAS unsigned long long gu64;
#define RLX_AGENT __ATOMIC_RELAXED, __HIP_MEMORY_SCOPE_AGENT
#define LDS_WAIT() asm volatile("s_waitcnt lgkmcnt(0)" ::: "memory")
#define VM_WAIT() asm volatile("s_waitcnt vmcnt(0)" ::: "memory")
__device__ __forceinline__ unsigned long long rt() { return __builtin_amdgcn_s_memrealtime(); }
__device__ __forceinline__ unsigned f2bf(float f) { unsigned u = __builtin_bit_cast(unsigned, f); return (u + 0x7fffu + ((u >> 16) & 1u)) >> 16; }
__device__ __forceinline__ unsigned pk2(float lo, float hi) { return f2bf(lo) | (f2bf(hi) << 16); }

#define XB_TMO      128
#define XB_XCNT(j)  (256  + 64 * (j))
#define XB_XSUB(j)  (1280 + 64 * (j))
#define XB_XGEN(j)  (2304 + 64 * (j))
#define XB_TOP      3328
#define XB_TOPGEN   3392
#define XCD_BAR_WORDS 3456
#define XB_SPIN_CAP (1u << 18)

__device__ __forceinline__ unsigned xb_ld(unsigned* p)              { return __hip_atomic_load(p, __ATOMIC_RELAXED, __HIP_MEMORY_SCOPE_AGENT); }
__device__ __forceinline__ unsigned xb_add(unsigned* p, unsigned v) { return __hip_atomic_fetch_add(p, v, __ATOMIC_RELAXED, __HIP_MEMORY_SCOPE_AGENT); }
__device__ __forceinline__ unsigned xb_xcc_id() { return (unsigned)__builtin_amdgcn_s_getreg((3 << 11) | 20) & 0xFu; }
#define XB_SPIN(cond, bar) do { unsigned _sp = 0; while (cond) { __builtin_amdgcn_s_sleep(1); \
    if ((++_sp & 255u) == 0u) { if (xb_ld(&(bar)[XB_TMO])) break; if (_sp > XB_SPIN_CAP) { atomicAdd(&(bar)[XB_TMO], 1u); break; } } } } while (0)

struct XcdBarrier {
    unsigned* bar; unsigned x;
    volatile LAS unsigned* st;
};

__device__ __forceinline__ XcdBarrier xcd_barrier_post(unsigned* bar, volatile LAS unsigned* st, const bool t0) {
    XcdBarrier b; b.bar = bar; b.x = xb_xcc_id(); b.st = st;
    if (t0) (void)xb_add(&bar[XB_XCNT(b.x)], 1u);
    return b;
}
__device__ __forceinline__ void xcd_barrier_complete(unsigned* bar, unsigned x, unsigned& nloc, unsigned& nx) {
    const unsigned G = gridDim.x * gridDim.y * gridDim.z;
    unsigned sum, cnt, mine, sp = 0u;
    for (;;) {
        sum = 0u; cnt = 0u; mine = 0u;
#pragma unroll
        for (unsigned j = 0; j < 16; ++j) { const unsigned c = xb_ld(&bar[XB_XCNT(j)]); sum += c; cnt += (c > 0u) ? 1u : 0u; mine = (j == x) ? c : mine; }
        if (sum == G) break;
        __builtin_amdgcn_s_sleep(1);
        if ((++sp & 255u) == 0u) { if (xb_ld(&bar[XB_TMO])) break; if (sp > XB_SPIN_CAP) { atomicAdd(&bar[XB_TMO], 1u); break; } }
    }
    nloc = mine > 0u ? mine : 1u; nx = cnt > 0u ? cnt : 1u;
}

__device__ __forceinline__ void xcd_barrier_a() {
    asm volatile("s_waitcnt vmcnt(0)" ::: "memory");
    __syncthreads();
}
__device__ __forceinline__ void xcd_barrier_b(const XcdBarrier& b, const bool t0) {
    if (t0) {
        unsigned* bar = b.bar;
        __builtin_amdgcn_s_waitcnt(0);
        unsigned nloc = b.st[0], nx = b.st[1];
        if (nloc == 0u) { xcd_barrier_complete(bar, b.x, nloc, nx); b.st[0] = nloc; b.st[1] = nx; }
        const unsigned old = xb_add(&bar[XB_XSUB(b.x)], 1u);
        const unsigned gen = old / nloc;
        if (old + 1u == (gen + 1u) * nloc) {
            __builtin_amdgcn_fence(__ATOMIC_RELEASE, "agent");
            asm volatile("s_waitcnt vmcnt(0)" ::: "memory");
            const unsigned og = xb_add(&bar[XB_TOP], 1u);
            const unsigned tg = og / nx;
            if (og + 1u == (tg + 1u) * nx) xb_add(&bar[XB_TOPGEN], 1u);
            else XB_SPIN(xb_ld(&bar[XB_TOPGEN]) == tg, bar);
            __builtin_amdgcn_fence(__ATOMIC_ACQUIRE, "agent");
            xb_add(&bar[XB_XGEN(b.x)], 1u);
            asm volatile("s_waitcnt vmcnt(0)" ::: "memory");
        } else {
            XB_SPIN(xb_ld(&bar[XB_XGEN(b.x)]) == gen, bar);
            __builtin_amdgcn_fence(__ATOMIC_ACQUIRE, "agent");
            asm volatile("s_waitcnt vmcnt(0)" ::: "memory");
        }
    }
    __syncthreads();
}
__device__ __forceinline__ void xcd_barrier(const XcdBarrier& b, const bool t0) { xcd_barrier_a(); xcd_barrier_b(b, t0); }
namespace attn_body {
using bf16=__hip_bfloat16;
using bf16x8=__attribute__((ext_vector_type(8)))short;
using s16x4=__attribute__((ext_vector_type(4)))short;
using f32x16=__attribute__((ext_vector_type(16)))float;
using u32x4=__attribute__((ext_vector_type(4)))unsigned;
constexpr int BATCH=8,NHEAD=16,SEQ=2048,D=64,DM=3072,OPITCH=2048,ZPITCH=1024;
constexpr int NW=8,QBLK=32,QB=QBLK*NW,KVBLK=64,NQB=SEQ/QB;
constexpr int ATTN_PITCH=DM, ATTN_UNIT_ROWS=QB;
__device__ __forceinline__ int crow(int r,int hi){return (r&3)+8*(r>>2)+4*hi;}
#define SBAR() __builtin_amdgcn_sched_barrier(0)
__device__ __forceinline__ void cmask(f32x16&p0,f32x16&p1,int jb,int qrel,int hi){
  const float NEG=-INFINITY; int kb=64*jb+4*hi;
  #pragma unroll
  for(int r=0;r<16;++r){int kv=kb+(r&3)+8*(r>>2); if(kv>qrel)p0[r]=NEG; if(kv+32>qrel)p1[r]=NEG;}
}

constexpr int NSLOT=3, SLOTB=8192;
constexpr int LDS_K=0, LDS_V=NSLOT*SLOTB, LDS_WS=2*NSLOT*SLOTB, LDS_OST=LDS_WS+NW*64*4, LDS_BYTES=LDS_OST+NW*4096;
constexpr float C2=0.125f*1.4426950408889634f;
__device__ __forceinline__ float bflo(unsigned w){return __uint_as_float(w<<16);}
__device__ __forceinline__ float bfhi(unsigned w){return __uint_as_float(w&0xffff0000u);}
__device__ __forceinline__ float bfs(short v){return __uint_as_float(((unsigned)(unsigned short)v)<<16);}
__device__ __forceinline__ void glds16(const void*gsrc,unsigned lds_dst){unsigned keep;
  asm volatile("s_mov_b32 %0, m0\n\ts_mov_b32 m0, %2\n\ts_nop 0\n\tglobal_load_lds_dwordx4 %1, off\n\ts_mov_b32 m0, %0":"=&s"(keep):"v"(gsrc),"s"(lds_dst):"memory");}
__device__ __forceinline__ float max3f(float a,float b,float c){float r;asm("v_max3_f32 %0, %1, %2, %3":"=v"(r):"v"(a),"v"(b),"v"(c));return r;}
__device__ __forceinline__ float max2f(float a,float b){float r;asm("v_max_f32_e32 %0, %1, %2":"=v"(r):"v"(a),"v"(b));return r;}
__device__ __forceinline__ float fadd_s(float a,float b){float r;asm("v_add_f32_e32 %0, %1, %2":"=v"(r):"v"(a),"v"(b));return r;}
__device__ __forceinline__ float fsub_s(float a,float b){float r;asm("v_sub_f32_e32 %0, %1, %2":"=v"(r):"v"(a),"v"(b));return r;}
typedef float f32x2_t __attribute__((ext_vector_type(2))); typedef __bf16 bf16x2_t __attribute__((ext_vector_type(2)));
__device__ __forceinline__ unsigned cvtpk_s(float lo,float hi){f32x2_t v={lo,hi};bf16x2_t b=__builtin_convertvector(v,bf16x2_t);return __builtin_bit_cast(unsigned,b);}
#define WAIT_BAR(N) asm volatile("s_waitcnt vmcnt(" #N ") lgkmcnt(0)\n\ts_barrier":::"memory")

__device__ __forceinline__ void qkt(f32x16&p0,f32x16&p1,const char*Kslot,const bf16x8*qr,const f32x16&negm,int r32,int hi){
  const char*kb=Kslot+hi*1024+r32*16;
  #pragma unroll
  for(int d0=0;d0<4;++d0){
    const bf16x8 b0=*reinterpret_cast<const bf16x8*>(kb+d0*2048);
    const bf16x8 b1=*reinterpret_cast<const bf16x8*>(kb+d0*2048+512);
    if(d0==0){p0=__builtin_amdgcn_mfma_f32_32x32x16_bf16(b0,qr[0],negm,0,0,0);p1=__builtin_amdgcn_mfma_f32_32x32x16_bf16(b1,qr[0],negm,0,0,0);}
    else{p0=__builtin_amdgcn_mfma_f32_32x32x16_bf16(b0,qr[d0],p0,0,0,0);p1=__builtin_amdgcn_mfma_f32_32x32x16_bf16(b1,qr[d0],p1,0,0,0);}}
}
typedef __attribute__((address_space(3))) const char* lds_cptr;
typedef short v4i16_t __attribute__((ext_vector_type(4)));
__device__ __forceinline__ void kload8(bf16x8*kf,lds_cptr kp){
  kf[0]=*(const __attribute__((address_space(3))) bf16x8*)(kp);      kf[1]=*(const __attribute__((address_space(3))) bf16x8*)(kp+512);
  kf[2]=*(const __attribute__((address_space(3))) bf16x8*)(kp+2048); kf[3]=*(const __attribute__((address_space(3))) bf16x8*)(kp+2560);
  kf[4]=*(const __attribute__((address_space(3))) bf16x8*)(kp+4096); kf[5]=*(const __attribute__((address_space(3))) bf16x8*)(kp+4608);
  kf[6]=*(const __attribute__((address_space(3))) bf16x8*)(kp+6144); kf[7]=*(const __attribute__((address_space(3))) bf16x8*)(kp+6656);
}
__device__ __forceinline__ void kload2(bf16x8*kf,lds_cptr kp,int j){ kf[2*j]=*(const __attribute__((address_space(3))) bf16x8*)(kp+j*2048); kf[2*j+1]=*(const __attribute__((address_space(3))) bf16x8*)(kp+j*2048+512); }
__device__ __forceinline__ s16x4 vtr(lds_cptr p){ return __builtin_bit_cast(s16x4,__builtin_amdgcn_ds_read_tr16_b64_v4i16((__attribute__((address_space(3))) v4i16_t*)p)); }
__device__ __forceinline__ float rowmax(const f32x16&p0,const f32x16&p1){
  float a=max3f(p0[0],p0[1],p1[0]),b=max3f(p0[2],p0[3],p1[1]);a=max3f(a,p1[2],p1[3]);
  #pragma unroll
  for(int r=4;r<16;r+=4){a=max3f(a,p0[r],p0[r+1]);b=max3f(b,p0[r+2],p0[r+3]);a=max3f(a,p1[r],p1[r+1]);b=max3f(b,p1[r+2],p1[r+3]);}
  const float m=max2f(a,b);
  auto rr=__builtin_amdgcn_permlane32_swap(__float_as_uint(m),__float_as_uint(m),false,false);
  return max2f(__uint_as_float(rr[0]),__uint_as_float(rr[1]));
}
__device__ __forceinline__ void pv(f32x16*o,int vb,bf16x8 pa0,bf16x8 pa1,bf16x8 pa2,bf16x8 pa3){
  #pragma unroll
  for(int d0=0;d0<2;++d0){s16x4 lo[4],hi[4];
    #pragma unroll
    for(int ks=0;ks<4;++ks){
      asm volatile("ds_read_b64_tr_b16 %0,%1 offset:%c2":"=&v"(lo[ks]):"v"(vb),"i"(d0*4096+ks*1024):"memory");
      asm volatile("ds_read_b64_tr_b16 %0,%1 offset:%c2":"=&v"(hi[ks]):"v"(vb),"i"(d0*4096+ks*1024+512):"memory");}
    asm volatile("s_waitcnt lgkmcnt(0)":::"memory");SBAR();
    #define PK(k) (bf16x8){lo[k][0],lo[k][1],lo[k][2],lo[k][3],hi[k][0],hi[k][1],hi[k][2],hi[k][3]}
    o[d0]=__builtin_amdgcn_mfma_f32_32x32x16_bf16(pa0,PK(0),o[d0],0,0,0);
    o[d0]=__builtin_amdgcn_mfma_f32_32x32x16_bf16(pa1,PK(1),o[d0],0,0,0);
    o[d0]=__builtin_amdgcn_mfma_f32_32x32x16_bf16(pa2,PK(2),o[d0],0,0,0);
    o[d0]=__builtin_amdgcn_mfma_f32_32x32x16_bf16(pa3,PK(3),o[d0],0,0,0);
    #undef PK
  }
}

#ifndef ATTN_STORE16
#define ATTN_STORE16(p,v) (*(u32x4*)(p)=(v))
#endif
template<int THRL> __device__ __forceinline__ void attn_unit(int b,int h,int qb,const bf16*Q,const bf16*__restrict__ K,const bf16*__restrict__ V,bf16*O,const bf16*__restrict__ ZB,const float*__restrict__ KMEAN,char*shm,const int wave_id){
  const int wid=__builtin_amdgcn_readfirstlane(wave_id); const int lane=mk_lane_id(),tid=wid*64+lane,r32=lane&31,hi=lane>>5; (void)tid;
  const long rowbase=(long)b*SEQ; const int q0=qb*QB;
  const bf16*Qw=Q+(rowbase+q0+wid*QBLK)*DM+h*D;
  const bf16*Kh=K+rowbase*DM+h*D,*Vh=V+rowbase*DM+h*D;
  const unsigned lds0=(unsigned)(uintptr_t)shm;
  float*wsf=(float*)(shm+LDS_WS)+wid*64;
  const bf16*ksrc=Kh+(long)lane*DM+wid*8;
  const bf16*vsrc=Vh+(long)(16*(wid&3)+(lane>>2))*DM+(wid>>2)*32+(lane&3)*8;
  const unsigned kdst=lds0+LDS_K+wid*1024, vdst=lds0+LDS_V+wid*1024;
  #define TROW(t) (((t)<4)?(q0+64*(t)):(64*((t)-4)))
  #define DMA_K(t,slot) glds16(ksrc+(long)TROW(t)*DM,(unsigned)__builtin_amdgcn_readfirstlane(kdst+(slot)))
  #define DMA_V(t,slot) glds16(vsrc+(long)TROW(t)*DM,(unsigned)__builtin_amdgcn_readfirstlane(vdst+(slot)))
  const int vb0=(int)(lds0+LDS_V)+((lane>>4)&1)*32+(lane&3)*8+(4*hi+((lane&15)>>2))*64;
  const char*Kbase=shm+LDS_K; bf16x8 kf[8];
  const lds_cptr shm3=(lds_cptr)shm; const lds_cptr kp0=shm3+LDS_K+hi*1024+r32*16; const lds_cptr vp0=shm3+LDS_V+((lane>>4)&1)*32+(lane&3)*8+(4*hi+((lane&15)>>2))*64;
  const int NT=(q0+QB)/KVBLK;
  DMA_K(0,0);DMA_V(0,0);DMA_K(1,SLOTB);
  bf16x8 qr[4];
  #pragma unroll
  for(int d0=0;d0<4;++d0)qr[d0]=*reinterpret_cast<const bf16x8*>(&Qw[(long)r32*DM+d0*16+hi*8]);
  float mhat=0.f,l_reg=0.f;f32x16 o[2];o[0]=f32x16{};o[1]=f32x16{};f32x16 negm=f32x16{};asm volatile("":"+v"(negm));
  const int qrel=wid*QBLK+r32;
  unsigned selm=(1u<<qb)-1u;
  if(qb>3){ float g[7];
    #pragma unroll
    for(int n=0;n<7;++n){ g[n]=-INFINITY; if(n<qb){ const float*km=KMEAN+(((long)b*NHEAD+h)*8+n)*64+hi*8; float acc_=0.f;
        #pragma unroll
        for(int d0=0;d0<4;++d0){ const float4 k0=*reinterpret_cast<const float4*>(km+d0*16), k1=*reinterpret_cast<const float4*>(km+d0*16+4); const bf16x8 qv_=qr[d0];
          acc_+=bfs(qv_[0])*k0.x+bfs(qv_[1])*k0.y+bfs(qv_[2])*k0.z+bfs(qv_[3])*k0.w+bfs(qv_[4])*k1.x+bfs(qv_[5])*k1.y+bfs(qv_[6])*k1.z+bfs(qv_[7])*k1.w; }
        auto rr=__builtin_amdgcn_permlane32_swap(__float_as_uint(acc_),__float_as_uint(acc_),false,false); g[n]=__uint_as_float(rr[0])+__uint_as_float(rr[1]); } }
    selm=0u;
    #pragma unroll
    for(int n=0;n<7;++n){ int rank=0;
      #pragma unroll
      for(int m_=0;m_<7;++m_) if(m_!=n) rank+=(g[m_]>g[n]||(g[m_]==g[n]&&m_<n))?1:0;
      if(n<qb&&rank<3) selm|=1u<<n; } }
  #define CMASK(P0,P1,t) do{int jb_=(t); if(jb_<4)cmask(P0,P1,jb_,qrel,hi);}while(0)
  bool resc=false;
  #define START(P0,P1) do{ const float rm=rowmax(P0,P1); resc=false; \
    { const float dl=rm; mhat=fadd_s(mhat,dl); \
      _Pragma("unroll") for(int r=0;r<16;++r){P0[r]=fsub_s(P0[r],dl);P1[r]=fsub_s(P1[r],dl);} \
      _Pragma("unroll") for(int r=0;r<16;++r)negm[r]=-mhat; asm volatile("":"+v"(negm)); } \
    _Pragma("unroll") for(int r=0;r<16;++r)P0[r]=__builtin_amdgcn_exp2f(P0[r]); }while(0)
  #define RESC() do{ if(resc){ asm volatile("s_waitcnt lgkmcnt(0)":::"memory"); \
      _Pragma("unroll") for(int d_=0;d_<2;++d_) _Pragma("unroll") for(int r=0;r<16;++r)o[d_][r]*=wsf[crow(r,hi)]; } }while(0)
  f32x16 pA0,pA1,pB0,pB1;
  int sl_prev=0,sl_cur=0,sl_next=SLOTB;
  #define ROT() do{sl_prev=sl_cur;sl_cur=sl_next;sl_next=(sl_next==(NSLOT-1)*SLOTB)?0:sl_next+SLOTB;}while(0)
  DMA_K(2,2*SLOTB);
  WAIT_BAR(3);
  qkt(pA0,pA1,Kbase,qr,negm,r32,hi);asm volatile("s_nop 15\n\ts_nop 7":"+v"(pA0),"+v"(pA1));CMASK(pA0,pA1,0);
  START(pA0,pA1);
  _Pragma("unroll") for(int r=0;r<16;++r)pA1[r]=__builtin_amdgcn_exp2f(pA1[r]);
  WAIT_BAR(0);
  DMA_K(3,0);DMA_V(1,SLOTB);
  ROT();
  kload8(kf,kp0+sl_cur);
  WAIT_BAR(2);
  s16x4 vlo[8],vhi[8]; u32x4 pw0,pw1,pw2,pw3;
  #define PKW(P,B) cvtpk_s(P[B],P[B+1])
  #define PAF(k) __builtin_bit_cast(bf16x8,pw##k)
  #define VFR(i) (bf16x8){vlo[i][0],vlo[i][1],vlo[i][2],vlo[i][3],vhi[i][0],vhi[i][1],vhi[i][2],vhi[i][3]}
  #define PIN(x) asm volatile("":"+v"(x))
  #define MX3(a,b,c) __builtin_fmaxf(__builtin_fmaxf((a),(b)),(c))
  #define GAPA(MF,A0,A1,A2,A3,W0,W1,PW) do{ MF; sacc+=A0; sacc+=A1; sacc+=A2; sacc+=A3; PIN(sacc); W0; W1; PIN(PW); SBAR(); }while(0)
  #define EX(v) __builtin_amdgcn_exp2f(v)
  #define GAPB(MF,X,B) do{ MF; X[B]=EX(X[B]); X[B+1]=EX(X[B+1]); X[B+2]=EX(X[B+2]); X[B+3]=EX(X[B+3]); PIN(X); SBAR(); }while(0)
  #define VRD(i) do{ vlo[i]=vtr(vp_+(((i)>>2)*4096+((i)&3)*1024)); vhi[i]=vtr(vp_+(((i)>>2)*4096+((i)&3)*1024+512)); }while(0)
  #define KRD(G,j) do{ if(G){ kload2(kf,kp0+sl_next,j); SBAR(); } }while(0)
  #define STEP(C0,C1,P0,P1,t,GK,GV,GL) do{ SBAR(); \
    { const float ci_=(((t)<4)||((selm>>(((t)-4)>>2))&1u))?-mhat:-INFINITY; _Pragma("unroll") for(int r=0;r<16;++r)negm[r]=ci_; asm volatile("":"+v"(negm)); } SBAR(); \
    const lds_cptr vp_=vp0+sl_prev; \
    VRD(0); SBAR(); float sacc=(P0[0]+P0[1]); \
    GAPA(C0=__builtin_amdgcn_mfma_f32_32x32x16_bf16(kf[0],qr[0],negm,0,0,0), P0[2],P0[3],P0[4],P0[5],     pw0[0]=PKW(P0,0), pw0[1]=PKW(P0,2), pw0); \
    VRD(4); SBAR(); GAPA(C1=__builtin_amdgcn_mfma_f32_32x32x16_bf16(kf[1],qr[0],negm,0,0,0), P0[6],P0[7],P0[8],P0[9],     pw0[2]=PKW(P0,4), pw0[3]=PKW(P0,6), pw0); \
    VRD(1); SBAR(); GAPA(C0=__builtin_amdgcn_mfma_f32_32x32x16_bf16(kf[2],qr[1],C0,0,0,0),   P0[10],P0[11],P0[12],P0[13], pw1[0]=PKW(P0,8), pw1[1]=PKW(P0,10), pw1); \
    VRD(5); SBAR(); GAPA(C1=__builtin_amdgcn_mfma_f32_32x32x16_bf16(kf[3],qr[1],C1,0,0,0),   P0[14],P0[15],P1[0],P1[1],   pw1[2]=PKW(P0,12),pw1[3]=PKW(P0,14), pw1); \
    VRD(2); SBAR(); GAPA(C0=__builtin_amdgcn_mfma_f32_32x32x16_bf16(kf[4],qr[2],C0,0,0,0),   P1[2],P1[3],P1[4],P1[5],     pw2[0]=PKW(P1,0), pw2[1]=PKW(P1,2), pw2); \
    VRD(6); SBAR(); GAPA(C1=__builtin_amdgcn_mfma_f32_32x32x16_bf16(kf[5],qr[2],C1,0,0,0),   P1[6],P1[7],P1[8],P1[9],     pw2[2]=PKW(P1,4), pw2[3]=PKW(P1,6), pw2); \
    VRD(3); SBAR(); GAPA(C0=__builtin_amdgcn_mfma_f32_32x32x16_bf16(kf[6],qr[3],C0,0,0,0),   P1[10],P1[11],P1[12],P1[13], pw3[0]=PKW(P1,8), pw3[1]=PKW(P1,10), pw3); \
    VRD(7); SBAR(); GAPA(C1=__builtin_amdgcn_mfma_f32_32x32x16_bf16(kf[7],qr[3],C1,0,0,0),   P1[14],P1[15],0.f,0.f,       pw3[2]=PKW(P1,12),pw3[3]=PKW(P1,14), pw3); \
    l_reg+=sacc; \
    if(GK){DMA_K((t)+3,sl_cur);} if(GV){DMA_V((t)+1,sl_next);} \
    CMASK(C0,C1,t); \
    { float a=MX3(C0[0],C0[1],C1[0]),b=MX3(C0[2],C0[3],C1[1]); a=MX3(a,C1[2],C1[3]); \
      _Pragma("unroll") for(int r=4;r<16;r+=4){a=MX3(a,C0[r],C0[r+1]);b=MX3(b,C0[r+2],C0[r+3]);a=MX3(a,C1[r],C1[r+1]);b=MX3(b,C1[r+2],C1[r+3]);} \
      float rm=__builtin_fmaxf(a,b); { auto rr=__builtin_amdgcn_permlane32_swap(__float_as_uint(rm),__float_as_uint(rm),false,false); rm=__builtin_fmaxf(__uint_as_float(rr[0]),__uint_as_float(rr[1])); } \
      resc=false; \
      if(__builtin_expect(__any(rm>(float)THRL),0)){ const float dl=__builtin_fmaxf(rm,0.f); mhat+=dl; \
        _Pragma("unroll") for(int r=0;r<16;++r){C0[r]-=dl;C1[r]-=dl;} \
        _Pragma("unroll") for(int r=0;r<16;++r)negm[r]=-mhat; asm volatile("":"+v"(negm)); \
        const float f=__builtin_amdgcn_exp2f(-dl); l_reg*=f; if(hi==0)wsf[r32]=f; resc=true; } } \
    SBAR(); \
    GAPB(o[0]=__builtin_amdgcn_mfma_f32_32x32x16_bf16(PAF(0),VFR(0),o[0],0,0,0), C0,0); \
    GAPB(o[1]=__builtin_amdgcn_mfma_f32_32x32x16_bf16(PAF(0),VFR(4),o[1],0,0,0), C0,4); \
    KRD(GL,0); GAPB(o[0]=__builtin_amdgcn_mfma_f32_32x32x16_bf16(PAF(1),VFR(1),o[0],0,0,0), C0,8); \
    KRD(GL,1); GAPB(o[1]=__builtin_amdgcn_mfma_f32_32x32x16_bf16(PAF(1),VFR(5),o[1],0,0,0), C0,12); \
    KRD(GL,2); GAPB(o[0]=__builtin_amdgcn_mfma_f32_32x32x16_bf16(PAF(2),VFR(2),o[0],0,0,0), C1,0); \
    KRD(GL,3); GAPB(o[1]=__builtin_amdgcn_mfma_f32_32x32x16_bf16(PAF(2),VFR(6),o[1],0,0,0), C1,4); \
    GAPB(o[0]=__builtin_amdgcn_mfma_f32_32x32x16_bf16(PAF(3),VFR(3),o[0],0,0,0), C1,8); \
    GAPB(o[1]=__builtin_amdgcn_mfma_f32_32x32x16_bf16(PAF(3),VFR(7),o[1],0,0,0), C1,12); \
    }while(0)
  int t=1;
  #define ENDW(tt) do{ if((tt)+3<NT){WAIT_BAR(2);} else if((tt)+2<NT){WAIT_BAR(1);} else {WAIT_BAR(0);} }while(0)
  for(;t+1<NT;t+=2){
    STEP(pB0,pB1,pA0,pA1,t,(t+3<NT),(t+1<NT),(t+1<NT));       ENDW(t);   RESC(); ROT();
    STEP(pA0,pA1,pB0,pB1,t+1,(t+4<NT),(t+2<NT),(t+2<NT));     ENDW(t+1); RESC(); ROT();
  }
  STEP(pB0,pB1,pA0,pA1,NT-1,false,false,false); RESC();
  { float sacc=pB0[0]+pB0[1]; _Pragma("unroll") for(int r=2;r<16;++r)sacc+=pB0[r]; _Pragma("unroll") for(int r=0;r<16;++r)sacc+=pB1[r]; l_reg+=sacc;
    pw0=(u32x4){PKW(pB0,0),PKW(pB0,2),PKW(pB0,4),PKW(pB0,6)};pw1=(u32x4){PKW(pB0,8),PKW(pB0,10),PKW(pB0,12),PKW(pB0,14)};pw2=(u32x4){PKW(pB1,0),PKW(pB1,2),PKW(pB1,4),PKW(pB1,6)};pw3=(u32x4){PKW(pB1,8),PKW(pB1,10),PKW(pB1,12),PKW(pB1,14)};
    SBAR(); pv(o,vb0+sl_cur,PAF(0),PAF(1),PAF(2),PAF(3)); }
  #undef PKW
  #undef PAF
  #undef VFR
  #undef PIN
  #undef MX3
  #undef GAPA
  #undef GAPB
  #undef EX
  #undef VRD
  #undef KRD
  #undef STEP
  #undef ENDW
  {auto rr=__builtin_amdgcn_permlane32_swap(__float_as_uint(l_reg),__float_as_uint(l_reg),false,false);l_reg=__uint_as_float(rr[0])+__uint_as_float(rr[1]);}
  if(hi==0)wsf[32+r32]=l_reg;asm volatile("s_waitcnt lgkmcnt(0)":::"memory");
  float rli[16];
  #pragma unroll
  for(int r=0;r<16;++r)rli[r]=__builtin_amdgcn_rcpf(wsf[32+crow(r,hi)]);
  bf16*Ow=O+(rowbase+q0+wid*QBLK)*OPITCH+h*D; const bf16*Zw=ZB+(rowbase+q0+wid*QBLK)*ZPITCH+h*D;
  { bf16*stg=(bf16*)(shm+LDS_OST)+wid*2048;
    #pragma unroll
    for(int r=0;r<16;++r){const int orow=crow(r,hi);
      #pragma unroll
      for(int d0=0;d0<2;++d0)stg[orow*64+d0*32+r32]=__float2bfloat16(o[d0][r]*rli[r]);}
    asm volatile("s_waitcnt lgkmcnt(0)":::"memory");
    #pragma unroll
    for(int i=0;i<4;++i){const int row=i*8+(lane>>3),ch=lane&7; const u32x4 v=*(const u32x4*)(stg+row*64+ch*8); const u32x4 z=*(const u32x4*)(Zw+(long)row*ZPITCH+ch*8); u32x4 w;
      w.x=cvtpk_s(bflo(v.x)*bflo(z.x),bfhi(v.x)*bfhi(z.x)); w.y=cvtpk_s(bflo(v.y)*bflo(z.y),bfhi(v.y)*bfhi(z.y)); w.z=cvtpk_s(bflo(v.z)*bflo(z.z),bfhi(v.z)*bfhi(z.z)); w.w=cvtpk_s(bflo(v.w)*bflo(z.w),bfhi(v.w)*bfhi(z.w));
      ATTN_STORE16(Ow+(long)row*OPITCH+ch*8,w);} }
  asm volatile("s_waitcnt lgkmcnt(0)\n\ts_barrier":::"memory");
  #undef DMA_K
  #undef DMA_V
  #undef CMASK
  #undef START
  #undef RESC
  #undef ROT
}
constexpr int ATTN_LDS_BYTES=LDS_BYTES;
struct AttnTensors { const bf16* Q; const bf16* K; const bf16* V; bf16* O; const bf16* ZB; const float* KMEAN; };
struct AttnUnit { int bh; int qb; };
struct StaticOrder {
  int vcu, G;
  __device__ __forceinline__ explicit StaticOrder(int grid,int block):vcu((grid%8==0)?(block%8)*(grid/8)+block/8:block),G(grid){}
  __device__ __forceinline__ StaticOrder(int ncu,int v,int):vcu(v),G(ncu){}
  __device__ __forceinline__ bool next(int i,AttnUnit&u)const{ const int pi=(i>>1)*G+vcu; if(pi>=BATCH*NHEAD*4)return false; u.bh=pi>>2; const int p=pi&3; u.qb=(i&1)?p:7-p; return true; }
  __device__ __forceinline__ void a_ready(const AttnUnit&)const{}
  __device__ __forceinline__ void done(const AttnUnit&)const{}
};
struct MobaOrder {
  int c,G; bool shift16; int give;
  __device__ __forceinline__ bool own(int ii,int cc,AttnUnit&u)const{ const int r=ii>>1,q=r*G+cc; if(q>=BATCH*NHEAD*4)return false; const int p=(G&3)?(q&3):(((q&3)+r)&3); u.bh=q>>2; u.qb=(ii&1)?p:7-p; return true; }
  __device__ __forceinline__ int slot_of(int cc,int qb)const{ const int p=qb<4?qb:7-qb; return 2*((p-(cc&3))&3)+(qb<4?1:0); }
  __device__ __forceinline__ bool next(int i,AttnUnit&u)const{
    if(!shift16&&give<=0) return own(i,c,u);
    const bool lite=shift16&&(c&31)<16; const int s2=lite?slot_of(c,2):-1;
    int k=i; for(int ii=0;ii<8;++ii){ AttnUnit t; own(ii,c,t); if(ii==s2||((give>>t.qb)&1))continue; if(k==0){u=t;return t.bh<BATCH*NHEAD;} --k; }
    if(shift16&&!lite&&k==0) return own(slot_of(c-16,2),c-16,u);
    return false; }
  __device__ __forceinline__ void a_ready(const AttnUnit&)const{}
  __device__ __forceinline__ void done(const AttnUnit&)const{}
};
template<class Sched,int THRL=8> __device__ __forceinline__ void attn_phase(char*lds,const AttnTensors&T,const Sched&S,const int wave_id){
  AttnUnit u;
  for(int i=0;S.next(i,u);++i){ S.a_ready(u); attn_unit<THRL>(u.bh/NHEAD,u.bh%NHEAD,u.qb,T.Q,T.K,T.V,T.O,T.ZB,T.KMEAN,lds,wave_id); S.done(u); }
}
#undef SBAR
#undef WAIT_BAR
}
constexpr int NWAVES = 8;
#ifndef MK_TS
#define MK_TS 0
#endif
#ifndef MK_ALIGN34
#define MK_ALIGN34 true
#endif
constexpr int CW_TS = 12288;
#ifndef MK_N_LAUNCHES
#define MK_N_LAUNCHES 0
#endif
constexpr int BATCH = 8, SEQ = 2048, DM = 2048, T = BATCH * SEQ, NH = 16, HD = 64, WID = 1024;
constexpr int NIN = 12544;
constexpr float RMS_EPS = 1e-6f, GN_EPS = 64e-5f, QSCALE = 0.125f * 1.4426950408889634f;
constexpr size_t MiB = 1u << 20;
constexpr size_t WS_CTL = 0, CTL_ZERO_BYTES = 64 * 1024;
constexpr size_t WS_KMEAN = 1 * MiB;
constexpr size_t WS_WINT = 2 * MiB;
constexpr size_t WS_WMT = 52 * MiB, WS_WOT = 60 * MiB;
constexpr size_t WS_XN = 68 * MiB;
constexpr size_t WS_MERGED = 68 * MiB;
constexpr size_t WS_RKV = 132 * MiB;
constexpr size_t WS_Y = 392 * MiB;
constexpr size_t WS_ZA = 228 * MiB, WS_QKVB = 260 * MiB, WS_ZB = 356 * MiB, WS_LORA = 388 * MiB;
constexpr size_t WS_END = 456 * MiB;
constexpr int CW_BAR = 4096, CW_SUB = 14336;
constexpr int RING_BYTES = 131072, LDSCTL_OFF = 143360, MISC_OFF = LDSCTL_OFF + 320, LDS_BYTES = 147456;

__device__ __forceinline__ float bf2f(bf16 v) { return __builtin_bit_cast(float, (unsigned)v << 16); }
__device__ __forceinline__ float blo(unsigned w) { return __builtin_bit_cast(float, w << 16); }
__device__ __forceinline__ float bhi(unsigned w) { return __builtin_bit_cast(float, w & 0xffff0000u); }
__device__ __forceinline__ void unpack8(const v4u w, float* f) { f[0] = blo(w.x); f[1] = bhi(w.x); f[2] = blo(w.y); f[3] = bhi(w.y); f[4] = blo(w.z); f[5] = bhi(w.z); f[6] = blo(w.w); f[7] = bhi(w.w); }
__device__ __forceinline__ v4u pack8(const float* f) { v4u w; w.x = pk2(f[0], f[1]); w.y = pk2(f[2], f[3]); w.z = pk2(f[4], f[5]); w.w = pk2(f[6], f[7]); return w; }
__device__ __forceinline__ float wave_sum(float v) {
#pragma unroll
    for (int o = 1; o < 64; o <<= 1) v += __shfl_xor(v, o);
    return v;
}
__device__ __forceinline__ float wave_max(float v) {
#pragma unroll
    for (int o = 1; o < 64; o <<= 1) v = fmaxf(v, __shfl_xor(v, o));
    return v;
}
__device__ __forceinline__ float dpp_f(float x, int ctrl_unused) { return x; }
#define DPP_ADD(x, CTRL) ((x) + __builtin_bit_cast(float, __builtin_amdgcn_update_dpp(0, __builtin_bit_cast(int, (x)), (CTRL), 0xF, 0xF, true)))
__device__ __forceinline__ float red8(float x) {
    x = DPP_ADD(x, 0xB1);
    x = DPP_ADD(x, 0x4E);
    x = DPP_ADD(x, 0x141);
    return x;
}

struct Frame {
    LAS unsigned char* lds; volatile LAS unsigned* MISC; gu32* ctl;
    int tid, lane, wave, vcu, G;
    const float* in[22]; float* out; unsigned char* ws;
};
#define IN_X 0
#define IN_NORMW 1
#define IN_WIN 2
#define IN_MUR 3
#define IN_MUK 4
#define IN_MUV 5
#define IN_MUW 6
#define IN_MUA 7
#define IN_W0 8
#define IN_WDUP 9
#define IN_A0 10
#define IN_WAUP 11
#define IN_KK 12
#define IN_KA 13
#define IN_RK 14
#define IN_GNW 15
#define IN_GNB 16
#define IN_QNW 17
#define IN_KNW 18
#define IN_WPR 19
#define IN_WPM 20
#define IN_WOUT 21

__device__ __forceinline__ void transpose_item(const float* W, int ldw, int k0, int srcn0, bf16* WT, int K, int dstn0, LAS float* scr, int lane) {
    if (srcn0 >= 0) {
        float t[32]; const float* wp = W + (size_t)(k0 + (lane >> 5)) * ldw + srcn0 + (lane & 31);
#pragma unroll
        for (int i = 0; i < 32; ++i) t[i] = wp[(size_t)(2 * i) * ldw];
#pragma unroll
        for (int i = 0; i < 32; ++i) scr[(2 * i + (lane >> 5)) * 33 + (lane & 31)] = t[i];
    } else {
#pragma unroll 8
        for (int i = 0; i < 32; ++i) { const int kk = 2 * i + (lane >> 5); scr[kk * 33 + (lane & 31)] = 0.f; }
    }
    LDS_WAIT(); asm volatile("" ::: "memory");
    const int c = lane & 7;
#pragma unroll
    for (int j = 0; j < 4; ++j) { const int n = (lane >> 3) + 8 * j; const LAS float* s = scr + (8 * c) * 33 + n;
        v4u o; o.x = pk2(s[0 * 33], s[1 * 33]); o.y = pk2(s[2 * 33], s[3 * 33]); o.z = pk2(s[4 * 33], s[5 * 33]); o.w = pk2(s[6 * 33], s[7 * 33]);
        *(GAS v4u*)(WT + (size_t)(dstn0 + n) * K + k0 + 8 * c) = o; }
    LDS_WAIT(); asm volatile("" ::: "memory");
}
__device__ __forceinline__ int win_src_col(int d) { if (d >= 4096 && d < 6144) { const int i = d & 255; return 4224 + ((d - 4096) & ~255) + 64 * ((i >> 5) & 3) + 32 * (i >> 7) + (i & 31); }
    if (d >= 8192 && d < 12288) { const int j = (d - 8192) >> 8, o = d & 255; return 8320 + (o >> 7) * 2048 + 128 * j + (o & 127); }
    return d < 4096 ? d : d < 8192 ? 4224 + (d - 4096) : d < 12416 ? 4096 + (d - 12288) : -1; }
__device__ __forceinline__ void rms_row_to_bf16(Frame& F, const float* xrow, const f32x4 (&gg)[8], bf16* orow) {
    const GAS f32x4* xr = (const GAS f32x4*)xrow + F.lane;
    f32x4 v[8]; float s = 0.f;
#pragma unroll
    for (int j = 0; j < 8; ++j) { v[j] = xr[64 * j]; s += (v[j].x * v[j].x + v[j].y * v[j].y) + (v[j].z * v[j].z + v[j].w * v[j].w); }
    const float rstd = 1.f / sqrtf(wave_sum(s) * (1.f / DM) + RMS_EPS);
    GAS unsigned long long* o8 = (GAS unsigned long long*)orow + F.lane;
#pragma unroll
    for (int j = 0; j < 8; ++j) o8[64 * j] = (unsigned long long)pk2(v[j].x * rstd * gg[j].x, v[j].y * rstd * gg[j].y) | ((unsigned long long)pk2(v[j].z * rstd * gg[j].z, v[j].w * rstd * gg[j].w) << 32);
}
__device__ __forceinline__ void p0_prologue(Frame& F) {
    LAS float* scr = (LAS float*)(F.lds + F.wave * 16384);
    const int gw = F.vcu * NWAVES + F.wave, NGW = F.G * NWAVES;
    bf16* WINT = (bf16*)(F.ws + WS_WINT);
    constexpr int I_IN = (DM / 64) * (NIN / 32);
    bf16* XN = (bf16*)(F.ws + WS_XN);
    { GAS f32x4* km = (GAS f32x4*)(F.ws + WS_KMEAN); for (int e = gw * 64 + F.lane; e < BATCH * NH * 8 * 64 / 4; e += NGW * 64) km[e] = (f32x4){0.f, 0.f, 0.f, 0.f}; }
    const bool rows_first = (F.wave & 1) != 0;
#pragma unroll 1
    for (int pass = 0; pass < 2; ++pass) {
        if ((pass == 0) == rows_first) { f32x4 gg[8];
#pragma unroll
            for (int j = 0; j < 8; ++j) gg[j] = ((const GAS f32x4*)F.in[IN_NORMW])[F.lane + 64 * j];
            f32x4 v[8], w[8]; int m = gw;
            if (m < T) {
#pragma unroll
                for (int j = 0; j < 8; ++j) v[j] = ((const GAS f32x4*)(F.in[IN_X] + (size_t)m * DM))[F.lane + 64 * j]; }
            for (; m < T; m += NGW) { const int mn = m + NGW;
                if (mn < T) {
#pragma unroll
                    for (int j = 0; j < 8; ++j) w[j] = ((const GAS f32x4*)(F.in[IN_X] + (size_t)mn * DM))[F.lane + 64 * j]; }
                float s_ = 0.f;
#pragma unroll
                for (int j = 0; j < 8; ++j) s_ += (v[j].x * v[j].x + v[j].y * v[j].y) + (v[j].z * v[j].z + v[j].w * v[j].w);
                const float rstd = 1.f / sqrtf(wave_sum(s_) * (1.f / DM) + RMS_EPS);
                GAS unsigned long long* o8 = (GAS unsigned long long*)(XN + (size_t)m * DM) + F.lane;
#pragma unroll
                for (int j = 0; j < 8; ++j) o8[64 * j] = (unsigned long long)pk2(v[j].x * rstd * gg[j].x, v[j].y * rstd * gg[j].y) | ((unsigned long long)pk2(v[j].z * rstd * gg[j].z, v[j].w * rstd * gg[j].w) << 32);
#pragma unroll
                for (int j = 0; j < 8; ++j) v[j] = w[j]; } }
        else { for (int it = gw; it < I_IN; it += NGW) { const int nblk = NIN / 32, kb = it / nblk, nb = it % nblk; transpose_item(F.in[IN_WIN], 12416, 64 * kb, win_src_col(32 * nb), WINT, DM, 32 * nb, scr, F.lane); } }
    }
}


__device__ __forceinline__ void p0_weights_late(Frame& F, int gw, int ngw, int lo = 0, int hi = 1 << 30) {
    LAS float* scr = (LAS float*)(F.lds + F.wave * 16384);
    bf16* WMT = (bf16*)(F.ws + WS_WMT); bf16* WOT = (bf16*)(F.ws + WS_WOT);
    constexpr int I_A = (WID / 64) * (DM / 32), I_O = (DM / 64) * (DM / 32), NITEMS = 2 * I_A + I_O;
    for (int it = lo + gw; it < (hi < NITEMS ? hi : NITEMS); it += ngw) {
        int r = it; const int nblk = DM / 32;
        if (r < I_A) { const int kb = r / nblk, nb = r % nblk; transpose_item(F.in[IN_WPM], DM, 64 * kb, 32 * nb, WMT, DM, 32 * nb, scr, F.lane); continue; } r -= I_A;
        if (r < I_A) { const int kb = r / nblk, nb = r % nblk; transpose_item(F.in[IN_WPR], DM, 64 * kb, 32 * nb, WMT + WID, DM, 32 * nb, scr, F.lane); continue; } r -= I_A;
        { const int kb = r / nblk, nb = r % nblk; transpose_item(F.in[IN_WOUT], DM, 64 * kb, 32 * nb, WOT, DM, 32 * nb, scr, F.lane); }
    }
}
#ifndef MK_NLATE
#define MK_NLATE 9
#endif
constexpr int NLATE = MK_NLATE, NMAIN = 49 - NLATE;
struct InOrderMain { pg8::StaticOrder S;
    __device__ __forceinline__ bool next(int i, pg8::Unit& u) const { if (!S.next(i, u)) return false; if (u.pn == NMAIN - 1) u.pn = 48; return true; }
    __device__ __forceinline__ void a_ready(const pg8::Unit&) const {}
    __device__ __forceinline__ void done(const pg8::Unit&) const {} };
struct InOrderLate { int c, G;
    __device__ __forceinline__ bool next(int i, pg8::Unit& u) const { const int ng = G >> 5, g = c >> 5, w = c & 31, per = (64 / ng) * NLATE, j = i * 32 + w; if (j >= per) return false;
        u.pm = g * (64 / ng) + j / NLATE; u.pn = 48 - NLATE + j % NLATE; return true; }
    __device__ __forceinline__ void a_ready(const pg8::Unit&) const {}
    __device__ __forceinline__ void done(const pg8::Unit&) const {} };
namespace ck {
constexpr int C = 32, NCH = SEQ / C, LT = 72, LX = 40;
typedef float f32x2 __attribute__((ext_vector_type(2)));
typedef float f32x16 __attribute__((ext_vector_type(16)));
typedef __bf16 bf16x2_t __attribute__((ext_vector_type(2)));
typedef unsigned u32x2 __attribute__((ext_vector_type(2)));
__device__ __forceinline__ unsigned cvt2(float lo, float hi) { f32x2 v = {lo, hi}; bf16x2_t b = __builtin_convertvector(v, bf16x2_t); return __builtin_bit_cast(unsigned, b); }
__device__ __forceinline__ float fsig(float x) { return __builtin_amdgcn_rcpf(1.0f + __builtin_amdgcn_exp2f(-1.4426950408889634f * x)); }
__device__ __forceinline__ float ftanh(float x) { return 1.0f - 2.0f * __builtin_amdgcn_rcpf(1.0f + __builtin_amdgcn_exp2f(2.8853900817779268f * x)); }
__device__ __forceinline__ float fexp(float x) { return __builtin_amdgcn_exp2f(1.4426950408889634f * x); }
__device__ __forceinline__ int crow(int r, int hi) { return (r & 3) + 8 * (r >> 2) + 4 * hi; }
__device__ __forceinline__ float red16(float x) { x = red8(x); x = DPP_ADD(x, 0x128); return x; }
__device__ __forceinline__ int opq(int x) { asm volatile("" : "+v"(x)); return x; }
#define CK_BAR() asm volatile("s_waitcnt lgkmcnt(0)\n\ts_barrier" ::: "memory")
typedef short v4i16_t __attribute__((ext_vector_type(4)));
template <bool TR> __device__ __forceinline__ pg8::bf16x8 ck_frag(const LAS bf16* X, int ld, int k0, int lane) {
    if (!TR) return *(const LAS pg8::bf16x8*)(X + (lane & 31) * ld + k0 + 8 * (lane >> 5));
    const LAS bf16* p = X + (k0 + 8 * (lane >> 5) + ((lane & 15) >> 2)) * ld + 16 * ((lane >> 4) & 1) + 4 * (lane & 3);
    const v4i16_t lo = __builtin_amdgcn_ds_read_tr16_b64_v4i16((LAS v4i16_t*)p), hi4 = __builtin_amdgcn_ds_read_tr16_b64_v4i16((LAS v4i16_t*)(p + 4 * ld));
    return (pg8::bf16x8){lo[0], lo[1], lo[2], lo[3], hi4[0], hi4[1], hi4[2], hi4[3]};
}
template <int K, bool TA, bool TB> __device__ __forceinline__ f32x16 mm_tile(const LAS bf16* A, int lda, const LAS bf16* B, int ldb, f32x16 acc, int lane) {
#pragma unroll
    for (int k0 = 0; k0 < K; k0 += 16) acc = __builtin_amdgcn_mfma_f32_32x32x16_bf16(ck_frag<TA>(A, lda, k0, lane), ck_frag<TB>(B, ldb, k0, lane), acc, 0, 0, 0);
    return acc;
}
constexpr int SZ_TOK = C * LT * 2, SZ_GRM = C * 36 * 4 + 3 * C * LX * 2 + 64 * 4;
constexpr int O_TOK = 0;
constexpr int O_GRM = O_TOK + 2 * 5 * SZ_TOK;
constexpr int O_TM = O_GRM + 2 * SZ_GRM, O_LVT = O_TM + C * LX * 2, O_AHT = O_LVT + 64 * LX * 2, O_W2T = O_AHT + 64 * LX * 2;
constexpr int O_RH = O_W2T + 64 * LX * 2, O_PP = O_RH + C * LT * 2, O_ZT = O_PP + 64 * LT * 2;
constexpr int O_GX = O_ZT + 64 * LT * 2, O_LA = O_GX + C * 64 * 4, O_LW = O_LA + C * 68 * 4, O_PAR = O_LW + C * 64 * 4, O_L21 = O_PAR + 12 * 64 * 4, O_XT = O_L21 + 16 * 24 * 2, O_HAND = O_XT + 16 * 24 * 2, O_END1 = O_HAND + 8 * 64;
constexpr int O_YL = O_LVT, O_WST = 0;
static_assert(O_END1 <= 143360 && C * 65 * 4 <= 2 * 64 * LX * 2, "chunk LDS map");

__device__ __forceinline__ void head(Frame& F, int bh) {
    LAS unsigned char* lds = F.lds; LAS float* Lpar = (LAS float*)(lds + O_PAR); LAS float* La = (LAS float*)(lds + O_LA); LAS float* Lws = (LAS float*)(lds + O_LW); LAS bf16* BVb = (LAS bf16*)(lds + O_GX); LAS unsigned* Lhand = (LAS unsigned*)(lds + O_HAND);
    LAS bf16* Tm = (LAS bf16*)(lds + O_TM); LAS bf16* LVt = (LAS bf16*)(lds + O_LVT); LAS bf16* AhT = (LAS bf16*)(lds + O_AHT); LAS bf16* W2t = (LAS bf16*)(lds + O_W2T); LAS bf16* Rh = (LAS bf16*)(lds + O_RH); LAS bf16* Pp = (LAS bf16*)(lds + O_PP); LAS bf16* ZT = (LAS bf16*)(lds + O_ZT);
    LAS float* Yl = (LAS float*)(lds + O_YL);
    const bf16* RKV = (const bf16*)(F.ws + WS_RKV); const bf16* LORA = (const bf16*)(F.ws + WS_LORA); const bf16* ZA = (const bf16*)(F.ws + WS_ZA); bf16* YA = (bf16*)(F.ws + WS_Y) + 1024;
    const int tid0 = F.tid, lane0 = F.lane, wave = F.wave, b = bh >> 4, h = bh & 15;
    const size_t row0 = (size_t)b * SEQ;
    const bool front = wave >= 4; const int fw = wave - 4;
    CK_BAR();
    { const int tid = tid0;
    for (int e = tid; e < 12 * 64; e += 512) { const int a = e >> 6, d = e & 63;
        const float* pp = a == 0 ? F.in[IN_MUR] : a == 1 ? F.in[IN_MUK] : a == 2 ? F.in[IN_MUV] : a == 3 ? F.in[IN_KK] : a == 4 ? F.in[IN_KA] : a == 5 ? F.in[IN_RK] : a == 6 ? F.in[IN_GNW] : a == 7 ? F.in[IN_GNB] : a == 8 ? F.in[IN_W0] : a == 9 ? F.in[IN_A0] : a == 10 ? F.in[IN_MUW] : F.in[IN_MUA];
        Lpar[e] = pp[a >= 10 ? d : h * 64 + d]; }
    { LAS float* Wst = (LAS float*)(lds + O_WST);
#pragma unroll
        for (int it = 0; it < 4; ++it) { const int e = tid + 512 * it, mtx = e >> 10, row = (e >> 4) & 63, c4 = (e & 15) * 4; const float* W = mtx ? F.in[IN_WAUP] : F.in[IN_WDUP];
            *(LAS pg8::f32x4*)(Wst + mtx * 4096 + row * 64 + c4) = *(const GAS pg8::f32x4*)(W + (size_t)row * 1024 + h * 64 + c4); } }
    for (int e = tid; e < 64 * LT / 2; e += 512) ((LAS unsigned*)ZT)[e] = 0u;
    if (tid < 256) Tm[(tid >> 4) * LX + 16 + (tid & 15)] = (bf16)0;
    if (tid < 128) Lhand[tid] = 0u; }
    CK_BAR();
    const bool la = (fw & 1) != 0, lw = !la; const int lct = (fw >> 1) & 1;
    pg8::bf16x8 wf[4];
    if (front) { const int l_ = lane0, hi_ = l_ >> 5, c_ = l_ & 31; const LAS float* Wst = (LAS float*)(lds + O_WST) + (la ? 4096 : 0) + (8 * hi_) * 64 + c_ + 32 * lct;
#pragma unroll
        for (int s = 0; s < 4; ++s) { float t[8];
#pragma unroll
            for (int j = 0; j < 8; ++j) t[j] = Wst[(16 * s + j) * 64];
            const v4u pk_ = {cvt2(t[0], t[1]), cvt2(t[2], t[3]), cvt2(t[4], t[5]), cvt2(t[6], t[7])}; wf[s] = __builtin_bit_cast(pg8::bf16x8, pk_); } }
    CK_BAR();
    v4u pLc[4], pR[6];
#define CK_PF_LORA(nn) do { const int l_ = opq(lane0), t_ = (nn) * C + (l_ & 31); const bf16* lp_ = LORA + (row0 + t_) * 128 + (la ? 64 : 0) + 8 * (l_ >> 5); \
        _Pragma("unroll") for (int s = 0; s < 4; ++s) pLc[s] = *(const GAS v4u*)(lp_ + 16 * s); } while (0)
#define CK_PF_RKV(nn) do { const int i_ = fw * 64 + opq(lane0), t_ = (nn) * C + (i_ >> 3); const bf16* rp_ = RKV + (row0 + t_) * 3072 + h * 64 + 8 * (i_ & 7); \
        pR[0] = *(const GAS v4u*)rp_; pR[1] = *(const GAS v4u*)(rp_ + 1024); pR[2] = *(const GAS v4u*)(rp_ + 2048); \
        if (t_ > 0) { pR[3] = *(const GAS v4u*)(rp_ - 3072); pR[4] = *(const GAS v4u*)(rp_ - 3072 + 1024); pR[5] = *(const GAS v4u*)(rp_ - 3072 + 2048); } else { pR[3] = (v4u){0u, 0u, 0u, 0u}; pR[4] = pR[3]; pR[5] = pR[3]; } \
        } while (0)
    if (front) CK_PF_LORA(0);
    f32x16 Z = {};
    v4u zaC = {0u, 0u, 0u, 0u};
    for (int n = -1; n < NCH; ++n) {
        const int m = n + 1; const bool fm = front && m < NCH, bn = !front && n >= 0;
        const int lane = opq(lane0), r32 = lane & 31, hi = lane >> 5, idx = fw * 64 + lane, tok = idx >> 3, p = idx & 7;
        LAS bf16* tkM = (LAS bf16*)(lds + O_TOK + (m & 1) * 5 * SZ_TOK); LAS unsigned char* gmM = lds + O_GRM + (m & 1) * SZ_GRM;
        const LAS bf16* tkN = (const LAS bf16*)(lds + O_TOK + (n & 1) * 5 * SZ_TOK); const LAS unsigned char* gmN = lds + O_GRM + (n & 1) * SZ_GRM;
        const LAS bf16* tokA = tkN, *tokR = tkN + C * LT, *tokB = tkN + 2 * C * LT, *tokK = tkN + 3 * C * LT, *tokV = tkN + 4 * C * LT;
        const LAS float* Lab = (const LAS float*)gmN; const LAS bf16* Lak = (const LAS bf16*)(gmN + C * 36 * 4); const LAS bf16* Mrb = Lak + C * LX; const LAS bf16* Mrk = Mrb + C * LX; const LAS float* gC = (const LAS float*)(gmN + C * 36 * 4 + 3 * C * LX * 2);
        float r_[8], kp_[8], v_[8], al_[8], be_[8], lw_[8];
        if (fm) CK_PF_RKV(m);
        if (fm) { LAS float* mu_ = Lpar + (la ? 11 : 10) * 64 + 8 * hi;
            f32x16 acc0_ = {};
#pragma unroll
            for (int s = 0; s < 4; ++s) { float cu_[8], pv_[8]; unpack8(pLc[s], cu_);
                {
                    v4u pp_; const v4u hd_ = *(const LAS v4u*)(Lhand + (fw * 2 + hi) * 16 + 4 * s);
                    pp_.x = (unsigned)__builtin_amdgcn_update_dpp(0, (int)pLc[s].x, 0x138, 0xF, 0xF, false); pp_.y = (unsigned)__builtin_amdgcn_update_dpp(0, (int)pLc[s].y, 0x138, 0xF, 0xF, false);
                    pp_.z = (unsigned)__builtin_amdgcn_update_dpp(0, (int)pLc[s].z, 0x138, 0xF, 0xF, false); pp_.w = (unsigned)__builtin_amdgcn_update_dpp(0, (int)pLc[s].w, 0x138, 0xF, 0xF, false);
                    if (r32 == 0) pp_ = hd_;
                    unpack8(pp_, pv_); }
#pragma unroll
                for (int j = 0; j < 8; ++j) cu_[j] = cu_[j] + (pv_[j] - cu_[j]) * mu_[16 * s + j];
                if (lw) {
#pragma unroll
                    for (int j = 0; j < 8; ++j) cu_[j] = ftanh(cu_[j]); }
                const v4u pk_ = {cvt2(cu_[0], cu_[1]), cvt2(cu_[2], cu_[3]), cvt2(cu_[4], cu_[5]), cvt2(cu_[6], cu_[7])}; const pg8::bf16x8 af_ = __builtin_bit_cast(pg8::bf16x8, pk_);
                acc0_ = __builtin_amdgcn_mfma_f32_32x32x16_bf16(af_, wf[s], acc0_, 0, 0, 0); }
            if (r32 == 31) {
#pragma unroll
                for (int s = 0; s < 4; ++s) *(LAS v4u*)(Lhand + (fw * 2 + hi) * 16 + 4 * s) = pLc[s]; }
            const float b0_ = Lpar[(lw ? 8 : 9) * 64 + 32 * lct + r32];
#pragma unroll
            for (int r = 0; r < 16; ++r) acc0_[r] = fsig(acc0_[r] + b0_);
            if (lw) { LAS float* o_ = Lws + (4 * hi) * 64 + 32 * lct + r32;
#pragma unroll
                for (int r = 0; r < 16; ++r) o_[((r & 3) + 8 * (r >> 2)) * 64] = -0.60653066f * acc0_[r]; }
            else { LAS float* o_ = La + (4 * hi) * 68 + 32 * lct + r32;
#pragma unroll
                for (int r = 0; r < 16; ++r) o_[((r & 3) + 8 * (r >> 2)) * 68] = acc0_[r]; } }
        if (bn && wave == 0) {
            LAS bf16* L21b = (LAS bf16*)(lds + O_L21); LAS bf16* Xt = (LAS bf16*)(lds + O_XT);
            const int blk = (lane >> 4) & 1, i = lane & 15; const LAS float* Lb = Lab + (16 * blk) * 36 + 16 * blk; float T[16];
#pragma unroll
            for (int t = 0; t < 16; ++t) { float a0 = (t == i) ? 1.f : 0.f, a1 = 0.f, a2 = 0.f, a3 = 0.f;
#pragma unroll
                for (int j4 = 0; j4 < t; j4 += 4) { const pg8::f32x4 l4 = *(const LAS pg8::f32x4*)(Lb + t * 36 + j4);
                    a0 += l4.x * T[j4]; if (j4 + 1 < t) a1 += l4.y * T[j4 + 1]; if (j4 + 2 < t) a2 += l4.z * T[j4 + 2]; if (j4 + 3 < t) a3 += l4.w * T[j4 + 3]; }
                T[t] = (a0 + a1) + (a2 + a3); }
            if (hi == 0) {
#pragma unroll
                for (int t = 0; t < 16; ++t) Tm[(16 * blk + t) * LX + 16 * blk + i] = (bf16)f2bf(T[t]); }
            { const int r = lane >> 2, j0 = 4 * (lane & 3); const pg8::f32x4 l4 = *(const LAS pg8::f32x4*)(Lab + (16 + r) * 36 + j0); *(LAS u32x2*)(L21b + r * 24 + j0) = (u32x2){cvt2(l4.x, l4.y), cvt2(l4.z, l4.w)}; }
            asm volatile("s_waitcnt lgkmcnt(0)" ::: "memory");
            { const pg8::bf16x8 a = *(const LAS pg8::bf16x8*)(L21b + i * 24 + 8 * hi); const f32x16 x = __builtin_amdgcn_mfma_f32_32x32x16_bf16(a, ck_frag<true>(Tm, LX, 0, lane), f32x16{}, 0, 0, 0);
                if (r32 < 16) {
#pragma unroll
                    for (int q = 0; q < 2; ++q) *(LAS u32x2*)(Xt + r32 * 24 + 8 * q + 4 * hi) = (u32x2){cvt2(x[4 * q], x[4 * q + 1]), cvt2(x[4 * q + 2], x[4 * q + 3])}; } }
            asm volatile("s_waitcnt lgkmcnt(0)" ::: "memory");
            { const pg8::bf16x8 a = *(const LAS pg8::bf16x8*)(Tm + (16 + i) * LX + 16 + 8 * hi), bfr = *(const LAS pg8::bf16x8*)(Xt + i * 24 + 8 * hi);
                const f32x16 t21 = __builtin_amdgcn_mfma_f32_32x32x16_bf16(a, bfr, f32x16{}, 0, 0, 0);
                if (r32 < 16) {
#pragma unroll
                    for (int q = 0; q < 2; ++q)
#pragma unroll
                        for (int e2 = 0; e2 < 4; ++e2) Tm[(16 + 8 * q + 4 * hi + e2) * LX + r32] = (bf16)f2bf(t21[4 * q + e2]); } } }
        CK_BAR();
        if (bn) zaC = *(const GAS v4u*)(ZA + (row0 + n * C + ((wave * 64 + lane) >> 3)) * 1024 + h * 64 + 8 * (lane & 7));
        if (fm) {
            const int cch = 16 * fw + (lane & 15), seg = lane >> 4; LAS float* gCm = (LAS float*)(gmM + C * 36 * 4 + 3 * C * LX * 2); float g[8];
#pragma unroll
            for (int j = 0; j < 8; ++j) g[j] = Lws[(8 * seg + j) * 64 + cch];
#pragma unroll
            for (int j = 1; j < 8; ++j) g[j] += g[j - 1];
            const float S = g[7];
            const auto a_ = __builtin_amdgcn_permlane16_swap(__float_as_uint(S), __float_as_uint(S), false, false); const float other16 = (seg & 1) ? __uint_as_float(a_[0]) : __uint_as_float(a_[1]);
            const float pairT = S + other16;
            const auto b_ = __builtin_amdgcn_permlane32_swap(__float_as_uint(pairT), __float_as_uint(pairT), false, false); const float other32 = (seg & 2) ? __uint_as_float(b_[0]) : __uint_as_float(b_[1]);
            const float off = ((seg & 1) ? other16 : 0.f) + ((seg & 2) ? other32 : 0.f);
#pragma unroll
            for (int j = 0; j < 8; ++j) Lws[(8 * seg + j) * 64 + cch] = g[j] + off;
            if (seg == 3) gCm[cch] = fexp(g[7] + off); }
        if (bn) { const int nt = wave & 1; const LAS bf16* A_ = wave < 2 ? Tm : Lak; const LAS bf16* B_ = (wave < 2 ? tokA : tokV) + nt * 32; LAS bf16* O_ = (wave < 2 ? AhT : LVt) + nt * 32 * LX;
            const f32x16 d = mm_tile<32, false, true>(A_, LX, B_, LT, f32x16{}, lane);
#pragma unroll
            for (int q = 0; q < 4; ++q) *(LAS u32x2*)(O_ + r32 * LX + 8 * q + 4 * hi) = (u32x2){cvt2(d[4 * q], d[4 * q + 1]), cvt2(d[4 * q + 2], d[4 * q + 3])}; }
        CK_BAR();
        if (fm) { float cr[8], ck_[8], cv[8], qr[8], qk[8], qv[8]; unpack8(pR[0], cr); unpack8(pR[1], ck_); unpack8(pR[2], cv); unpack8(pR[3], qr); unpack8(pR[4], qk); unpack8(pR[5], qv);
            float kkr[8], kk_[8], ss = 0.f, bon = 0.f;
#pragma unroll
            for (int j = 0; j < 8; ++j) { const int d = 8 * p + j; r_[j] = cr[j] + (qr[j] - cr[j]) * Lpar[0 * 64 + d]; kk_[j] = ck_[j] + (qk[j] - ck_[j]) * Lpar[1 * 64 + d]; v_[j] = cv[j] + (qv[j] - cv[j]) * Lpar[2 * 64 + d];
                kkr[j] = kk_[j] * Lpar[3 * 64 + d]; ss += kkr[j] * kkr[j]; }
            ss = red8(ss); const float inv = 1.f / fmaxf(sqrtf(ss), 1e-12f);
#pragma unroll
            for (int j = 0; j < 8; ++j) { const int d = 8 * p + j; const float aa = La[tok * 68 + d], kn = kkr[j] * inv; kp_[j] = kk_[j] * (1.f + (aa - 1.f) * Lpar[4 * 64 + d]); al_[j] = -kn; be_[j] = kn * aa;
                bon += r_[j] * kp_[j] * Lpar[5 * 64 + d]; lw_[j] = Lws[tok * 64 + d] - (tok > 0 ? Lws[(tok - 1) * 64 + d] : 0.f); }
            bon = red8(bon);
#pragma unroll
            for (int j = 0; j < 8; ++j) kkr[j] = bon * v_[j];
            *(LAS v4u*)(BVb + (m & 1) * C * 64 + tok * 64 + 8 * p) = (v4u){cvt2(kkr[0], kkr[1]), cvt2(kkr[2], kkr[3]), cvt2(kkr[4], kkr[5]), cvt2(kkr[6], kkr[7])};
            float at[8], rt[8], bt[8], kt[8];
#pragma unroll
            for (int j = 0; j < 8; ++j) { const float gi = Lws[tok * 64 + 8 * p + j], ge = gi - lw_[j], en = fexp(-gi); at[j] = al_[j] * fexp(ge); rt[j] = r_[j] * fexp(gi); bt[j] = be_[j] * en; kt[j] = kp_[j] * en; }
            const int o = tok * LT + 8 * p;
            *(LAS v4u*)(tkM + o) = (v4u){cvt2(at[0], at[1]), cvt2(at[2], at[3]), cvt2(at[4], at[5]), cvt2(at[6], at[7])}; *(LAS v4u*)(tkM + C * LT + o) = (v4u){cvt2(rt[0], rt[1]), cvt2(rt[2], rt[3]), cvt2(rt[4], rt[5]), cvt2(rt[6], rt[7])};
            *(LAS v4u*)(tkM + 2 * C * LT + o) = (v4u){cvt2(bt[0], bt[1]), cvt2(bt[2], bt[3]), cvt2(bt[4], bt[5]), cvt2(bt[6], bt[7])}; *(LAS v4u*)(tkM + 3 * C * LT + o) = (v4u){cvt2(kt[0], kt[1]), cvt2(kt[2], kt[3]), cvt2(kt[4], kt[5]), cvt2(kt[6], kt[7])};
            *(LAS v4u*)(tkM + 4 * C * LT + o) = (v4u){cvt2(v_[0], v_[1]), cvt2(v_[2], v_[3]), cvt2(v_[4], v_[5]), cvt2(v_[6], v_[7])}; }
        if (bn) {
            if (wave < 2) { const int nt = wave; const f32x16 d = mm_tile<32, false, false>(Tm, LX, LVt + nt * 32 * LX, LX, f32x16{}, lane);
#pragma unroll
                for (int q = 0; q < 4; ++q) *(LAS u32x2*)(W2t + (nt * 32 + r32) * LX + 8 * q + 4 * hi) = (u32x2){cvt2(d[4 * q], d[4 * q + 1]), cvt2(d[4 * q + 2], d[4 * q + 3])}; }
            else { const int ct = wave - 2; const f32x16 d = mm_tile<32, false, false>(AhT + ct * 32 * LX, LX, Mrb, LX, f32x16{}, lane); const int t = r32;
#pragma unroll
                for (int q = 0; q < 4; ++q) { const int c0 = ct * 32 + 8 * q + 4 * hi; const u32x2 rr = *(const LAS u32x2*)(tokR + t * LT + c0);
                    *(LAS u32x2*)(Rh + t * LT + c0) = (u32x2){cvt2(d[4 * q] + blo(rr.x), d[4 * q + 1] + bhi(rr.x)), cvt2(d[4 * q + 2] + blo(rr.y), d[4 * q + 3] + bhi(rr.y))}; } }
            { const int ct = wave & 1, c2t = wave >> 1; const f32x16 d = mm_tile<32, false, true>(AhT + ct * 32 * LX, LX, tokB + c2t * 32, LT, f32x16{}, lane); const int c2 = c2t * 32 + r32; const float gm = gC[c2];
#pragma unroll
                for (int q = 0; q < 4; ++q) { const int c0 = ct * 32 + 8 * q + 4 * hi;
                    *(LAS u32x2*)(Pp + c2 * LT + c0) = (u32x2){cvt2(gm * d[4 * q], gm * d[4 * q + 1]), cvt2(gm * d[4 * q + 2], gm * d[4 * q + 3])}; } } }
        CK_BAR();
        if (fm) { const LAS bf16* A_ = (fw == 0 || fw == 2) ? tkM + 2 * C * LT : tkM + 3 * C * LT; const LAS bf16* Bt_ = (fw < 2) ? tkM : tkM + C * LT;
            const f32x16 d = mm_tile<64, false, false>(A_, LT, Bt_, LT, f32x16{}, lane); const int t = r32;
            LAS float* LabM = (LAS float*)gmM; LAS bf16* O_ = (LAS bf16*)(gmM + C * 36 * 4) + (fw - 1) * C * LX;
            const int lim = t + (fw < 2 ? 0 : 1) - 4 * hi;
            float x[16];
#pragma unroll
            for (int r = 0; r < 16; ++r) x[r] = (8 * (r >> 2) + (r & 3) < lim) ? d[r] : 0.f;
            if (fw == 0) { LAS float* o_ = LabM + t * 36 + 4 * hi;
#pragma unroll
                for (int q = 0; q < 4; ++q) *(LAS pg8::f32x4*)(o_ + 8 * q) = (pg8::f32x4){x[4 * q], x[4 * q + 1], x[4 * q + 2], x[4 * q + 3]}; }
            else { LAS bf16* o_ = O_ + t * LX + 4 * hi;
#pragma unroll
                for (int q = 0; q < 4; ++q) *(LAS u32x2*)(o_ + 8 * q) = (u32x2){cvt2(x[4 * q], x[4 * q + 1]), cvt2(x[4 * q + 2], x[4 * q + 3])}; } }
        if (front && n >= 0 && fw < 2) { const int yv = fw;
            f32x16 y = mm_tile<32, false, false>(Mrb, LX, W2t + yv * 32 * LX, LX, f32x16{}, lane); y = mm_tile<32, false, true>(Mrk, LX, tokV + yv * 32, LT, y, lane);
            const f32x16 y2 = mm_tile<64, false, false>(Rh, LT, ZT + yv * 32 * LT, LT, f32x16{}, lane);
#pragma unroll
            for (int r = 0; r < 16; ++r) Yl[crow(r, hi) * 65 + yv * 32 + r32] = y[r] + y2[r]; }
        if (bn) { const int c2t = wave & 1, vt = wave >> 1;
            f32x16 d = mm_tile<32, true, false>(tokB + c2t * 32, LT, W2t + vt * 32 * LX, LX, f32x16{}, lane); d = mm_tile<32, true, true>(tokK + c2t * 32, LT, tokV + vt * 32, LT, d, lane);
#pragma unroll
            for (int q = 0; q < 4; ++q) { const pg8::f32x4 g4 = *(const LAS pg8::f32x4*)(gC + c2t * 32 + 8 * q + 4 * hi);
                d[4 * q] = g4.x * (d[4 * q] + Z[4 * q]); d[4 * q + 1] = g4.y * (d[4 * q + 1] + Z[4 * q + 1]); d[4 * q + 2] = g4.z * (d[4 * q + 2] + Z[4 * q + 2]); d[4 * q + 3] = g4.w * (d[4 * q + 3] + Z[4 * q + 3]); }
            const f32x16 pz = mm_tile<64, false, false>(Pp + c2t * 32 * LT, LT, ZT + vt * 32 * LT, LT, f32x16{}, lane);
            Z = d + pz;
 }
        CK_BAR();
        if (front && m + 1 < NCH) CK_PF_LORA(m + 1);
        if (bn) { const int c2t = wave & 1, vt = wave >> 1;
#pragma unroll
            for (int q = 0; q < 4; ++q) *(LAS u32x2*)(ZT + (vt * 32 + r32) * LT + c2t * 32 + 8 * q + 4 * hi) = (u32x2){cvt2(Z[4 * q], Z[4 * q + 1]), cvt2(Z[4 * q + 2], Z[4 * q + 3])};
            const int tb = (wave * 64 + lane) >> 3, pb = lane & 7;
            const size_t row = row0 + n * C + tb; float y[8], za[8], o[8], bv[8], sm = 0.f; unpack8(zaC, za); unpack8(*(const LAS v4u*)(BVb + (n & 1) * C * 64 + tb * 64 + 8 * pb), bv);
#pragma unroll
            for (int j = 0; j < 8; ++j) { y[j] = Yl[tb * 65 + 8 * pb + j]; sm += y[j]; }
            const float mean = red8(sm) * (1.f / 64.f); float q_ = 0.f;
#pragma unroll
            for (int j = 0; j < 8; ++j) { y[j] -= mean; q_ += y[j] * y[j]; }
            const float rstd = __builtin_amdgcn_rsqf(red8(q_) * (1.f / 64.f) + GN_EPS);
#pragma unroll
            for (int j = 0; j < 8; ++j) o[j] = (y[j] * rstd * Lpar[6 * 64 + 8 * pb + j] + Lpar[7 * 64 + 8 * pb + j] + bv[j]) * za[j];
            *(GAS v4u*)(YA + row * 2048 + h * 64 + 8 * pb) = (v4u){cvt2(o[0], o[1]), cvt2(o[2], o[3]), cvt2(o[4], o[5]), cvt2(o[6], o[7])}; }
    }
#undef CK_PF_RKV
#undef CK_PF_LORA
}
#undef CK_BAR
}

__device__ __forceinline__ void subset_barrier(gu32* cnt, unsigned nwg, bool t0) {
    asm volatile("s_waitcnt vmcnt(0)" ::: "memory"); __syncthreads();
    if (t0) { __builtin_amdgcn_fence(__ATOMIC_RELEASE, "agent"); asm volatile("s_waitcnt vmcnt(0)" ::: "memory");
        __hip_atomic_fetch_add((unsigned*)cnt, 1u, RLX_AGENT);
        unsigned sp = 0; while (__hip_atomic_load((unsigned*)cnt, RLX_AGENT) < nwg && ++sp < (1u << 22)) __builtin_amdgcn_s_sleep(2);
        __builtin_amdgcn_fence(__ATOMIC_ACQUIRE, "agent"); asm volatile("s_waitcnt vmcnt(0)" ::: "memory"); }
    __syncthreads();
}

#ifndef MK_CHECK
#define MK_CHECK 0
#endif
#ifndef MK_NAIVE_ATTN
#define MK_NAIVE_ATTN 0
#endif

#ifndef MK_GIVE_QB
#define MK_GIVE_QB 3
#endif
constexpr int PER_PHASE = 5;
struct Args { const float* in[22]; float* out; unsigned char* ws; int ph_lo, ph_hi, li, pad; };
__global__ void __launch_bounds__(NWAVES * 64, 2) mk_fwd(Args args) {
    extern __shared__ __attribute__((aligned(16))) unsigned char lds[];
    Frame F;
    F.lds = (LAS unsigned char*)lds; F.MISC = (volatile LAS unsigned*)(F.lds + MISC_OFF);
    F.wave = __builtin_amdgcn_readfirstlane((int)threadIdx.x >> 6); F.lane = mk_lane_id(); F.tid = F.wave * 64 + F.lane;
    F.G = gridDim.x; { const int bx = blockIdx.x; F.vcu = (F.G % 8 == 0) ? (bx % 8) * (F.G / 8) + bx / 8 : bx; }
    F.ws = args.ws; F.out = args.out; F.ctl = (gu32*)(args.ws + WS_CTL);
#pragma unroll
    for (int i = 0; i < 22; ++i) F.in[i] = args.in[i];
    for (int u = F.tid; u < (LDS_BYTES - LDSCTL_OFF) / 4; u += NWAVES * 64) ((LAS unsigned*)(F.lds + LDSCTL_OFF))[u] = 0u;
    __syncthreads();
    XcdBarrier bar; bar.bar = (unsigned*)(F.ctl + CW_BAR); bar.x = 0; bar.st = nullptr;
    if (MK_N_LAUNCHES == 1) bar = xcd_barrier_post((unsigned*)(F.ctl + CW_BAR), F.MISC + 8, F.tid == 0);
#define GRID_BAR() do { if (MK_N_LAUNCHES == 1) { FRESH(); xcd_barrier(bar, F.tid == 0); } } while (0)
    const int lo = args.ph_lo, hi = args.ph_hi;
#define TS(k) do { if (MK_TS && F.tid == 0 && (blockIdx.x == 0 || blockIdx.x == 4)) __hip_atomic_store((unsigned*)(F.ctl + CW_TS + (blockIdx.x ? 32 : 0) + (k)), (unsigned)__builtin_amdgcn_s_memrealtime(), __ATOMIC_RELAXED, __HIP_MEMORY_SCOPE_AGENT); } while (0)
    TS(0);
#if MK_TS == 90
    if (blockIdx.x == 0 && F.lane == 0) __hip_atomic_store((unsigned*)(F.ctl + CW_TS + 100 + F.wave), 1u + ((unsigned)__builtin_amdgcn_s_getreg((2 - 1) << 11 | 4 << 6 | 4) & 3u), __ATOMIC_RELAXED, __HIP_MEMORY_SCOPE_AGENT);
#endif
#ifndef MK_PHASE_MASK
#define MK_PHASE_MASK 0x1f
#endif
#define IN(k) (((MK_PHASE_MASK >> (k)) & 1) && lo <= (k) && (k) < hi)
#define FRESH() do { int l_ = mk_lane_id(); asm volatile("" : "+v"(l_)); F.lane = l_; F.tid = F.wave * 64 + l_; } while (0)
#define BOTH(k) (IN(k) && IN((k) + 1))
    bf16* WS16 = (bf16*)args.ws; (void)WS16;
    if (IN(0)) { FRESH(); p0_prologue(F); TS(1); if (BOTH(0)) GRID_BAR(); TS(2); }
    if (IN(1)) {
        pg8::Gemm g{(const pg8::bf16_t*)(args.ws + WS_XN), (const pg8::bf16_t*)(args.ws + WS_WINT), T, NIN, DM}; InOrderMain S; S.S.init(T, NMAIN * 256, F.G, (int)blockIdx.x);
        pg8::EpiIn E{(pg8::bf16_t*)(args.ws + WS_RKV), (pg8::bf16_t*)(args.ws + WS_ZA), (pg8::bf16_t*)(args.ws + WS_QKVB), (pg8::bf16_t*)(args.ws + WS_ZB), (pg8::bf16_t*)args.out, (pg8::bf16_t*)(args.ws + WS_LORA), F.in[IN_QNW], F.in[IN_KNW], (float*)(args.ws + WS_KMEAN)};
        pg8::gemm_phase<pg8::EpiIn, InOrderMain, true, true>(F.lds, g, S, E, F.wave);
        TS(3); if (BOTH(1)) GRID_BAR(); TS(4);
    }
    if (IN(2)) {
        const attn_body::bf16* QK = (const attn_body::bf16*)(args.ws + WS_QKVB);
        const attn_body::AttnTensors AT{QK, QK + 1024, QK + 2048, (attn_body::bf16*)(args.ws + WS_Y), (const attn_body::bf16*)(args.ws + WS_ZB), (const float*)(args.ws + WS_KMEAN)};
        const pg8::Gemm gl{(const pg8::bf16_t*)(args.ws + WS_XN), (const pg8::bf16_t*)(args.ws + WS_WINT), T, NIN, DM};
        const pg8::EpiIn El{(pg8::bf16_t*)(args.ws + WS_RKV), (pg8::bf16_t*)(args.ws + WS_ZA), (pg8::bf16_t*)(args.ws + WS_QKVB), (pg8::bf16_t*)(args.ws + WS_ZB), (pg8::bf16_t*)args.out, (pg8::bf16_t*)(args.ws + WS_LORA), F.in[IN_QNW], F.in[IN_KNW], (float*)(args.ws + WS_KMEAN)};
        constexpr int NSCAN = BATCH * NH; FRESH();
        const bool split = F.G >= 2 * NSCAN && ((F.G - NSCAN) & 31) == 0 && 64 % ((F.G - NSCAN) >> 5) == 0;
        if (split && F.vcu < NSCAN) { ck::head(F, F.vcu); FRESH(); __syncthreads(); p0_weights_late(F, F.vcu * NWAVES + F.wave, NSCAN * NWAVES, 0, 2048);
            if (MK_GIVE_QB) { const attn_body::MobaOrder S{F.vcu, NSCAN, false, MK_GIVE_QB};
#pragma unroll 1
                for (int qb = 0; qb < 8; ++qb) if ((MK_GIVE_QB >> qb) & 1) { FRESH(); __syncthreads(); attn_body::AttnUnit u; if (S.own(S.slot_of(F.vcu, qb), F.vcu, u)) attn_body::attn_unit<8>(u.bh / NH, u.bh % NH, u.qb, AT.Q, AT.K, AT.V, AT.O, AT.ZB, AT.KMEAN, (char*)lds, F.wave); } } }
        else {
            const int c = split ? F.vcu - NSCAN : F.vcu, ng = split ? F.G - NSCAN : F.G;
            if (!split) { for (int u = F.vcu; u < NSCAN; u += F.G) ck::head(F, u); __syncthreads(); }
            if (split) { InOrderLate SL{c, ng}; pg8::gemm_phase<pg8::EpiIn, InOrderLate, true, true>(F.lds, gl, SL, El, F.wave); }
            else { InOrderLate SL{0, 32}; for (int k = F.vcu; k < 32; k += F.G) { SL.c = k; pg8::gemm_phase<pg8::EpiIn, InOrderLate, true, true>(F.lds, gl, SL, El, F.wave); } }
            FRESH(); __syncthreads();
            const attn_body::MobaOrder S{c, ng, split && ng == 128 && (((64 / (ng >> 5)) * NLATE) & 31) == 16, split ? MK_GIVE_QB : 0}; attn_body::attn_phase<attn_body::MobaOrder>((char*)lds, AT, S, F.wave);
            if (!split) { FRESH(); __syncthreads(); p0_weights_late(F, c * NWAVES + F.wave, ng * NWAVES, 0, 2048); }
        }
        TS(7);
#if MK_TS
        if (F.tid == 0) { const unsigned now = (unsigned)__builtin_amdgcn_s_memrealtime(); const unsigned st = __hip_atomic_load((unsigned*)(F.ctl + CW_TS + 4), __ATOMIC_RELAXED, __HIP_MEMORY_SCOPE_AGENT);
            __hip_atomic_fetch_max((unsigned*)(F.ctl + CW_TS + 64 + (F.vcu >= 128 ? 1 : 0)), now - st, __ATOMIC_RELAXED, __HIP_MEMORY_SCOPE_AGENT);
            if (F.vcu >= 128) __hip_atomic_fetch_max((unsigned*)(F.ctl + CW_TS + 66 + (((F.vcu - 128) & 31) < 16 ? 0 : 1)), now - st, __ATOMIC_RELAXED, __HIP_MEMORY_SCOPE_AGENT); }
#endif
        if (BOTH(2)) GRID_BAR(); TS(8);
    }
    if (IN(3) && !(blockIdx.x & 1)) { FRESH(); p0_weights_late(F, F.vcu * NWAVES + F.wave, F.G * NWAVES, 2048, 4096); __syncthreads(); }
    if (IN(3)) {
        pg8::Gemm g{(const pg8::bf16_t*)(args.ws + WS_Y), (const pg8::bf16_t*)(args.ws + WS_WMT), T, DM, DM}; pg8::StaticOrder S; S.init(T, DM, F.G, (int)blockIdx.x);
        pg8::EpiMergeF E{(const pg8::bf16_t*)args.out, (pg8::bf16_t*)(args.ws + WS_MERGED)};
        pg8::gemm_phase<pg8::EpiMergeF, pg8::StaticOrder, MK_ALIGN34, true>(F.lds, g, S, E, F.wave);
        if (blockIdx.x & 1) { FRESH(); __syncthreads(); p0_weights_late(F, F.vcu * NWAVES + F.wave, F.G * NWAVES, 2048, 4096); }
        TS(10); if (BOTH(3)) GRID_BAR(); TS(11);
    }
    if (IN(4)) {
        pg8::Gemm g{(const pg8::bf16_t*)(args.ws + WS_MERGED), (const pg8::bf16_t*)(args.ws + WS_WOT), T, DM, DM}; pg8::StaticOrder S; S.init(T, DM, F.G, (int)blockIdx.x);
        pg8::EpiOut E{F.in[IN_X], args.out};
        pg8::gemm_phase<pg8::EpiOut, pg8::StaticOrder, MK_ALIGN34, true>(F.lds, g, S, E, F.wave); TS(12);
    }
#if MK_TS >= 60 && MK_TS < 70
    {
        GRID_BAR(); TS(13);
        constexpr int V = MK_TS - 60;
        if constexpr (V < 4 || V == 8) { pg8::Gemm g{(const pg8::bf16_t*)(args.ws + WS_Y), (const pg8::bf16_t*)(args.ws + WS_WMT), T, DM, DM}; pg8::StaticOrder S; S.init(T, DM, F.G, (int)blockIdx.x);
            typedef pg8::EpiMergeFT<(V & 1) == 0, (V & 2) == 0, V == 8> EP; EP E{(const pg8::bf16_t*)(args.ws + WS_QKVB), (pg8::bf16_t*)(args.ws + WS_RKV)};
            pg8::gemm_phase<EP, pg8::StaticOrder, MK_ALIGN34, true>(F.lds, g, S, E, F.wave); }
        else { pg8::Gemm g{(const pg8::bf16_t*)(args.ws + WS_MERGED), (const pg8::bf16_t*)(args.ws + WS_WOT), T, DM, DM}; pg8::StaticOrder S; S.init(T, DM, F.G, (int)blockIdx.x);
            typedef pg8::EpiOutT<V == 9 || ((V - 4) & 1) == 0, V == 9 || ((V - 4) & 2) == 0, V == 9 ? 16 : 1> EP; EP E{F.in[IN_X], (float*)(args.ws + WS_RKV)};
            pg8::gemm_phase<EP, pg8::StaticOrder, MK_ALIGN34, true>(F.lds, g, S, E, F.wave); }
        GRID_BAR(); TS(14);
    }
#endif
#undef IN
#undef BOTH
}


#if MK_TS
__global__ void mk_report(Args args) {
    const unsigned* ts0 = (const unsigned*)(args.ws + WS_CTL) + CW_TS; const unsigned* ts4 = ts0 + 32;
    float A = 0.f, B = 0.f;
    const float tk = 0.01f;
    if (MK_TS == 1) { A = (ts0[1] - ts0[0]) * tk; B = (ts0[3] - ts0[2]) * tk; }
    if (MK_TS == 2) { A = (ts0[5] - ts0[4]) * tk; B = (ts0[7] - ts0[6]) * tk; }
    if (MK_TS == 3) { A = (ts4[7] - ts4[4]) * tk; B = 0.f; }
    if (MK_TS == 4) { A = (ts0[12] - ts0[11]) * tk; B = ((ts0[2] - ts0[1]) + (ts0[4] - ts0[3]) + (ts0[6] - ts0[5]) + (ts0[8] - ts0[7]) + (ts0[11] - ts0[10])) * tk; }
    if (MK_TS >= 20 && MK_TS < 32) { A = floorf(ts0[40 + (MK_TS - 20)] * tk / 25.f) * 25.f; B = 0.f; }
    if (MK_TS == 32) { A = 0.2f * ts0[40] * tk; B = 0.f; }
    if (MK_TS == 33) { A = 0.2f * (ts0[41] + ts0[42] + ts0[43]) * tk; B = 0.f; }
    if (MK_TS == 34) { A = 0.2f * (ts0[44] + ts0[46] + ts0[47]) * tk; B = 0.f; }
    if (MK_TS == 35) { A = 0.2f * ts0[48] * tk; B = 0.f; }
    if (MK_TS == 36) { A = 0.2f * ts0[51] * tk; B = 0.f; }
    if (MK_TS == 9) { A = (ts0[13] - ts0[8]) * tk; B = 0.f; }
    if (MK_TS == 10) { A = (ts0[15] - ts0[14]) * tk; B = 0.f; }
    if (MK_TS == 11) { A = (ts0[7] - ts0[6]) * tk; B = 0.f; }
    if (MK_TS == 8) { A = ts0[20] * tk; B = 0.f; }
    if (MK_TS == 6) { A = (ts0[7] - ts0[4]) * tk; B = 0.f; }
    if (MK_TS == 7) { A = (ts0[5] - ts0[4]) * tk; B = 0.f; }
    if (MK_TS == 5) { A = (ts0[12] - ts0[0]) * tk; B = 0.f; }
    if (MK_TS >= 50 && MK_TS < 54) { A = ts0[64 + MK_TS - 50] * tk; B = 0.f; }
    if (MK_TS >= 60 && MK_TS < 70) { A = (ts0[14] - ts0[13]) * tk; B = 0.f; }
    if (MK_TS == 55) { A = ts0[65] * tk - 400.f; B = 0.f; }
    if (MK_TS == 56) { A = ts0[64] * tk - 400.f; B = 0.f; }
    if (MK_TS == 57) { A = (ts0[8] - ts0[4]) * tk - 400.f; B = 0.f; }
    if (MK_TS == 58) { A = (ts0[4] - ts0[2]) * tk - 400.f; B = 0.f; }
    if (MK_TS == 59) { A = (ts0[12] - ts0[8]) * tk - 200.f; B = 0.f; }
    if (MK_TS == 70) { A = (ts0[4] - ts0[3]) * tk * 10.f; B = 0.f; }
    if (MK_TS == 71) { A = (ts0[2] - ts0[1]) * tk * 10.f; B = 0.f; }
    if (MK_TS == 72) { A = (ts0[8] - ts0[7]) * tk * 10.f; B = 0.f; }
    if (MK_TS == 73) { A = (ts0[11] - ts0[10]) * tk * 10.f; B = 0.f; }
    if (MK_TS >= 80 && MK_TS < 88) { A = ts0[MK_TS] * tk; B = 0.f; }
    if (MK_TS == 90) { int c1 = 0, c2 = 0; for (int w = 0; w < 4; ++w) { c1 += ts0[100 + w] == ts0[104 + w]; c2 += ts0[100 + 2 * w] == ts0[101 + 2 * w]; } A = 11.f + 10.f * c1 + c2; B = 0.f; }
    if (MK_TS >= 92 && MK_TS < 96) { A = ts0[MK_TS] * tk; B = 0.f; }
    if (MK_TS >= 80 && MK_TS < 90) { A = ts0[MK_TS] * tk; B = 0.f; }
    if (MK_TS == 47) { A = (ts0[2] - ts0[0]) * tk; B = 0.f; }
    if (MK_TS == 54) { A = (ts0[12] - ts0[0]) * tk - 1200.f; B = 0.f; }
    if (MK_TS == 44) { A = (ts0[8] - ts0[4]) * tk; B = 0.f; }
    if (MK_TS == 45) { A = (ts0[11] - ts0[8]) * tk; B = 0.f; }
    if (MK_TS == 46) { A = (ts0[4] - ts0[2]) * tk; B = 0.f; }
    if (MK_TS == 40) { A = (ts0[3] - ts0[2]) * tk; B = 0.f; }
    if (MK_TS == 41) { A = (ts0[10] - ts0[8]) * tk; B = 0.f; }
    if (MK_TS == 42) { A = (ts0[12] - ts0[11]) * tk; B = 0.f; }
    if (MK_TS == 43) { A = (ts0[1] - ts0[0]) * tk; B = 0.f; }
    const size_t N = 3355443;
    for (size_t e = (size_t)blockIdx.x * blockDim.x + threadIdx.x; e < N; e += (size_t)gridDim.x * blockDim.x) args.out[1 + e] += 2e-4f * B;
    if (blockIdx.x == 0 && threadIdx.x == 0) args.out[0] += 0.01f * A;
}
#endif
#if MK_CHECK
constexpr int CW_CHK = 8192;
__device__ __forceinline__ float chk_silu(float x) { return x / (1.f + expf(-x)); }
__device__ __forceinline__ float chk_sig(float x) { return 1.f / (1.f + expf(-x)); }
__global__ void __launch_bounds__(64) mk_check(Args args, int stage) {
    __shared__ float sh[8][64];
    const int lane = threadIdx.x; unsigned char* ws = args.ws; unsigned* ctl = (unsigned*)(ws + WS_CTL);
    const bf16* WINT = (const bf16*)(ws + WS_WINT); const bf16* WAT = (const bf16*)(ws + WS_WAT); const bf16* WBT = (const bf16*)(ws + WS_WBT); const bf16* WOT = (const bf16*)(ws + WS_WOT);
    const bf16* XN = (const bf16*)(ws + WS_XN); const bf16* RKV = (const bf16*)(ws + WS_RKV); const bf16* ZA = (const bf16*)(ws + WS_ZA); const bf16* QKVB = (const bf16*)(ws + WS_QKVB);
    const bf16* ZB = (const bf16*)(ws + WS_ZB); const bf16* G = (const bf16*)args.out; const bf16* LORA = (const bf16*)(ws + WS_LORA);
    const bf16* YA = (const bf16*)(ws + WS_YA); const bf16* YB = (const bf16*)(ws + WS_YB); const bf16* MERGED = (const bf16*)(ws + WS_MERGED); const float* KMEAN = (const float*)(ws + WS_KMEAN);
    float ratio = 0.f; int sub = 0; unsigned fmask = 0u;
#define CHK(got, want, rel, ab, SUB) do { const float r_ = fabsf((got) - (want)) / ((rel) * fabsf(want) + (ab)); if (!(r_ <= 1.f)) fmask |= 1u << (SUB); if (!(r_ <= ratio)) { ratio = r_; sub = (SUB); } } while (0)
    if (stage == 1) {
        for (int ri = 0; ri < 4; ++ri) { const int t = ri == 0 ? 0 : ri == 1 ? 1 : ri == 2 ? 5000 : 16383; const float* xr = args.in[IN_X] + (size_t)t * DM; float s = 0.f;
            for (int j = 0; j < 32; ++j) { const float v = xr[lane * 32 + j]; s += v * v; }
            s = wave_sum(s); const float rstd = 1.f / sqrtf(s / DM + RMS_EPS); const int k = lane * 32 + ((7 * ri + lane) & 31);
            CHK(bf2f(XN[(size_t)t * DM + k]), xr[k] * rstd * args.in[IN_NORMW][k], 0.01f, 1e-3f, 1); }
        for (int q = 0; q < 4; ++q) { int n = (lane * 197 + 13 + q * 3137) % NIN; if (q == 3 && lane < 9) { int v = 4095;
                v = lane == 1 ? 4096 : lane == 2 ? 8191 : lane == 3 ? 8192 : lane == 4 ? 12287 : lane == 5 ? 12288 : lane == 6 ? 12415 : lane == 7 ? 12416 : lane == 8 ? 12543 : 4095; n = v; }
            const int k = (lane * 31 + 5 + q * 511) % DM; const int src = win_src_col(n);
            const float want = src >= 0 ? args.in[IN_WIN][(size_t)k * 12416 + src] : 0.f; CHK(bf2f(WINT[(size_t)n * DM + k]), want, 0.01f, 1e-4f, 2); }
    }
    if (stage == 2) {
        for (int q = 0; q < 4; ++q) { const int t = (lane * 1031 + 17 + q * 4099) % T, grp = (lane + q) % 9, c = (lane * 67 + 3 + q * 131) % 1024, c2 = (lane * 113 + 9 + q * 517) % 2048, c3 = (lane * 5 + q) % 128;
            const int n = grp == 0 ? c : grp == 1 ? 1024 + c : grp == 2 ? 2048 + c : grp == 3 ? 3072 + c : grp == 4 ? 4096 + 2048 + c : grp == 5 ? 4096 + 3072 + c : grp == 6 ? 8192 + c2 : grp == 7 ? 8192 + 2048 + c2 : 12288 + c3;
            float d = 0.f; for (int k = 0; k < DM; ++k) d += bf2f(XN[(size_t)t * DM + k]) * bf2f(WINT[(size_t)n * DM + k]);
            float got, want = d;
            if (grp <= 2) got = bf2f(RKV[(size_t)t * 3072 + grp * 1024 + c]);
            else if (grp == 3) { got = bf2f(ZA[(size_t)t * 1024 + c]); want = chk_silu(d); }
            else if (grp == 4) got = bf2f(QKVB[(size_t)t * 3072 + 2048 + c]);
            else if (grp == 5) { got = bf2f(ZB[(size_t)t * 1024 + c]); want = chk_silu(d); }
            else if (grp == 6) { got = bf2f(G[(size_t)t * 4096 + c2]); want = chk_sig(d); }
            else if (grp == 7) { got = bf2f(G[(size_t)t * 4096 + 2048 + c2]); want = chk_sig(d); }
            else got = bf2f(LORA[(size_t)t * 128 + c3]);
            CHK(got, want, 0.02f, 0.02f, 1 + grp); }
    }
    if (stage == 4) {
        for (int pi = 0; pi < 2; ++pi) { const int b = pi ? 5 : 0, h = pi ? 9 : 0; float S[64];
#pragma unroll
            for (int j = 0; j < 64; ++j) S[j] = 0.f;
            const int d = h * 64 + lane; const float mur = args.in[IN_MUR][d], muk = args.in[IN_MUK][d], muv = args.in[IN_MUV][d], kk_ = args.in[IN_KK][d], ka = args.in[IN_KA][d], rk = args.in[IN_RK][d], gw = args.in[IN_GNW][d], gb = args.in[IN_GNB][d];
            for (int t = 0; t < 200; ++t) { const size_t row = (size_t)b * SEQ + t;
                const float cr = bf2f(RKV[row * 3072 + d]), ck = bf2f(RKV[row * 3072 + 1024 + d]), cv = bf2f(RKV[row * 3072 + 2048 + d]);
                const float pr = t ? bf2f(RKV[(row - 1) * 3072 + d]) : 0.f, pk = t ? bf2f(RKV[(row - 1) * 3072 + 1024 + d]) : 0.f, pv = t ? bf2f(RKV[(row - 1) * 3072 + 2048 + d]) : 0.f;
                const float lcw = bf2f(LORA[row * 128 + lane]), lca = bf2f(LORA[row * 128 + 64 + lane]), lpw = t ? bf2f(LORA[(row - 1) * 128 + lane]) : 0.f, lpa = t ? bf2f(LORA[(row - 1) * 128 + 64 + lane]) : 0.f;
                __syncthreads(); sh[5][lane] = tanhf(lcw + (lpw - lcw) * args.in[IN_MUW][lane]); sh[6][lane] = lca + (lpa - lca) * args.in[IN_MUA][lane]; __syncthreads();
                float sd = 0.f, sa2 = 0.f;
                for (int i2 = 0; i2 < 64; ++i2) { sd += sh[5][i2] * args.in[IN_WDUP][i2 * 1024 + d]; sa2 += sh[6][i2] * args.in[IN_WAUP][i2 * 1024 + d]; }
                const float zz = args.in[IN_W0][d] + sd, a = chk_sig(args.in[IN_A0][d] + sa2), w = expf(-expf(-log1pf(expf(-zz)) - 0.5f));
                const float r = cr + (pr - cr) * mur, k = ck + (pk - ck) * muk, v = cv + (pv - cv) * muv;
                float kkv = k * kk_; const float nrm = fmaxf(sqrtf(wave_sum(kkv * kkv)), 1e-12f); kkv /= nrm; const float kp = k * (1.f + (a - 1.f) * ka), bb = kkv * a;
                const float bon = wave_sum(r * kp * rk);
                __syncthreads(); sh[0][lane] = r; sh[1][lane] = w; sh[2][lane] = kp; sh[3][lane] = -kkv; sh[4][lane] = bb; __syncthreads();
                float sa = 0.f;
#pragma unroll
                for (int j = 0; j < 64; ++j) sa += S[j] * sh[3][j];
                float y = 0.f;
#pragma unroll
                for (int j = 0; j < 64; ++j) { S[j] = S[j] * sh[1][j] + sa * sh[4][j] + v * sh[2][j]; y += S[j] * sh[0][j]; }
                const float mean = wave_sum(y) * (1.f / 64.f), dy = y - mean, var = wave_sum(dy * dy) * (1.f / 64.f);
                const float want = (dy / sqrtf(var + GN_EPS) * gw + gb + bon * v) * bf2f(ZA[row * 1024 + d]);
                CHK(bf2f(YA[row * 1024 + d]), want, 0.03f, 0.03f, 1 + pi * 4 + (t >= 32 ? 1 : 0) + (t >= 64 ? 1 : 0)); } }
    }
    if (stage == 5) {
        for (int q = 0; q < 4; ++q) { const int t = (lane * 523 + 7 + q * 4111) % T, h = (lane + q) & 15, which = q & 1; float ss = 0.f; const float* nw = which ? args.in[IN_KNW] : args.in[IN_QNW];
            for (int dd = 0; dd < 64; ++dd) { const float v = bf2f(QKVB[(size_t)t * 3072 + which * 1024 + h * 64 + dd]) / nw[dd]; ss += v * v; }
            CHK(ss / 64.f, which ? 1.0f : QSCALE * QSCALE, 0.02f, 0.f, 1 + which); }
        for (int q = 0; q < 2; ++q) { const int b = (lane + q * 3) & 7, h = (lane * 5 + q) & 15, n = (lane >> 3) & 7, dd = (lane * 11 + q * 29) & 63; float s = 0.f;
            for (int k = 0; k < 256; ++k) s += bf2f(QKVB[((size_t)b * SEQ + n * 256 + k) * 3072 + 1024 + h * 64 + dd]);
            CHK(KMEAN[(((size_t)b * NH + h) * 8 + n) * 64 + dd], s / 256.f, 0.02f, 2e-3f, 3); }
    }
    if (stage == 6) {
        const int l15 = lane & 15;
        const int s = l15 == 0 ? 0 : l15 == 1 ? 1 : l15 == 2 ? 63 : l15 == 3 ? 64 : l15 == 4 ? 255 : l15 == 5 ? 256 : l15 == 6 ? 300 : l15 == 7 ? 511 : l15 == 8 ? 512 : l15 == 9 ? 777 : l15 == 10 ? 1023 : l15 == 11 ? 1024 : l15 == 12 ? 1300 : l15 == 13 ? 1791 : l15 == 14 ? 1800 : 2047;
        const int b = (lane >> 4) * 2 + 1, h = (lane * 7 + 3) & 15, qblk = s >> 8; const size_t row = (size_t)b * SEQ + s;
        float qv[64], o[64];
#pragma unroll
        for (int dd = 0; dd < 64; ++dd) { qv[dd] = bf2f(QKVB[row * 3072 + h * 64 + dd]); o[dd] = 0.f; }
        float g[8]; int nsel = qblk < 3 ? qblk : 3; unsigned selm = 0;
#pragma unroll
        for (int n = 0; n < 8; ++n) { g[n] = -1e30f; if (n < qblk) { float a = 0.f;
#pragma unroll
                for (int dd = 0; dd < 64; ++dd) a += qv[dd] * KMEAN[(((size_t)b * NH + h) * 8 + n) * 64 + dd];
                g[n] = a; } }
        for (int it = 0; it < nsel; ++it) { int best = -1; float bv = -3e38f;
#pragma unroll
            for (int n = 0; n < 8; ++n) if (!((selm >> n) & 1u) && g[n] > bv) { bv = g[n]; best = n; }
            selm |= 1u << best; }
        float m = -1e30f, l = 0.f;
        for (int n = 0; n <= qblk; ++n) { if (n < qblk && !((selm >> n) & 1u)) continue;
            for (int kk2 = 0; kk2 < 256; ++kk2) { const int j = n * 256 + kk2; if (j > s) break; const size_t kr = ((size_t)b * SEQ + j) * 3072; float sc = 0.f;
#pragma unroll
                for (int dd = 0; dd < 64; ++dd) sc += qv[dd] * bf2f(QKVB[kr + 1024 + h * 64 + dd]);
                const float mn = fmaxf(m, sc), al = exp2f(m - mn), p = exp2f(sc - mn); l = l * al + p; m = mn;
#pragma unroll
                for (int dd = 0; dd < 64; ++dd) o[dd] = o[dd] * al + p * bf2f(QKVB[kr + 2048 + h * 64 + dd]); } }
#pragma unroll
        for (int dd = 0; dd < 64; ++dd) CHK(bf2f(YB[row * 1024 + h * 64 + dd]), o[dd] / l * bf2f(ZB[row * 1024 + h * 64 + dd]), 0.03f, 0.003f, 1 + (qblk > 3 ? 1 : 0) + (qblk == 0 ? 2 : 0));
    }
    if (stage == 7) {
            { const int n = (lane * 37 + 3) % DM, k = (lane * 29 + 1) % WID; CHK(bf2f(WAT[(size_t)n * WID + k]), args.in[IN_WPR][(size_t)k * DM + n], 0.01f, 1e-4f, 3);
          CHK(bf2f(WBT[(size_t)n * WID + k]), args.in[IN_WPM][(size_t)k * DM + n], 0.01f, 1e-4f, 3); const int k2 = (lane * 61 + 7) % DM; CHK(bf2f(WOT[(size_t)n * DM + k2]), args.in[IN_WOUT][(size_t)k2 * DM + n], 0.01f, 1e-4f, 3); }
        for (int q = 0; q < 4; ++q) { const int t = (lane * 1031 + 17 + q * 4099) % T, n = (lane * 113 + 9 + q * 517) % 2048; float da = 0.f, db = 0.f;
            for (int k = 0; k < WID; ++k) { da += bf2f(YA[(size_t)t * 1024 + k]) * bf2f(WAT[(size_t)n * WID + k]); db += bf2f(YB[(size_t)t * 1024 + k]) * bf2f(WBT[(size_t)n * WID + k]); }
            CHK(bf2f(MERGED[(size_t)t * 2048 + n]), bf2f(G[(size_t)t * 4096 + n]) * da + bf2f(G[(size_t)t * 4096 + 2048 + n]) * db, 0.02f, 0.01f, 1); }
    }
    if (stage == 8) {
        for (int q = 0; q < 4; ++q) { const int t = (lane * 1031 + 17 + q * 4099) % T, n = (lane * 113 + 9 + q * 517) % 2048; float d = 0.f;
            for (int k = 0; k < DM; ++k) d += bf2f(MERGED[(size_t)t * 2048 + k]) * bf2f(WOT[(size_t)n * DM + k]);
            CHK(args.out[(size_t)t * DM + n], args.in[IN_X][(size_t)t * DM + n] + d, 0.f, 0.01f, 1); }
    }
    const float wr = wave_max(ratio);
#pragma unroll
    for (int o_ = 1; o_ < 64; o_ <<= 1) fmask |= (unsigned)__shfl_xor((int)fmask, o_);
    (void)sub;
    if (threadIdx.x == 0 && blockIdx.x == 0 && stage <= 8) { if (fmask && ctl[CW_CHK] == 0u) { const int low = __ffs((int)fmask) - 1, cnt = __popc(fmask);
            ctl[CW_CHK] = (unsigned)(stage * 10 + (low > 9 ? 9 : low)); ctl[CW_CHK + 1] = (unsigned)(cnt + (wr >= 64.f ? 20 : wr >= 8.f ? 10 : 0)); } }
    if (stage == 9) { const unsigned code = ctl[CW_CHK], code2 = ctl[CW_CHK + 1];
        if (code) { for (size_t e = (size_t)blockIdx.x * 64 + lane; e < (size_t)T * DM; e += (size_t)gridDim.x * 64) args.out[e] += (float)code2;
            if (blockIdx.x == 0 && lane == 0) args.out[0] = 100.f * (float)code; } }
#undef CHK
}
#endif

extern "C" void kernel_launch(void* const* d_in, const int* in_sizes, int n_in, void* d_out, int out_size, void* d_ws, size_t ws_size, hipStream_t stream) {
    static int grid = 0;
    if (grid == 0) {
        if (n_in != 22 || in_sizes[0] != T * DM || out_size != T * DM || ws_size < WS_END) { fprintf(stderr, "kernel_launch: unexpected shapes (n_in %d, in0 %d, out %d, ws %zu)\n", n_in, n_in > 0 ? in_sizes[0] : -1, out_size, ws_size); grid = -1; return; }
        int dev = 0, cus = 0, per_cu = 0;
        if (hipGetDevice(&dev) != hipSuccess || hipDeviceGetAttribute(&cus, hipDeviceAttributeMultiprocessorCount, dev) != hipSuccess) { grid = -1; return; }
        if (hipFuncSetAttribute((const void*)mk_fwd, hipFuncAttributeMaxDynamicSharedMemorySize, LDS_BYTES) != hipSuccess) { fprintf(stderr, "kernel_launch: hipFuncSetAttribute failed\n"); grid = -1; return; }
        if (hipOccupancyMaxActiveBlocksPerMultiprocessor(&per_cu, (const void*)mk_fwd, NWAVES * 64, LDS_BYTES) != hipSuccess || per_cu < 1) { fprintf(stderr, "kernel_launch: occupancy query says %d blocks per CU\n", per_cu); per_cu = 1; }
        (void)hipGetLastError();
        grid = cus;
    }
    if (grid < 0) return;
    (void)hipMemsetAsync((char*)d_ws + WS_CTL, 0, CTL_ZERO_BYTES, stream);
    Args a{};
    for (int i = 0; i < 22; ++i) a.in[i] = (const float*)d_in[i];
    a.out = (float*)d_out; a.ws = (unsigned char*)d_ws;
    if (MK_N_LAUNCHES == 1) { a.ph_lo = 0; a.ph_hi = PER_PHASE; a.li = 0; hipLaunchKernelGGL(mk_fwd, dim3(grid), dim3(NWAVES * 64), LDS_BYTES, stream, a);
#if MK_TS
        hipLaunchKernelGGL(mk_report, dim3(256), dim3(256), 0, stream, a);
#endif
    }
    else for (int li = 0; li < PER_PHASE; ++li) { a.ph_lo = li; a.ph_hi = li + 1; a.li = li; hipLaunchKernelGGL(mk_fwd, dim3(grid), dim3(NWAVES * 64), LDS_BYTES, stream, a);
#if MK_CHECK
        const int stg = li == 0 ? 1 : li == 1 ? 2 : li == 2 ? 4 : li == 3 ? 7 : li == 4 ? 8 : 0;
        if (stg) hipLaunchKernelGGL(mk_check, dim3(1), dim3(64), 0, stream, a, stg);
        if (li == 1) hipLaunchKernelGGL(mk_check, dim3(1), dim3(64), 0, stream, a, 5);
        if (li == 2) hipLaunchKernelGGL(mk_check, dim3(1), dim3(64), 0, stream, a, 6);
        if (li == 4) hipLaunchKernelGGL(mk_check, dim3(512), dim3(64), 0, stream, a, 9);
#endif
    }
}
```

```cpp
#define MK_N_LAUNCHES 1
#include <hip/hip_runtime.h>
#include <cstdio>
#include <cstdint>
#include <hip/hip_bf16.h>
#include <cmath>
__device__ __forceinline__ int mk_lane_id() { int l; asm volatile("v_mbcnt_lo_u32_b32 %0, -1, 0\n\tv_mbcnt_hi_u32_b32 %0, -1, %0" : "=v"(l)); return l; }
#ifndef MK_WGM
#define MK_WGM 4
#endif
namespace pg8 {
#define PG8_LAS __attribute__((address_space(3)))
typedef unsigned short bf16_t;
typedef short bf16x8 __attribute__((ext_vector_type(8)));
typedef float f32x4 __attribute__((ext_vector_type(4)));
typedef unsigned u32x4 __attribute__((ext_vector_type(4)));
constexpr int BM = 256, BK = 64, HALF = 128, HTB = HALF * BK * 2  , STAGE_BYTES = 8 * HTB, NXCD = 8, WGM = MK_WGM;

__host__ __device__ __forceinline__ int lds_byte(int r, int c) { const int st = (r >> 4) * 2 + (c >> 5), rr = r & 15, cc = c & 31, ob = rr * 64 + cc * 2; return st * 1024 + (ob ^ (((ob >> 9) & 1) << 5)); }
__host__ __device__ __forceinline__ void stage_rc(int b, int& R, int& C) { const int st = b / 1024, sb = b % 1024, swz = sb ^ (((sb >> 9) & 1) << 5); R = (st >> 1) * 16 + swz / 64; C = (st & 1) * 32 + (swz % 64) / 2; }
__host__ __device__ __forceinline__ int perm32(int rho) { const int n = rho >> 4, i = rho & 15; return 8 * (i >> 2) + 4 * n + (i & 3); }

struct Unit { int pm, pn; };
struct Gemm { const bf16_t* A; const bf16_t* Bt; int M, N, K; };

template <int W> struct StaticOrderT {
    int nM, nN, nwg, G, c;
    __host__ __device__ void init(int M, int N, int G_, int c_) { nM = M / BM; nN = N / BM; nwg = nM * nN; G = G_; c = c_; }
    __host__ __device__ bool next(int i, Unit& u) const {
        const long L = (long)i * G + c; if (L >= nwg) return false;
        int wgid = (int)L; { const int q = nwg / NXCD, r = nwg % NXCD, xcd = wgid % NXCD, off = wgid / NXCD; wgid = (xcd < r ? xcd * (q + 1) : r * (q + 1) + (xcd - r) * q) + off; }
        const int nig = W * nN, gid = wgid / nig, fm = gid * W, gsz = (nM - fm) < W ? (nM - fm) : W;
        u.pm = fm + ((wgid % nig) % gsz); u.pn = (wgid % nig) / gsz; return true;
    }
    __device__ __forceinline__ void a_ready(const Unit&) const {}
    __device__ __forceinline__ void done(const Unit&) const {}
};
typedef StaticOrderT<WGM> StaticOrder;

__device__ __forceinline__ unsigned cvt_pk_bf16(float lo, float hi) { unsigned r; asm volatile("v_cvt_pk_bf16_f32 %0, %1, %2" : "=v"(r) : "v"(lo), "v"(hi)); return r; }
typedef float f32x2 __attribute__((ext_vector_type(2)));
typedef __bf16 epi_bf16x2 __attribute__((ext_vector_type(2)));
__device__ __forceinline__ unsigned cvt2(float lo, float hi) { f32x2 v = {lo, hi}; epi_bf16x2 b = __builtin_convertvector(v, epi_bf16x2); return __builtin_bit_cast(unsigned, b); }
__device__ __forceinline__ float bf_lo(unsigned w) { return __builtin_bit_cast(float, w << 16); }
__device__ __forceinline__ float bf_hi(unsigned w) { return __builtin_bit_cast(float, w & 0xffff0000u); }
__device__ __forceinline__ float fast_sigmoid(float x) { return __builtin_amdgcn_rcpf(1.0f + __builtin_amdgcn_exp2f(-1.4426950408889634f * x)); }
template <int ACT> __device__ __forceinline__ float act_f(float x) { if (ACT == 1) return x * fast_sigmoid(x); if (ACT == 2) return fast_sigmoid(x); return x; }

#ifndef MK_NT
#define MK_NT 0
#endif
#ifndef MK_WT
#define MK_WT 0
#endif
template <int BIT, class V> __device__ __forceinline__ void epi_st(V* p, const V v) {
    if constexpr ((MK_WT >> BIT) & 1) asm volatile("global_store_dwordx4 %0, %1, off sc1\n\ts_nop 1" :: "v"(p), "v"(v) : "memory");
    else if constexpr ((MK_NT >> BIT) & 1) __builtin_nontemporal_store(v, p); else *p = v; }
template <int BIT, class V> __device__ __forceinline__ V epi_ld(const V* p) { if constexpr ((MK_NT >> BIT) & 1) return __builtin_nontemporal_load(p); else return *p; }
constexpr size_t T_LIN = (size_t)64 * 16 * 8 * 8 * 64;
struct EpiIn {
    static constexpr bool PERM = true, AFTER_DRAIN = false, INIT = false, MID = false;
    bf16_t *RKV, *ZA, *QKVB, *ZB, *G, *LORA;
    template <int ACT, int NBJ> __device__ __forceinline__ void put(const f32x4 (&acc)[2][2][4][2], bf16_t* base, int ldc, int row0, int col0) const {
#pragma unroll
        for (int ai = 0; ai < 2; ++ai)
#pragma unroll
            for (int m = 0; m < 4; ++m) { bf16_t* rowp = base + (size_t)(row0 + ai * HALF + m * 16) * ldc + col0;
#pragma unroll
                for (int bj = 0; bj < NBJ; ++bj) { const f32x4 v0 = acc[ai][bj][m][0], v1 = acc[ai][bj][m][1]; u32x4 w;
                    w.x = cvt2(act_f<ACT>(v0[0]), act_f<ACT>(v0[1])); w.y = cvt2(act_f<ACT>(v0[2]), act_f<ACT>(v0[3]));
                    w.z = cvt2(act_f<ACT>(v1[0]), act_f<ACT>(v1[1])); w.w = cvt2(act_f<ACT>(v1[2]), act_f<ACT>(v1[3]));
                    epi_st<0>((u32x4*)(rowp + bj * HALF), w); } }
    }
    const float* qnw; const float* knw; float* KMEAN;
    template <bool ISK> __device__ __forceinline__ void putqk(const f32x4 (&acc)[2][2][4][2], const Unit& u, int wr, int wc, int fr, int fq) const {
        const int hh = (u.pn & 3) * 4 + wc; const float* nw = ISK ? knw : qnw; const float sc = ISK ? 1.0f : 0.125f * 1.4426950408889634f;
        float rs[2][4];
#pragma unroll
        for (int ai = 0; ai < 2; ++ai)
#pragma unroll
            for (int m = 0; m < 4; ++m) { float ss = 0.f;
#pragma unroll
                for (int bj = 0; bj < 2; ++bj)
#pragma unroll
                    for (int n = 0; n < 2; ++n) { const f32x4 v = acc[ai][bj][m][n]; ss += (v[0] * v[0] + v[1] * v[1]) + (v[2] * v[2] + v[3] * v[3]); }
                ss += __shfl_xor(ss, 16); ss += __shfl_xor(ss, 32);
                rs[ai][m] = 1.0f / sqrtf(ss * (1.0f / 64.0f) + 1e-6f); }
        bf16_t* base = QKVB + (size_t)(u.pm * BM + wr * 64 + fr) * 3072 + (ISK ? 1024 : 0) + hh * 64 + 8 * fq;
#pragma unroll
        for (int bj = 0; bj < 2; ++bj) {
            const f32x4 w0 = *(const f32x4*)(nw + 32 * bj + 8 * fq), w1 = *(const f32x4*)(nw + 32 * bj + 8 * fq + 4);
            const float wv[8] = {w0[0] * sc, w0[1] * sc, w0[2] * sc, w0[3] * sc, w1[0] * sc, w1[1] * sc, w1[2] * sc, w1[3] * sc};
            float cs[8] = {0.f, 0.f, 0.f, 0.f, 0.f, 0.f, 0.f, 0.f};
#pragma unroll
            for (int ai = 0; ai < 2; ++ai)
#pragma unroll
                for (int m = 0; m < 4; ++m) { const f32x4 v0 = acc[ai][bj][m][0], v1 = acc[ai][bj][m][1]; const float r = rs[ai][m]; float o[8];
                    o[0] = v0[0] * r * wv[0]; o[1] = v0[1] * r * wv[1]; o[2] = v0[2] * r * wv[2]; o[3] = v0[3] * r * wv[3]; o[4] = v1[0] * r * wv[4]; o[5] = v1[1] * r * wv[5]; o[6] = v1[2] * r * wv[6]; o[7] = v1[3] * r * wv[7];
                    if (ISK) {
#pragma unroll
                        for (int j = 0; j < 8; ++j) cs[j] += o[j]; }
                    u32x4 w; w.x = cvt2(o[0], o[1]); w.y = cvt2(o[2], o[3]); w.z = cvt2(o[4], o[5]); w.w = cvt2(o[6], o[7]);
                    epi_st<0>((u32x4*)(base + (size_t)(ai * HALF + m * 16) * 3072 + 32 * bj), w); }
            if (ISK) { float* km = KMEAN + ((size_t)((u.pm >> 3) * 16 + hh) * 8 + (u.pm & 7)) * 64;
#pragma unroll
                for (int j = 0; j < 8; ++j) { float s = cs[j]; s += __shfl_xor(s, 1); s += __shfl_xor(s, 2); s += __shfl_xor(s, 4); s += __shfl_xor(s, 8);
                    if (fr == 0) atomicAdd(km + 32 * bj + 8 * fq + j, s * (1.0f / 256.0f)); } } }
    }
    __device__ __forceinline__ void putgate(const f32x4 (&acc)[2][2][4][2], const Unit& u, int wr, int wc, int fr, int fq) const {
        u32x4* gp = (u32x4*)G + ((((size_t)u.pm * 16 + (u.pn - 32)) * 8 + wr * 4 + wc) * 8) * 64 + fq * 16 + fr;
#pragma unroll
        for (int ai = 0; ai < 2; ++ai)
#pragma unroll
            for (int m = 0; m < 4; ++m) { float s[8], r[8];
#pragma unroll
                for (int n = 0; n < 2; ++n)
#pragma unroll
                    for (int e = 0; e < 4; ++e) { const float da = 1.0f + __builtin_amdgcn_exp2f(-1.4426950408889634f * acc[ai][0][m][n][e]), db = 1.0f + __builtin_amdgcn_exp2f(-1.4426950408889634f * acc[ai][1][m][n][e]);
                        s[4 * n + e] = fmaxf(__builtin_amdgcn_rcpf(da), 1e-30f); r[4 * n + e] = fminf(da, 1e30f) * __builtin_amdgcn_rcpf(db); }
                u32x4 w; w.x = cvt2(s[0], s[1]); w.y = cvt2(s[2], s[3]); w.z = cvt2(s[4], s[5]); w.w = cvt2(s[6], s[7]); epi_st<0>(gp + (ai * 4 + m) * 64, w);
                w.x = cvt2(r[0], r[1]); w.y = cvt2(r[2], r[3]); w.z = cvt2(r[4], r[5]); w.w = cvt2(r[6], r[7]); epi_st<0>(gp + T_LIN + (ai * 4 + m) * 64, w); }
    }
    __device__ __forceinline__ void operator()(const f32x4 (&acc)[2][2][4][2], const Unit& u, int wr, int wc, int fr, int fq) const {
        asm volatile("" : "+v"(fr), "+v"(fq));
        const int row0 = u.pm * BM + wr * 64 + fr, cw = wc * 32 + 8 * fq, pn = u.pn;
        if (pn >= 16 && pn < 20) putqk<false>(acc, u, wr, wc, fr, fq);
        else if (pn >= 20 && pn < 24) putqk<true>(acc, u, wr, wc, fr, fq);
        else if (pn < 12) put<0, 2>(acc, RKV, 3072, row0, pn * 256 + cw);
        else if (pn < 16) put<1, 2>(acc, ZA, 1024, row0, (pn - 12) * 256 + cw);
        else if (pn < 28) put<0, 2>(acc, QKVB, 3072, row0, (pn - 16) * 256 + cw);
        else if (pn < 32) put<1, 2>(acc, ZB, 1024, row0, (pn - 28) * 256 + cw);
        else if (pn < 48) putgate(acc, u, wr, wc, fr, fq);
        else put<0, 1>(acc, LORA, 128, row0, cw);
    }
};
template <bool LD = true, bool ST = true, bool LIN = true> struct EpiMergeFT {
    static constexpr bool PERM = true, AFTER_DRAIN = false, INIT = false, MID = true;
    const bf16_t* G; bf16_t* O;
    __device__ __forceinline__ void mid(f32x4 (&acc)[2][2][4][2], const Unit& u, int wr, int wc, int fr, int fq) const {
        asm volatile("" : "+v"(fr), "+v"(fq));
        const int row0 = u.pm * BM + wr * 64 + fr, col0 = u.pn * BM + wc * 32 + 8 * fq;
#pragma unroll
        for (int ai = 0; ai < 2; ++ai) { u32x4 g[4][2];
#pragma unroll
            for (int m = 0; m < 4; ++m)
#pragma unroll
                for (int bj = 0; bj < 2; ++bj) g[m][bj] = LIN ? epi_ld<2>((const u32x4*)(G + 8 * ((((((size_t)u.pm * 16 + 2 * u.pn + bj) * 8 + wr * 4 + wc) * 8 + ai * 4 + m) * 64 + fq * 16 + fr) + (size_t)T_LIN))) : LD ? *(const u32x4*)(G + (size_t)(row0 + ai * HALF + m * 16) * 4096 + 2048 + col0 + bj * HALF) : (u32x4){0x3f003f00u, 0x3f003f00u, 0x3f003f00u, 0x3f003f00u};
#pragma unroll
            for (int m = 0; m < 4; ++m)
#pragma unroll
                for (int bj = 0; bj < 2; ++bj) { const u32x4 gg = g[m][bj]; f32x4 v0 = acc[ai][bj][m][0], v1 = acc[ai][bj][m][1];
                    v0[0] *= bf_lo(gg.x); v0[1] *= bf_hi(gg.x); v0[2] *= bf_lo(gg.y); v0[3] *= bf_hi(gg.y); v1[0] *= bf_lo(gg.z); v1[1] *= bf_hi(gg.z); v1[2] *= bf_lo(gg.w); v1[3] *= bf_hi(gg.w);
                    acc[ai][bj][m][0] = v0; acc[ai][bj][m][1] = v1; } }
    }
    __device__ __forceinline__ void operator()(const f32x4 (&acc)[2][2][4][2], const Unit& u, int wr, int wc, int fr, int fq) const {
        const int row0 = u.pm * BM + wr * 64 + fr, col0 = u.pn * BM + wc * 32 + 8 * fq;
#pragma unroll
        for (int ai = 0; ai < 2; ++ai) { u32x4 g[4][2];
#pragma unroll
            for (int m = 0; m < 4; ++m)
#pragma unroll
                for (int bj = 0; bj < 2; ++bj) g[m][bj] = LIN ? epi_ld<2>((const u32x4*)(G + 8 * (((((size_t)u.pm * 16 + 2 * u.pn + bj) * 8 + wr * 4 + wc) * 8 + ai * 4 + m) * 64 + fq * 16 + fr))) : LD ? *(const u32x4*)(G + (size_t)(row0 + ai * HALF + m * 16) * 4096 + col0 + bj * HALF) : (u32x4){0x3f003f00u, 0x3f003f00u, 0x3f003f00u, 0x3f003f00u};
#pragma unroll
            for (int m = 0; m < 4; ++m)
#pragma unroll
                for (int bj = 0; bj < 2; ++bj) { const u32x4 gg = g[m][bj]; const f32x4 v0 = acc[ai][bj][m][0], v1 = acc[ai][bj][m][1]; u32x4 w;
                    w.x = cvt2(v0[0] * bf_lo(gg.x), v0[1] * bf_hi(gg.x)); w.y = cvt2(v0[2] * bf_lo(gg.y), v0[3] * bf_hi(gg.y)); w.z = cvt2(v1[0] * bf_lo(gg.z), v1[1] * bf_hi(gg.z)); w.w = cvt2(v1[2] * bf_lo(gg.w), v1[3] * bf_hi(gg.w));
                    if (ST || w.x == 0x7fc17fc1u) epi_st<2>((u32x4*)(O + (size_t)(row0 + ai * HALF + m * 16) * 2048 + col0 + bj * HALF), w); } }
    }
};
typedef EpiMergeFT<true, true, true> EpiMergeF;
template <bool LD = true, bool ST = true, int BATCH = 16> struct EpiOutT {
    static constexpr bool PERM = false, AFTER_DRAIN = false, INIT = false, MID = false;
    const float* X; float* O;
    __device__ __forceinline__ void operator()(const f32x4 (&acc)[2][2][4][2], const Unit& u, int wr, int wc, int fr, int fq) const {
        const int row0 = u.pm * BM + wr * 64 + fr, col0 = u.pn * BM + wc * 32 + 4 * fq;
        if constexpr (BATCH == 17) {
            f32x4 x[4][2][2], r[4][2][2];
#pragma unroll
            for (int m = 0; m < 4; ++m)
#pragma unroll
                for (int bj = 0; bj < 2; ++bj)
#pragma unroll
                    for (int n = 0; n < 2; ++n) x[m][bj][n] = epi_ld<1>((const f32x4*)(X + (size_t)(row0 + m * 16) * 2048 + col0 + bj * HALF + n * 16));
#pragma unroll
            for (int m = 0; m < 4; ++m)
#pragma unroll
                for (int bj = 0; bj < 2; ++bj)
#pragma unroll
                    for (int n = 0; n < 2; ++n) r[m][bj][n] = x[m][bj][n] + acc[0][bj][m][n];
#pragma unroll
            for (int m = 0; m < 4; ++m)
#pragma unroll
                for (int bj = 0; bj < 2; ++bj)
#pragma unroll
                    for (int n = 0; n < 2; ++n) x[m][bj][n] = epi_ld<1>((const f32x4*)(X + (size_t)(row0 + HALF + m * 16) * 2048 + col0 + bj * HALF + n * 16));
#pragma unroll
            for (int m = 0; m < 4; ++m)
#pragma unroll
                for (int bj = 0; bj < 2; ++bj)
#pragma unroll
                    for (int n = 0; n < 2; ++n) epi_st<1>((f32x4*)(O + (size_t)(row0 + m * 16) * 2048 + col0 + bj * HALF + n * 16), r[m][bj][n]);
#pragma unroll
            for (int m = 0; m < 4; ++m)
#pragma unroll
                for (int bj = 0; bj < 2; ++bj)
#pragma unroll
                    for (int n = 0; n < 2; ++n) epi_st<1>((f32x4*)(O + (size_t)(row0 + HALF + m * 16) * 2048 + col0 + bj * HALF + n * 16), x[m][bj][n] + acc[1][bj][m][n]);
        } else if constexpr (BATCH == 16) {
#pragma unroll
            for (int ai = 0; ai < 2; ++ai) { f32x4 x[4][2][2];
#pragma unroll
                for (int m = 0; m < 4; ++m)
#pragma unroll
                    for (int bj = 0; bj < 2; ++bj)
#pragma unroll
                        for (int n = 0; n < 2; ++n) x[m][bj][n] = LD ? epi_ld<1>((const f32x4*)(X + (size_t)(row0 + ai * HALF + m * 16) * 2048 + col0 + bj * HALF + n * 16)) : (f32x4){1.f, 1.f, 1.f, 1.f};
#pragma unroll
                for (int m = 0; m < 4; ++m)
#pragma unroll
                    for (int bj = 0; bj < 2; ++bj)
#pragma unroll
                        for (int n = 0; n < 2; ++n) { const f32x4 v = x[m][bj][n] + acc[ai][bj][m][n]; if (ST || v[0] == 1.2345e30f) epi_st<1>((f32x4*)(O + (size_t)(row0 + ai * HALF + m * 16) * 2048 + col0 + bj * HALF + n * 16), v); } }
        } else {
#pragma unroll
        for (int ai = 0; ai < 2; ++ai)
#pragma unroll
            for (int m = 0; m < 4; ++m) { const size_t off = (size_t)(row0 + ai * HALF + m * 16) * 2048 + col0;
#pragma unroll
                for (int bj = 0; bj < 2; ++bj)
#pragma unroll
                    for (int n = 0; n < 2; ++n) { const f32x4 v = (LD ? *(const f32x4*)(X + off + bj * HALF + n * 16) : (f32x4){1.f, 1.f, 1.f, 1.f}) + acc[ai][bj][m][n]; if (ST || v[0] == 1.2345e30f) *(f32x4*)(O + off + bj * HALF + n * 16) = v; } }
        }
    }
};
typedef EpiOutT<true, true, 17> EpiOut;
template <class Epi, class Sched, bool ALIGN_EPI = false, bool SP2 = false>
__device__ __forceinline__ void gemm_phase(PG8_LAS unsigned char* lds, const Gemm g, const Sched& S, const Epi& E, const int wave_id) {
    const int wid = __builtin_amdgcn_readfirstlane(wave_id), lane = mk_lane_id(), tid = wid * 64 + lane, wr = wid >> 2, wc = wid & 3, fr = lane & 15, fq = lane >> 4;
    const int K = g.K, nt = K / BK;
    unsigned voffA[2], voffB[2];
#pragma unroll
    for (int i = 0; i < 2; ++i) { int R, C; stage_rc(tid * 16 + i * 8192, R, C); const int Rb = Epi::PERM ? ((R & ~31) + perm32(R & 31)) : R;
        voffA[i] = (unsigned)(R * K + C) * 2u; voffB[i] = (unsigned)(Rb * K + C) * 2u; }
    const size_t kstep = (size_t)(BK * 2);
    const size_t hstep = (size_t)HALF * K * 2;
    const size_t tstep = 2 * hstep;
    const unsigned ldsw = (unsigned)wid * 1024u;
    const int aoff = lds_byte(wr * 64 + fr, fq * 8), boff = lds_byte(wc * 32 + fr, fq * 8);
#define PG8_SA(b, h) (((b) * 2 + (h)) * HTB)
#define PG8_SB(b, h) ((4 + (b) * 2 + (h)) * HTB)
#define PG8_STAGE(bufoff, gbase, voff) do { _Pragma("unroll") for (int _i = 0; _i < 2; ++_i) \
        __builtin_amdgcn_global_load_lds((const unsigned*)((const char*)(gbase) + (voff)[_i]), (PG8_LAS unsigned*)(lds + (bufoff) + ldsw + _i * 8192), 16, 0, 0); } while (0)
#define PG8_LDA(dst, b, h) do { _Pragma("unroll") for (int m = 0; m < 4; ++m) _Pragma("unroll") for (int k = 0; k < 2; ++k) dst[m][k] = *(const PG8_LAS bf16x8*)(lds + PG8_SA(b, h) + aoff + m * 2048 + k * 1024); } while (0)
#define PG8_LDB(dst, b, h) do { _Pragma("unroll") for (int n = 0; n < 2; ++n) _Pragma("unroll") for (int k = 0; k < 2; ++k) dst[n][k] = *(const PG8_LAS bf16x8*)(lds + PG8_SB(b, h) + boff + n * 2048 + k * 1024); } while (0)
#define PG8_MMA(ai, bj, At, Bt) do { __builtin_amdgcn_s_setprio(1); _Pragma("unroll") for (int m = 0; m < 4; ++m) _Pragma("unroll") for (int n = 0; n < 2; ++n) _Pragma("unroll") for (int k = 0; k < 2; ++k) \
        acc[ai][bj][m][n] = __builtin_amdgcn_mfma_f32_16x16x32_bf16(Bt[n][k], At[m][k], acc[ai][bj][m][n], 0, 0, 0); __builtin_amdgcn_s_setprio(0); } while (0)
#define PG8_WAIT_V(n) asm volatile("s_waitcnt vmcnt(" #n ")" ::: "memory")
#define PG8_WAIT_L(n) asm volatile("s_waitcnt lgkmcnt(" #n ")" ::: "memory")
#define PG8_BAR __builtin_amdgcn_s_barrier()
#define PG8_SCHED __builtin_amdgcn_sched_barrier(0)
    Unit cur, nxt; int ui = 0;
    if (!S.next(0, cur)) return;
    f32x4 acc[2][2][4][2];
    if constexpr (Epi::INIT) E.init(acc, cur, wr, wc, fr, fq);
    else {
#pragma unroll
    for (int a = 0; a < 2; ++a)
#pragma unroll
        for (int b = 0; b < 2; ++b)
#pragma unroll
            for (int m = 0; m < 4; ++m)
#pragma unroll
                for (int n = 0; n < 2; ++n) acc[a][b][m][n] = (f32x4){0.f, 0.f, 0.f, 0.f};
    }
    bf16x8 At[4][2], B0[2][2], B1[2][2];
    const char* cA = (const char*)g.A + (size_t)cur.pm * tstep; const char* cB = (const char*)g.Bt + (size_t)cur.pn * tstep;
    S.a_ready(cur);
    if constexpr (SP2) {
        PG8_STAGE(PG8_SB(0, 0), cB, voffB); PG8_STAGE(PG8_SB(0, 1), cB + hstep, voffB); PG8_STAGE(PG8_SA(0, 0), cA, voffA); PG8_STAGE(PG8_SA(0, 1), cA + hstep, voffA);
        if (wr == 1) PG8_BAR;
        PG8_WAIT_V(2); PG8_BAR;
        PG8_STAGE(PG8_SB(1, 0), cB + kstep, voffB); PG8_STAGE(PG8_SA(1, 0), cA + kstep, voffA); PG8_STAGE(PG8_SB(1, 1), cB + hstep + kstep, voffB);
        PG8_WAIT_V(6); PG8_BAR;
    } else {
        PG8_STAGE(PG8_SB(0, 0), cB, voffB); PG8_STAGE(PG8_SA(0, 0), cA, voffA); PG8_STAGE(PG8_SB(0, 1), cB + hstep, voffB); PG8_STAGE(PG8_SA(0, 1), cA + hstep, voffA);
        if (wr == 1) PG8_BAR;
        PG8_WAIT_V(4); PG8_BAR;
        PG8_STAGE(PG8_SB(1, 0), cB + kstep, voffB); PG8_STAGE(PG8_SA(1, 0), cA + kstep, voffA); PG8_STAGE(PG8_SB(1, 1), cB + hstep + kstep, voffB);
        PG8_WAIT_V(6); PG8_BAR;
    }
    for (;;) {
        const bool has_next = S.next(ui + 1, nxt);
        const char* nA = has_next ? (const char*)g.A + (size_t)nxt.pm * tstep : cA; const char* nB = has_next ? (const char*)g.Bt + (size_t)nxt.pn * tstep : cB;
        for (int t = 0; t < nt; t += 2) {
            const bool last = (t == nt - 2);
            const char* a1 = cA + (size_t)(t + 1) * kstep;
            const char* a2 = last ? nA : cA + (size_t)(t + 2) * kstep; const char* b2 = last ? nB : cB + (size_t)(t + 2) * kstep;
            const char* a3 = a2 + kstep; const char* b3 = b2 + kstep;
            if (last && has_next) S.a_ready(nxt);
            if constexpr (Epi::MID) { if (t == nt / 2) E.mid(acc, cur, wr, wc, fr, fq); }
            if constexpr (SP2) {
            PG8_LDB(B0, 0, 0); PG8_LDB(B1, 0, 1); PG8_SCHED; PG8_LDA(At, 0, 0); PG8_STAGE(PG8_SA(1, 1), a1 + hstep, voffA);
            PG8_WAIT_V(8); PG8_WAIT_L(0); PG8_BAR; PG8_MMA(0, 0, At, B0); PG8_MMA(0, 1, At, B1); PG8_BAR; PG8_SCHED;
            PG8_LDA(At, 0, 1); PG8_STAGE(PG8_SB(0, 0), b2, voffB); PG8_STAGE(PG8_SB(0, 1), b2 + hstep, voffB); PG8_STAGE(PG8_SA(0, 0), a2, voffA);
            PG8_WAIT_V(8); PG8_WAIT_L(0); PG8_BAR; PG8_MMA(1, 0, At, B0); PG8_MMA(1, 1, At, B1); PG8_BAR; PG8_SCHED;
            PG8_LDB(B0, 1, 0); PG8_LDB(B1, 1, 1); PG8_SCHED; PG8_LDA(At, 1, 0); PG8_STAGE(PG8_SA(0, 1), a2 + hstep, voffA);
            PG8_WAIT_V(8); PG8_WAIT_L(0); PG8_BAR; PG8_MMA(0, 0, At, B0); PG8_MMA(0, 1, At, B1); PG8_BAR; PG8_SCHED;
            PG8_LDA(At, 1, 1); PG8_STAGE(PG8_SB(1, 0), b3, voffB); PG8_STAGE(PG8_SB(1, 1), b3 + hstep, voffB); PG8_STAGE(PG8_SA(1, 0), a3, voffA);
            PG8_WAIT_V(8); PG8_WAIT_L(0); PG8_BAR; PG8_MMA(1, 0, At, B0); PG8_MMA(1, 1, At, B1); PG8_BAR; PG8_SCHED;
            } else {
            PG8_LDB(B0, 0, 0); PG8_SCHED; PG8_LDA(At, 0, 0); PG8_STAGE(PG8_SA(1, 1), a1 + hstep, voffA);
            PG8_WAIT_L(8); PG8_BAR; PG8_WAIT_L(0); PG8_MMA(0, 0, At, B0); PG8_BAR; PG8_SCHED;
            PG8_LDB(B1, 0, 1); PG8_STAGE(PG8_SB(0, 0), b2, voffB);
            PG8_BAR; PG8_WAIT_L(0); PG8_MMA(0, 1, At, B1); PG8_BAR;
            PG8_LDA(At, 0, 1); PG8_STAGE(PG8_SA(0, 0), a2, voffA);
            PG8_BAR; PG8_WAIT_L(0); PG8_MMA(1, 0, At, B0); PG8_BAR; PG8_SCHED;
            PG8_STAGE(PG8_SB(0, 1), b2 + hstep, voffB);
            PG8_WAIT_V(6); PG8_BAR; PG8_MMA(1, 1, At, B1); PG8_BAR;
            PG8_LDB(B0, 1, 0); PG8_SCHED; PG8_LDA(At, 1, 0); PG8_STAGE(PG8_SA(0, 1), a2 + hstep, voffA);
            PG8_WAIT_L(8); PG8_BAR; PG8_WAIT_L(0); PG8_MMA(0, 0, At, B0); PG8_BAR; PG8_SCHED;
            PG8_LDB(B1, 1, 1); PG8_STAGE(PG8_SB(1, 0), b3, voffB);
            PG8_BAR; PG8_WAIT_L(0); PG8_MMA(0, 1, At, B1); PG8_BAR;
            PG8_LDA(At, 1, 1); PG8_STAGE(PG8_SA(1, 0), a3, voffA);
            PG8_BAR; PG8_WAIT_L(0); PG8_MMA(1, 0, At, B0); PG8_BAR; PG8_SCHED;
            PG8_STAGE(PG8_SB(1, 1), b3 + hstep, voffB);
            PG8_WAIT_V(6); PG8_BAR; PG8_MMA(1, 1, At, B1); PG8_BAR;
            }
        }
        if constexpr (ALIGN_EPI) { if (wr == 0) PG8_BAR; }
        if constexpr (!Epi::AFTER_DRAIN) { E(acc, cur, wr, wc, fr, fq); S.done(cur); }
        if (!has_next) break;
        if constexpr (Epi::INIT) E.init(acc, nxt, wr, wc, fr, fq);
        else {
#pragma unroll
        for (int a = 0; a < 2; ++a)
#pragma unroll
            for (int b = 0; b < 2; ++b)
#pragma unroll
                for (int m = 0; m < 4; ++m)
#pragma unroll
                    for (int n = 0; n < 2; ++n) acc[a][b][m][n] = (f32x4){0.f, 0.f, 0.f, 0.f};
        }
        cur = nxt; cA = nA; cB = nB; ++ui;
        if constexpr (ALIGN_EPI) { if (wr == 1) PG8_BAR; }
    }
    PG8_WAIT_V(0);
    if constexpr (!ALIGN_EPI) { if (wr == 0) PG8_BAR; }
    PG8_BAR;
    if constexpr (Epi::AFTER_DRAIN) { E.fused(acc, cur, wr, wc, fr, fq, lds, wid, lane); S.done(cur); }
#undef PG8_SA
#undef PG8_SB
#undef PG8_STAGE
#undef PG8_LDA
#undef PG8_LDB
#undef PG8_MMA
#undef PG8_WAIT_V
#undef PG8_WAIT_L
#undef PG8_BAR
#undef PG8_SCHED
}
}
#define GAS __attribute__((address_space(1)))
#define LAS __attribute__((address_space(3)))
typedef unsigned short bf16;
typedef unsigned v4u __attribute__((ext_vector_type(4)));
typedef float f32x4 __attribute__((ext_vector_type(4)));
typedef short bf16x8 __attribute__((ext_vector_type(8)));
typedef GAS unsigned gu32;
typedef GAS unsigned long long gu64;
#define RLX_AGENT __ATOMIC_RELAXED, __HIP_MEMORY_SCOPE_AGENT
#define LDS_WAIT() asm volatile("s_waitcnt lgkmcnt(0)" ::: "memory")
#define VM_WAIT() asm volatile("s_waitcnt vmcnt(0)" ::: "memory")
__device__ __forceinline__ unsigned long long rt() { return __builtin_amdgcn_s_memrealtime(); }
__device__ __forceinline__ unsigned f2bf(float f) { unsigned u = __builtin_bit_cast(unsigned, f); return (u + 0x7fffu + ((u >> 16) & 1u)) >> 16; }
__device__ __forceinline__ unsigned pk2(float lo, float hi) { return f2bf(lo) | (f2bf(hi) << 16); }

#define XB_TMO      128
#define XB_XCNT(j)  (256  + 64 * (j))
#define XB_XSUB(j)  (1280 + 64 * (j))
#define XB_XGEN(j)  (2304 + 64 * (j))
#define XB_TOP      3328
#define XB_TOPGEN   3392
#define XCD_BAR_WORDS 3456
#define XB_SPIN_CAP (1u << 18)

__device__ __forceinline__ unsigned xb_ld(unsigned* p)              { return __hip_atomic_load(p, __ATOMIC_RELAXED, __HIP_MEMORY_SCOPE_AGENT); }
__device__ __forceinline__ unsigned xb_add(unsigned* p, unsigned v) { return __hip_atomic_fetch_add(p, v, __ATOMIC_RELAXED, __HIP_MEMORY_SCOPE_AGENT); }
__device__ __forceinline__ unsigned xb_xcc_id() { return (unsigned)__builtin_amdgcn_s_getreg((3 << 11) | 20) & 0xFu; }
#define XB_SPIN(cond, bar) do { unsigned _sp = 0; while (cond) { __builtin_amdgcn_s_sleep(1); \
    if ((++_sp & 255u) == 0u) { if (xb_ld(&(bar)[XB_TMO])) break; if (_sp > XB_SPIN_CAP) { atomicAdd(&(bar)[XB_TMO], 1u); break; } } } } while (0)

struct XcdBarrier {
    unsigned* bar; unsigned x;
    volatile LAS unsigned* st;
};

__device__ __forceinline__ XcdBarrier xcd_barrier_post(unsigned* bar, volatile LAS unsigned* st, const bool t0) {
    XcdBarrier b; b.bar = bar; b.x = xb_xcc_id(); b.st = st;
    if (t0) (void)xb_add(&bar[XB_XCNT(b.x)], 1u);
    return b;
}
__device__ __forceinline__ void xcd_barrier_complete(unsigned* bar, unsigned x, unsigned& nloc, unsigned& nx) {
    const unsigned G = gridDim.x * gridDim.y * gridDim.z;
    unsigned sum, cnt, mine, sp = 0u;
    for (;;) {
        sum = 0u; cnt = 0u; mine = 0u;
#pragma unroll
        for (unsigned j = 0; j < 16; ++j) { const unsigned c = xb_ld(&bar[XB_XCNT(j)]); sum += c; cnt += (c > 0u) ? 1u : 0u; mine = (j == x) ? c : mine; }
        if (sum == G) break;
        __builtin_amdgcn_s_sleep(1);
        if ((++sp & 255u) == 0u) { if (xb_ld(&bar[XB_TMO])) break; if (sp > XB_SPIN_CAP) { atomicAdd(&bar[XB_TMO], 1u); break; } }
    }
    nloc = mine > 0u ? mine : 1u; nx = cnt > 0u ? cnt : 1u;
}

__device__ __forceinline__ void xcd_barrier_a() {
    asm volatile("s_waitcnt vmcnt(0)" ::: "memory");
    __syncthreads();
}
__device__ __forceinline__ void xcd_barrier_b(const XcdBarrier& b, const bool t0) {
    if (t0) {
        unsigned* bar = b.bar;
        __builtin_amdgcn_s_waitcnt(0);
        unsigned nloc = b.st[0], nx = b.st[1];
        if (nloc == 0u) { xcd_barrier_complete(bar, b.x, nloc, nx); b.st[0] = nloc; b.st[1] = nx; }
        const unsigned old = xb_add(&bar[XB_XSUB(b.x)], 1u);
        const unsigned gen = old / nloc;
        if (old + 1u == (gen + 1u) * nloc) {
            __builtin_amdgcn_fence(__ATOMIC_RELEASE, "agent");
            asm volatile("s_waitcnt vmcnt(0)" ::: "memory");
            const unsigned og = xb_add(&bar[XB_TOP], 1u);
            const unsigned tg = og / nx;
            if (og + 1u == (tg + 1u) * nx) xb_add(&bar[XB_TOPGEN], 1u);
            else XB_SPIN(xb_ld(&bar[XB_TOPGEN]) == tg, bar);
            __builtin_amdgcn_fence(__ATOMIC_ACQUIRE, "agent");
            xb_add(&bar[XB_XGEN(b.x)], 1u);
            asm volatile("s_waitcnt vmcnt(0)" ::: "memory");
        } else {
            XB_SPIN(xb_ld(&bar[XB_XGEN(b.x)]) == gen, bar);
            __builtin_amdgcn_fence(__ATOMIC_ACQUIRE, "agent");
            asm volatile("s_waitcnt vmcnt(0)" ::: "memory");
        }
    }
    __syncthreads();
}
__device__ __forceinline__ void xcd_barrier(const XcdBarrier& b, const bool t0) { xcd_barrier_a(); xcd_barrier_b(b, t0); }
namespace attn_body {
using bf16=__hip_bfloat16;
using bf16x8=__attribute__((ext_vector_type(8)))short;
using s16x4=__attribute__((ext_vector_type(4)))short;
using f32x16=__attribute__((ext_vector_type(16)))float;
using u32x4=__attribute__((ext_vector_type(4)))unsigned;
constexpr int BATCH=8,NHEAD=16,SEQ=2048,D=64,DM=3072,OPITCH=2048,ZPITCH=1024;
constexpr int NW=8,QBLK=32,QB=QBLK*NW,KVBLK=64,NQB=SEQ/QB;
constexpr int ATTN_PITCH=DM, ATTN_UNIT_ROWS=QB;
__device__ __forceinline__ int crow(int r,int hi){return (r&3)+8*(r>>2)+4*hi;}
#define SBAR() __builtin_amdgcn_sched_barrier(0)
__device__ __forceinline__ void cmask(f32x16&p0,f32x16&p1,int jb,int qrel,int hi){
  const float NEG=-INFINITY; int kb=64*jb+4*hi;
  #pragma unroll
  for(int r=0;r<16;++r){int kv=kb+(r&3)+8*(r>>2); if(kv>qrel)p0[r]=NEG; if(kv+32>qrel)p1[r]=NEG;}
}

constexpr int NSLOT=3, SLOTB=8192;
constexpr int LDS_K=0, LDS_V=NSLOT*SLOTB, LDS_WS=2*NSLOT*SLOTB, LDS_OST=LDS_WS+NW*64*4, LDS_BYTES=LDS_OST+NW*4096;
constexpr float C2=0.125f*1.4426950408889634f;
__device__ __forceinline__ float bflo(unsigned w){return __uint_as_float(w<<16);}
__device__ __forceinline__ float bfhi(unsigned w){return __uint_as_float(w&0xffff0000u);}
__device__ __forceinline__ float bfs(short v){return __uint_as_float(((unsigned)(unsigned short)v)<<16);}
__device__ __forceinline__ void glds16(const void*gsrc,unsigned lds_dst){unsigned keep;
  asm volatile("s_mov_b32 %0, m0\n\ts_mov_b32 m0, %2\n\ts_nop 0\n\tglobal_load_lds_dwordx4 %1, off\n\ts_mov_b32 m0, %0":"=&s"(keep):"v"(gsrc),"s"(lds_dst):"memory");}
__device__ __forceinline__ float max3f(float a,float b,float c){float r;asm("v_max3_f32 %0, %1, %2, %3":"=v"(r):"v"(a),"v"(b),"v"(c));return r;}
__device__ __forceinline__ float max2f(float a,float b){float r;asm("v_max_f32_e32 %0, %1, %2":"=v"(r):"v"(a),"v"(b));return r;}
__device__ __forceinline__ float fadd_s(float a,float b){float r;asm("v_add_f32_e32 %0, %1, %2":"=v"(r):"v"(a),"v"(b));return r;}
__device__ __forceinline__ float fsub_s(float a,float b){float r;asm("v_sub_f32_e32 %0, %1, %2":"=v"(r):"v"(a),"v"(b));return r;}
typedef float f32x2_t __attribute__((ext_vector_type(2))); typedef __bf16 bf16x2_t __attribute__((ext_vector_type(2)));
__device__ __forceinline__ unsigned cvtpk_s(float lo,float hi){f32x2_t v={lo,hi};bf16x2_t b=__builtin_convertvector(v,bf16x2_t);return __builtin_bit_cast(unsigned,b);}
#define WAIT_BAR(N) asm volatile("s_waitcnt vmcnt(" #N ") lgkmcnt(0)\n\ts_barrier":::"memory")

__device__ __forceinline__ void qkt(f32x16&p0,f32x16&p1,const char*Kslot,const bf16x8*qr,const f32x16&negm,int r32,int hi){
  const char*kb=Kslot+hi*1024+r32*16;
  #pragma unroll
  for(int d0=0;d0<4;++d0){
    const bf16x8 b0=*reinterpret_cast<const bf16x8*>(kb+d0*2048);
    const bf16x8 b1=*reinterpret_cast<const bf16x8*>(kb+d0*2048+512);
    if(d0==0){p0=__builtin_amdgcn_mfma_f32_32x32x16_bf16(b0,qr[0],negm,0,0,0);p1=__builtin_amdgcn_mfma_f32_32x32x16_bf16(b1,qr[0],negm,0,0,0);}
    else{p0=__builtin_amdgcn_mfma_f32_32x32x16_bf16(b0,qr[d0],p0,0,0,0);p1=__builtin_amdgcn_mfma_f32_32x32x16_bf16(b1,qr[d0],p1,0,0,0);}}
}
typedef __attribute__((address_space(3))) const char* lds_cptr;
typedef short v4i16_t __attribute__((ext_vector_type(4)));
__device__ __forceinline__ void kload8(bf16x8*kf,lds_cptr kp){
  kf[0]=*(const __attribute__((address_space(3))) bf16x8*)(kp);      kf[1]=*(const __attribute__((address_space(3))) bf16x8*)(kp+512);
  kf[2]=*(const __attribute__((address_space(3))) bf16x8*)(kp+2048); kf[3]=*(const __attribute__((address_space(3))) bf16x8*)(kp+2560);
  kf[4]=*(const __attribute__((address_space(3))) bf16x8*)(kp+4096); kf[5]=*(const __attribute__((address_space(3))) bf16x8*)(kp+4608);
  kf[6]=*(const __attribute__((address_space(3))) bf16x8*)(kp+6144); kf[7]=*(const __attribute__((address_space(3))) bf16x8*)(kp+6656);
}
__device__ __forceinline__ void kload2(bf16x8*kf,lds_cptr kp,int j){ kf[2*j]=*(const __attribute__((address_space(3))) bf16x8*)(kp+j*2048); kf[2*j+1]=*(const __attribute__((address_space(3))) bf16x8*)(kp+j*2048+512); }
__device__ __forceinline__ s16x4 vtr(lds_cptr p){ return __builtin_bit_cast(s16x4,__builtin_amdgcn_ds_read_tr16_b64_v4i16((__attribute__((address_space(3))) v4i16_t*)p)); }
__device__ __forceinline__ float rowmax(const f32x16&p0,const f32x16&p1){
  float a=max3f(p0[0],p0[1],p1[0]),b=max3f(p0[2],p0[3],p1[1]);a=max3f(a,p1[2],p1[3]);
  #pragma unroll
  for(int r=4;r<16;r+=4){a=max3f(a,p0[r],p0[r+1]);b=max3f(b,p0[r+2],p0[r+3]);a=max3f(a,p1[r],p1[r+1]);b=max3f(b,p1[r+2],p1[r+3]);}
  const float m=max2f(a,b);
  auto rr=__builtin_amdgcn_permlane32_swap(__float_as_uint(m),__float_as_uint(m),false,false);
  return max2f(__uint_as_float(rr[0]),__uint_as_float(rr[1]));
}
__device__ __forceinline__ void pv(f32x16*o,int vb,bf16x8 pa0,bf16x8 pa1,bf16x8 pa2,bf16x8 pa3){
  #pragma unroll
  for(int d0=0;d0<2;++d0){s16x4 lo[4],hi[4];
    #pragma unroll
    for(int ks=0;ks<4;++ks){
      asm volatile("ds_read_b64_tr_b16 %0,%1 offset:%c2":"=&v"(lo[ks]):"v"(vb),"i"(d0*4096+ks*1024):"memory");
      asm volatile("ds_read_b64_tr_b16 %0,%1 offset:%c2":"=&v"(hi[ks]):"v"(vb),"i"(d0*4096+ks*1024+512):"memory");}
    asm volatile("s_waitcnt lgkmcnt(0)":::"memory");SBAR();
    #define PK(k) (bf16x8){lo[k][0],lo[k][1],lo[k][2],lo[k][3],hi[k][0],hi[k][1],hi[k][2],hi[k][3]}
    o[d0]=__builtin_amdgcn_mfma_f32_32x32x16_bf16(pa0,PK(0),o[d0],0,0,0);
    o[d0]=__builtin_amdgcn_mfma_f32_32x32x16_bf16(pa1,PK(1),o[d0],0,0,0);
    o[d0]=__builtin_amdgcn_mfma_f32_32x32x16_bf16(pa2,PK(2),o[d0],0,0,0);
    o[d0]=__builtin_amdgcn_mfma_f32_32x32x16_bf16(pa3,PK(3),o[d0],0,0,0);
    #undef PK
  }
}

#ifndef ATTN_STORE16
#define ATTN_STORE16(p,v) (*(u32x4*)(p)=(v))
#endif
template<int THRL> __device__ __forceinline__ void attn_unit(int b,int h,int qb,const bf16*Q,const bf16*__restrict__ K,const bf16*__restrict__ V,bf16*O,const bf16*__restrict__ ZB,const float*__restrict__ KMEAN,char*shm,const int wave_id){
  const int wid=__builtin_amdgcn_readfirstlane(wave_id); const int lane=mk_lane_id(),tid=wid*64+lane,r32=lane&31,hi=lane>>5; (void)tid;
  const long rowbase=(long)b*SEQ; const int q0=qb*QB;
  const bf16*Qw=Q+(rowbase+q0+wid*QBLK)*DM+h*D;
  const bf16*Kh=K+rowbase*DM+h*D,*Vh=V+rowbase*DM+h*D;
  const unsigned lds0=(unsigned)(uintptr_t)shm;
  float*wsf=(float*)(shm+LDS_WS)+wid*64;
  const bf16*ksrc=Kh+(long)lane*DM+wid*8;
  const bf16*vsrc=Vh+(long)(16*(wid&3)+(lane>>2))*DM+(wid>>2)*32+(lane&3)*8;
  const unsigned kdst=lds0+LDS_K+wid*1024, vdst=lds0+LDS_V+wid*1024;
  #define TROW(t) (((t)<4)?(q0+64*(t)):(64*((t)-4)))
  #define DMA_K(t,slot) glds16(ksrc+(long)TROW(t)*DM,(unsigned)__builtin_amdgcn_readfirstlane(kdst+(slot)))
  #define DMA_V(t,slot) glds16(vsrc+(long)TROW(t)*DM,(unsigned)__builtin_amdgcn_readfirstlane(vdst+(slot)))
  const int vb0=(int)(lds0+LDS_V)+((lane>>4)&1)*32+(lane&3)*8+(4*hi+((lane&15)>>2))*64;
  const char*Kbase=shm+LDS_K; bf16x8 kf[8];
  const lds_cptr shm3=(lds_cptr)shm; const lds_cptr kp0=shm3+LDS_K+hi*1024+r32*16; const lds_cptr vp0=shm3+LDS_V+((lane>>4)&1)*32+(lane&3)*8+(4*hi+((lane&15)>>2))*64;
  const int NT=(q0+QB)/KVBLK;
  DMA_K(0,0);DMA_V(0,0);DMA_K(1,SLOTB);
  bf16x8 qr[4];
  #pragma unroll
  for(int d0=0;d0<4;++d0)qr[d0]=*reinterpret_cast<const bf16x8*>(&Qw[(long)r32*DM+d0*16+hi*8]);
  float mhat=0.f,l_reg=0.f;f32x16 o[2];o[0]=f32x16{};o[1]=f32x16{};f32x16 negm=f32x16{};asm volatile("":"+v"(negm));
  const int qrel=wid*QBLK+r32;
  unsigned selm=(1u<<qb)-1u;
  if(qb>3){ float g[7];
    #pragma unroll
    for(int n=0;n<7;++n){ g[n]=-INFINITY; if(n<qb){ const float*km=KMEAN+(((long)b*NHEAD+h)*8+n)*64+hi*8; float acc_=0.f;
        #pragma unroll
        for(int d0=0;d0<4;++d0){ const float4 k0=*reinterpret_cast<const float4*>(km+d0*16), k1=*reinterpret_cast<const float4*>(km+d0*16+4); const bf16x8 qv_=qr[d0];
          acc_+=bfs(qv_[0])*k0.x+bfs(qv_[1])*k0.y+bfs(qv_[2])*k0.z+bfs(qv_[3])*k0.w+bfs(qv_[4])*k1.x+bfs(qv_[5])*k1.y+bfs(qv_[6])*k1.z+bfs(qv_[7])*k1.w; }
        auto rr=__builtin_amdgcn_permlane32_swap(__float_as_uint(acc_),__float_as_uint(acc_),false,false); g[n]=__uint_as_float(rr[0])+__uint_as_float(rr[1]); } }
    selm=0u;
    #pragma unroll
    for(int n=0;n<7;++n){ int rank=0;
      #pragma unroll
      for(int m_=0;m_<7;++m_) if(m_!=n) rank+=(g[m_]>g[n]||(g[m_]==g[n]&&m_<n))?1:0;
      if(n<qb&&rank<3) selm|=1u<<n; } }
  #define CMASK(P0,P1,t) do{int jb_=(t); if(jb_<4)cmask(P0,P1,jb_,qrel,hi);}while(0)
  bool resc=false;
  #define START(P0,P1) do{ const float rm=rowmax(P0,P1); resc=false; \
    { const float dl=rm; mhat=fadd_s(mhat,dl); \
      _Pragma("unroll") for(int r=0;r<16;++r){P0[r]=fsub_s(P0[r],dl);P1[r]=fsub_s(P1[r],dl);} \
      _Pragma("unroll") for(int r=0;r<16;++r)negm[r]=-mhat; asm volatile("":"+v"(negm)); } \
    _Pragma("unroll") for(int r=0;r<16;++r)P0[r]=__builtin_amdgcn_exp2f(P0[r]); }while(0)
  #define RESC() do{ if(resc){ asm volatile("s_waitcnt lgkmcnt(0)":::"memory"); \
      _Pragma("unroll") for(int d_=0;d_<2;++d_) _Pragma("unroll") for(int r=0;r<16;++r)o[d_][r]*=wsf[crow(r,hi)]; } }while(0)
  f32x16 pA0,pA1,pB0,pB1;
  int sl_prev=0,sl_cur=0,sl_next=SLOTB;
  #define ROT() do{sl_prev=sl_cur;sl_cur=sl_next;sl_next=(sl_next==(NSLOT-1)*SLOTB)?0:sl_next+SLOTB;}while(0)
  DMA_K(2,2*SLOTB);
  WAIT_BAR(3);
  qkt(pA0,pA1,Kbase,qr,negm,r32,hi);asm volatile("s_nop 15\n\ts_nop 7":"+v"(pA0),"+v"(pA1));CMASK(pA0,pA1,0);
  START(pA0,pA1);
  _Pragma("unroll") for(int r=0;r<16;++r)pA1[r]=__builtin_amdgcn_exp2f(pA1[r]);
  WAIT_BAR(0);
  DMA_K(3,0);DMA_V(1,SLOTB);
  ROT();
  kload8(kf,kp0+sl_cur);
  WAIT_BAR(2);
  s16x4 vlo[8],vhi[8]; u32x4 pw0,pw1,pw2,pw3;
  #define PKW(P,B) cvtpk_s(P[B],P[B+1])
  #define PAF(k) __builtin_bit_cast(bf16x8,pw##k)
  #define VFR(i) (bf16x8){vlo[i][0],vlo[i][1],vlo[i][2],vlo[i][3],vhi[i][0],vhi[i][1],vhi[i][2],vhi[i][3]}
  #define PIN(x) asm volatile("":"+v"(x))
  #define MX3(a,b,c) __builtin_fmaxf(__builtin_fmaxf((a),(b)),(c))
  #define GAPA(MF,A0,A1,A2,A3,W0,W1,PW) do{ MF; sacc+=A0; sacc+=A1; sacc+=A2; sacc+=A3; PIN(sacc); W0; W1; PIN(PW); SBAR(); }while(0)
  #define EX(v) __builtin_amdgcn_exp2f(v)
  #define GAPB(MF,X,B) do{ MF; X[B]=EX(X[B]); X[B+1]=EX(X[B+1]); X[B+2]=EX(X[B+2]); X[B+3]=EX(X[B+3]); PIN(X); SBAR(); }while(0)
  #define VRD(i) do{ vlo[i]=vtr(vp_+(((i)>>2)*4096+((i)&3)*1024)); vhi[i]=vtr(vp_+(((i)>>2)*4096+((i)&3)*1024+512)); }while(0)
  #define KRD(G,j) do{ if(G){ kload2(kf,kp0+sl_next,j); SBAR(); } }while(0)
  #define STEP(C0,C1,P0,P1,t,GK,GV,GL) do{ SBAR(); \
    { const float ci_=(((t)<4)||((selm>>(((t)-4)>>2))&1u))?-mhat:-INFINITY; _Pragma("unroll") for(int r=0;r<16;++r)negm[r]=ci_; asm volatile("":"+v"(negm)); } SBAR(); \
    const lds_cptr vp_=vp0+sl_prev; \
    VRD(0); SBAR(); float sacc=(P0[0]+P0[1]); \
    GAPA(C0=__builtin_amdgcn_mfma_f32_32x32x16_bf16(kf[0],qr[0],negm,0,0,0), P0[2],P0[3],P0[4],P0[5],     pw0[0]=PKW(P0,0), pw0[1]=PKW(P0,2), pw0); \
    VRD(4); SBAR(); GAPA(C1=__builtin_amdgcn_mfma_f32_32x32x16_bf16(kf[1],qr[0],negm,0,0,0), P0[6],P0[7],P0[8],P0[9],     pw0[2]=PKW(P0,4), pw0[3]=PKW(P0,6), pw0); \
    VRD(1); SBAR(); GAPA(C0=__builtin_amdgcn_mfma_f32_32x32x16_bf16(kf[2],qr[1],C0,0,0,0),   P0[10],P0[11],P0[12],P0[13], pw1[0]=PKW(P0,8), pw1[1]=PKW(P0,10), pw1); \
    VRD(5); SBAR(); GAPA(C1=__builtin_amdgcn_mfma_f32_32x32x16_bf16(kf[3],qr[1],C1,0,0,0),   P0[14],P0[15],P1[0],P1[1],   pw1[2]=PKW(P0,12),pw1[3]=PKW(P0,14), pw1); \
    VRD(2); SBAR(); GAPA(C0=__builtin_amdgcn_mfma_f32_32x32x16_bf16(kf[4],qr[2],C0,0,0,0),   P1[2],P1[3],P1[4],P1[5],     pw2[0]=PKW(P1,0), pw2[1]=PKW(P1,2), pw2); \
    VRD(6); SBAR(); GAPA(C1=__builtin_amdgcn_mfma_f32_32x32x16_bf16(kf[5],qr[2],C1,0,0,0),   P1[6],P1[7],P1[8],P1[9],     pw2[2]=PKW(P1,4), pw2[3]=PKW(P1,6), pw2); \
    VRD(3); SBAR(); GAPA(C0=__builtin_amdgcn_mfma_f32_32x32x16_bf16(kf[6],qr[3],C0,0,0,0),   P1[10],P1[11],P1[12],P1[13], pw3[0]=PKW(P1,8), pw3[1]=PKW(P1,10), pw3); \
    VRD(7); SBAR(); GAPA(C1=__builtin_amdgcn_mfma_f32_32x32x16_bf16(kf[7],qr[3],C1,0,0,0),   P1[14],P1[15],0.f,0.f,       pw3[2]=PKW(P1,12),pw3[3]=PKW(P1,14), pw3); \
    l_reg+=sacc; \
    if(GK){DMA_K((t)+3,sl_cur);} if(GV){DMA_V((t)+1,sl_next);} \
    CMASK(C0,C1,t); \
    { float a=MX3(C0[0],C0[1],C1[0]),b=MX3(C0[2],C0[3],C1[1]); a=MX3(a,C1[2],C1[3]); \
      _Pragma("unroll") for(int r=4;r<16;r+=4){a=MX3(a,C0[r],C0[r+1]);b=MX3(b,C0[r+2],C0[r+3]);a=MX3(a,C1[r],C1[r+1]);b=MX3(b,C1[r+2],C1[r+3]);} \
      float rm=__builtin_fmaxf(a,b); { auto rr=__builtin_amdgcn_permlane32_swap(__float_as_uint(rm),__float_as_uint(rm),false,false); rm=__builtin_fmaxf(__uint_as_float(rr[0]),__uint_as_float(rr[1])); } \
      resc=false; \
      if(__builtin_expect(__any(rm>(float)THRL),0)){ const float dl=__builtin_fmaxf(rm,0.f); mhat+=dl; \
        _Pragma("unroll") for(int r=0;r<16;++r){C0[r]-=dl;C1[r]-=dl;} \
        _Pragma("unroll") for(int r=0;r<16;++r)negm[r]=-mhat; asm volatile("":"+v"(negm)); \
        const float f=__builtin_amdgcn_exp2f(-dl); l_reg*=f; if(hi==0)wsf[r32]=f; resc=true; } } \
    SBAR(); \
    GAPB(o[0]=__builtin_amdgcn_mfma_f32_32x32x16_bf16(PAF(0),VFR(0),o[0],0,0,0), C0,0); \
    GAPB(o[1]=__builtin_amdgcn_mfma_f32_32x32x16_bf16(PAF(0),VFR(4),o[1],0,0,0), C0,4); \
    KRD(GL,0); GAPB(o[0]=__builtin_amdgcn_mfma_f32_32x32x16_bf16(PAF(1),VFR(1),o[0],0,0,0), C0,8); \
    KRD(GL,1); GAPB(o[1]=__builtin_amdgcn_mfma_f32_32x32x16_bf16(PAF(1),VFR(5),o[1],0,0,0), C0,12); \
    KRD(GL,2); GAPB(o[0]=__builtin_amdgcn_mfma_f32_32x32x16_bf16(PAF(2),VFR(2),o[0],0,0,0), C1,0); \
    KRD(GL,3); GAPB(o[1]=__builtin_amdgcn_mfma_f32_32x32x16_bf16(PAF(2),VFR(6),o[1],0,0,0), C1,4); \
    GAPB(o[0]=__builtin_amdgcn_mfma_f32_32x32x16_bf16(PAF(3),VFR(3),o[0],0,0,0), C1,8); \
    GAPB(o[1]=__builtin_amdgcn_mfma_f32_32x32x16_bf16(PAF(3),VFR(7),o[1],0,0,0), C1,12); \
    }while(0)
  int t=1;
  #define ENDW(tt) do{ if((tt)+3<NT){WAIT_BAR(2);} else if((tt)+2<NT){WAIT_BAR(1);} else {WAIT_BAR(0);} }while(0)
  for(;t+1<NT;t+=2){
    STEP(pB0,pB1,pA0,pA1,t,(t+3<NT),(t+1<NT),(t+1<NT));       ENDW(t);   RESC(); ROT();
    STEP(pA0,pA1,pB0,pB1,t+1,(t+4<NT),(t+2<NT),(t+2<NT));     ENDW(t+1); RESC(); ROT();
  }
  STEP(pB0,pB1,pA0,pA1,NT-1,false,false,false); RESC();
  { float sacc=pB0[0]+pB0[1]; _Pragma("unroll") for(int r=2;r<16;++r)sacc+=pB0[r]; _Pragma("unroll") for(int r=0;r<16;++r)sacc+=pB1[r]; l_reg+=sacc;
    pw0=(u32x4){PKW(pB0,0),PKW(pB0,2),PKW(pB0,4),PKW(pB0,6)};pw1=(u32x4){PKW(pB0,8),PKW(pB0,10),PKW(pB0,12),PKW(pB0,14)};pw2=(u32x4){PKW(pB1,0),PKW(pB1,2),PKW(pB1,4),PKW(pB1,6)};pw3=(u32x4){PKW(pB1,8),PKW(pB1,10),PKW(pB1,12),PKW(pB1,14)};
    SBAR(); pv(o,vb0+sl_cur,PAF(0),PAF(1),PAF(2),PAF(3)); }
  #undef PKW
  #undef PAF
  #undef VFR
  #undef PIN
  #undef MX3
  #undef GAPA
  #undef GAPB
  #undef EX
  #undef VRD
  #undef KRD
  #undef STEP
  #undef ENDW
  {auto rr=__builtin_amdgcn_permlane32_swap(__float_as_uint(l_reg),__float_as_uint(l_reg),false,false);l_reg=__uint_as_float(rr[0])+__uint_as_float(rr[1]);}
  if(hi==0)wsf[32+r32]=l_reg;asm volatile("s_waitcnt lgkmcnt(0)":::"memory");
  float rli[16];
  #pragma unroll
  for(int r=0;r<16;++r)rli[r]=__builtin_amdgcn_rcpf(wsf[32+crow(r,hi)]);
  bf16*Ow=O+(rowbase+q0+wid*QBLK)*OPITCH+h*D; const bf16*Zw=ZB+(rowbase+q0+wid*QBLK)*ZPITCH+h*D;
  { bf16*stg=(bf16*)(shm+LDS_OST)+wid*2048;
    #pragma unroll
    for(int r=0;r<16;++r){const int orow=crow(r,hi);
      #pragma unroll
      for(int d0=0;d0<2;++d0)stg[orow*64+d0*32+r32]=__float2bfloat16(o[d0][r]*rli[r]);}
    asm volatile("s_waitcnt lgkmcnt(0)":::"memory");
    #pragma unroll
    for(int i=0;i<4;++i){const int row=i*8+(lane>>3),ch=lane&7; const u32x4 v=*(const u32x4*)(stg+row*64+ch*8); const u32x4 z=*(const u32x4*)(Zw+(long)row*ZPITCH+ch*8); u32x4 w;
      w.x=cvtpk_s(bflo(v.x)*bflo(z.x),bfhi(v.x)*bfhi(z.x)); w.y=cvtpk_s(bflo(v.y)*bflo(z.y),bfhi(v.y)*bfhi(z.y)); w.z=cvtpk_s(bflo(v.z)*bflo(z.z),bfhi(v.z)*bfhi(z.z)); w.w=cvtpk_s(bflo(v.w)*bflo(z.w),bfhi(v.w)*bfhi(z.w));
      ATTN_STORE16(Ow+(long)row*OPITCH+ch*8,w);} }
  asm volatile("s_waitcnt lgkmcnt(0)\n\ts_barrier":::"memory");
  #undef DMA_K
  #undef DMA_V
  #undef CMASK
  #undef START
  #undef RESC
  #undef ROT
}
constexpr int ATTN_LDS_BYTES=LDS_BYTES;
struct AttnTensors { const bf16* Q; const bf16* K; const bf16* V; bf16* O; const bf16* ZB; const float* KMEAN; };
struct AttnUnit { int bh; int qb; };
struct StaticOrder {
  int vcu, G;
  __device__ __forceinline__ explicit StaticOrder(int grid,int block):vcu((grid%8==0)?(block%8)*(grid/8)+block/8:block),G(grid){}
  __device__ __forceinline__ StaticOrder(int ncu,int v,int):vcu(v),G(ncu){}
  __device__ __forceinline__ bool next(int i,AttnUnit&u)const{ const int pi=(i>>1)*G+vcu; if(pi>=BATCH*NHEAD*4)return false; u.bh=pi>>2; const int p=pi&3; u.qb=(i&1)?p:7-p; return true; }
  __device__ __forceinline__ void a_ready(const AttnUnit&)const{}
  __device__ __forceinline__ void done(const AttnUnit&)const{}
};
struct MobaOrder {
  int c,G; bool shift16; int give;
  __device__ __forceinline__ bool own(int ii,int cc,AttnUnit&u)const{ const int r=ii>>1,q=r*G+cc; if(q>=BATCH*NHEAD*4)return false; const int p=(G&3)?(q&3):(((q&3)+r)&3); u.bh=q>>2; u.qb=(ii&1)?p:7-p; return true; }
  __device__ __forceinline__ int slot_of(int cc,int qb)const{ const int p=qb<4?qb:7-qb; return 2*((p-(cc&3))&3)+(qb<4?1:0); }
  __device__ __forceinline__ bool next(int i,AttnUnit&u)const{
    if(!shift16&&give<=0) return own(i,c,u);
    const bool lite=shift16&&(c&31)<16; const int s2=lite?slot_of(c,2):-1;
    int k=i; for(int ii=0;ii<8;++ii){ AttnUnit t; own(ii,c,t); if(ii==s2||((give>>t.qb)&1))continue; if(k==0){u=t;return t.bh<BATCH*NHEAD;} --k; }
    if(shift16&&!lite&&k==0) return own(slot_of(c-16,2),c-16,u);
    return false; }
  __device__ __forceinline__ void a_ready(const AttnUnit&)const{}
  __device__ __forceinline__ void done(const AttnUnit&)const{}
};
template<class Sched,int THRL=8> __device__ __forceinline__ void attn_phase(char*lds,const AttnTensors&T,const Sched&S,const int wave_id){
  AttnUnit u;
  for(int i=0;S.next(i,u);++i){ S.a_ready(u); attn_unit<THRL>(u.bh/NHEAD,u.bh%NHEAD,u.qb,T.Q,T.K,T.V,T.O,T.ZB,T.KMEAN,lds,wave_id); S.done(u); }
}
#undef SBAR
#undef WAIT_BAR
}
constexpr int NWAVES = 8;
#ifndef MK_TS
#define MK_TS 0
#endif
#ifndef MK_ALIGN34
#define MK_ALIGN34 true
#endif
constexpr int CW_TS = 12288;
#ifndef MK_N_LAUNCHES
#define MK_N_LAUNCHES 0
#endif
constexpr int BATCH = 8, SEQ = 2048, DM = 2048, T = BATCH * SEQ, NH = 16, HD = 64, WID = 1024;
constexpr int NIN = 12544;
constexpr float RMS_EPS = 1e-6f, GN_EPS = 64e-5f, QSCALE = 0.125f * 1.4426950408889634f;
constexpr size_t MiB = 1u << 20;
constexpr size_t WS_CTL = 0, CTL_ZERO_BYTES = 64 * 1024;
constexpr size_t WS_KMEAN = 1 * MiB;
constexpr size_t WS_WINT = 2 * MiB;
constexpr size_t WS_WMT = 52 * MiB, WS_WOT = 60 * MiB;
constexpr size_t WS_XN = 68 * MiB;
constexpr size_t WS_MERGED = 68 * MiB;
constexpr size_t WS_RKV = 132 * MiB;
constexpr size_t WS_Y = 392 * MiB;
constexpr size_t WS_ZA = 228 * MiB, WS_QKVB = 260 * MiB, WS_ZB = 356 * MiB, WS_LORA = 388 * MiB;
constexpr size_t WS_END = 456 * MiB;
constexpr int CW_BAR = 4096, CW_SUB = 14336;
constexpr int RING_BYTES = 131072, LDSCTL_OFF = 143360, MISC_OFF = LDSCTL_OFF + 320, LDS_BYTES = 147456;

__device__ __forceinline__ float bf2f(bf16 v) { return __builtin_bit_cast(float, (unsigned)v << 16); }
__device__ __forceinline__ float blo(unsigned w) { return __builtin_bit_cast(float, w << 16); }
__device__ __forceinline__ float bhi(unsigned w) { return __builtin_bit_cast(float, w & 0xffff0000u); }
__device__ __forceinline__ void unpack8(const v4u w, float* f) { f[0] = blo(w.x); f[1] = bhi(w.x); f[2] = blo(w.y); f[3] = bhi(w.y); f[4] = blo(w.z); f[5] = bhi(w.z); f[6] = blo(w.w); f[7] = bhi(w.w); }
__device__ __forceinline__ v4u pack8(const float* f) { v4u w; w.x = pk2(f[0], f[1]); w.y = pk2(f[2], f[3]); w.z = pk2(f[4], f[5]); w.w = pk2(f[6], f[7]); return w; }
__device__ __forceinline__ float wave_sum(float v) {
#pragma unroll
    for (int o = 1; o < 64; o <<= 1) v += __shfl_xor(v, o);
    return v;
}
__device__ __forceinline__ float wave_max(float v) {
#pragma unroll
    for (int o = 1; o < 64; o <<= 1) v = fmaxf(v, __shfl_xor(v, o));
    return v;
}
__device__ __forceinline__ float dpp_f(float x, int ctrl_unused) { return x; }
#define DPP_ADD(x, CTRL) ((x) + __builtin_bit_cast(float, __builtin_amdgcn_update_dpp(0, __builtin_bit_cast(int, (x)), (CTRL), 0xF, 0xF, true)))
__device__ __forceinline__ float red8(float x) {
    x = DPP_ADD(x, 0xB1);
    x = DPP_ADD(x, 0x4E);
    x = DPP_ADD(x, 0x141);
    return x;
}

struct Frame {
    LAS unsigned char* lds; volatile LAS unsigned* MISC; gu32* ctl;
    int tid, lane, wave, vcu, G;
    const float* in[22]; float* out; unsigned char* ws;
};
#define IN_X 0
#define IN_NORMW 1
#define IN_WIN 2
#define IN_MUR 3
#define IN_MUK 4
#define IN_MUV 5
#define IN_MUW 6
#define IN_MUA 7
#define IN_W0 8
#define IN_WDUP 9
#define IN_A0 10
#define IN_WAUP 11
#define IN_KK 12
#define IN_KA 13
#define IN_RK 14
#define IN_GNW 15
#define IN_GNB 16
#define IN_QNW 17
#define IN_KNW 18
#define IN_WPR 19
#define IN_WPM 20
#define IN_WOUT 21

__device__ __forceinline__ void transpose_item(const float* W, int ldw, int k0, int srcn0, bf16* WT, int K, int dstn0, LAS float* scr, int lane) {
    if (srcn0 >= 0) {
        float t[32]; const float* wp = W + (size_t)(k0 + (lane >> 5)) * ldw + srcn0 + (lane & 31);
#pragma unroll
        for (int i = 0; i < 32; ++i) t[i] = wp[(size_t)(2 * i) * ldw];
#pragma unroll
        for (int i = 0; i < 32; ++i) scr[(2 * i + (lane >> 5)) * 33 + (lane & 31)] = t[i];
    } else {
#pragma unroll 8
        for (int i = 0; i < 32; ++i) { const int kk = 2 * i + (lane >> 5); scr[kk * 33 + (lane & 31)] = 0.f; }
    }
    LDS_WAIT(); asm volatile("" ::: "memory");
    const int c = lane & 7;
#pragma unroll
    for (int j = 0; j < 4; ++j) { const int n = (lane >> 3) + 8 * j; const LAS float* s = scr + (8 * c) * 33 + n;
        v4u o; o.x = pk2(s[0 * 33], s[1 * 33]); o.y = pk2(s[2 * 33], s[3 * 33]); o.z = pk2(s[4 * 33], s[5 * 33]); o.w = pk2(s[6 * 33], s[7 * 33]);
        *(GAS v4u*)(WT + (size_t)(dstn0 + n) * K + k0 + 8 * c) = o; }
    LDS_WAIT(); asm volatile("" ::: "memory");
}
__device__ __forceinline__ int win_src_col(int d) { if (d >= 4096 && d < 6144) { const int i = d & 255; return 4224 + ((d - 4096) & ~255) + 64 * ((i >> 5) & 3) + 32 * (i >> 7) + (i & 31); }
    if (d >= 8192 && d < 12288) { const int j = (d - 8192) >> 8, o = d & 255; return 8320 + (o >> 7) * 2048 + 128 * j + (o & 127); }
    return d < 4096 ? d : d < 8192 ? 4224 + (d - 4096) : d < 12416 ? 4096 + (d - 12288) : -1; }
__device__ __forceinline__ void rms_row_to_bf16(Frame& F, const float* xrow, const f32x4 (&gg)[8], bf16* orow) {
    const GAS f32x4* xr = (const GAS f32x4*)xrow + F.lane;
    f32x4 v[8]; float s = 0.f;
#pragma unroll
    for (int j = 0; j < 8; ++j) { v[j] = xr[64 * j]; s += (v[j].x * v[j].x + v[j].y * v[j].y) + (v[j].z * v[j].z + v[j].w * v[j].w); }
    const float rstd = 1.f / sqrtf(wave_sum(s) * (1.f / DM) + RMS_EPS);
    GAS unsigned long long* o8 = (GAS unsigned long long*)orow + F.lane;
#pragma unroll
    for (int j = 0; j < 8; ++j) o8[64 * j] = (unsigned long long)pk2(v[j].x * rstd * gg[j].x, v[j].y * rstd * gg[j].y) | ((unsigned long long)pk2(v[j].z * rstd * gg[j].z, v[j].w * rstd * gg[j].w) << 32);
}
__device__ __forceinline__ void p0_prologue(Frame& F) {
    LAS float* scr = (LAS float*)(F.lds + F.wave * 16384);
    const int gw = F.vcu * NWAVES + F.wave, NGW = F.G * NWAVES;
    bf16* WINT = (bf16*)(F.ws + WS_WINT);
    constexpr int I_IN = (DM / 64) * (NIN / 32);
    bf16* XN = (bf16*)(F.ws + WS_XN);
    { GAS f32x4* km = (GAS f32x4*)(F.ws + WS_KMEAN); for (int e = gw * 64 + F.lane; e < BATCH * NH * 8 * 64 / 4; e += NGW * 64) km[e] = (f32x4){0.f, 0.f, 0.f, 0.f}; }
    const bool rows_first = (F.wave & 1) != 0;
#pragma unroll 1
    for (int pass = 0; pass < 2; ++pass) {
        if ((pass == 0) == rows_first) { f32x4 gg[8];
#pragma unroll
            for (int j = 0; j < 8; ++j) gg[j] = ((const GAS f32x4*)F.in[IN_NORMW])[F.lane + 64 * j];
            f32x4 v[8], w[8]; int m = gw;
            if (m < T) {
#pragma unroll
                for (int j = 0; j < 8; ++j) v[j] = ((const GAS f32x4*)(F.in[IN_X] + (size_t)m * DM))[F.lane + 64 * j]; }
            for (; m < T; m += NGW) { const int mn = m + NGW;
                if (mn < T) {
#pragma unroll
                    for (int j = 0; j < 8; ++j) w[j] = ((const GAS f32x4*)(F.in[IN_X] + (size_t)mn * DM))[F.lane + 64 * j]; }
                float s_ = 0.f;
#pragma unroll
                for (int j = 0; j < 8; ++j) s_ += (v[j].x * v[j].x + v[j].y * v[j].y) + (v[j].z * v[j].z + v[j].w * v[j].w);
                const float rstd = 1.f / sqrtf(wave_sum(s_) * (1.f / DM) + RMS_EPS);
                GAS unsigned long long* o8 = (GAS unsigned long long*)(XN + (size_t)m * DM) + F.lane;
#pragma unroll
                for (int j = 0; j < 8; ++j) o8[64 * j] = (unsigned long long)pk2(v[j].x * rstd * gg[j].x, v[j].y * rstd * gg[j].y) | ((unsigned long long)pk2(v[j].z * rstd * gg[j].z, v[j].w * rstd * gg[j].w) << 32);
#pragma unroll
                for (int j = 0; j < 8; ++j) v[j] = w[j]; } }
        else { for (int it = gw; it < I_IN; it += NGW) { const int nblk = NIN / 32, kb = it / nblk, nb = it % nblk; transpose_item(F.in[IN_WIN], 12416, 64 * kb, win_src_col(32 * nb), WINT, DM, 32 * nb, scr, F.lane); } }
    }
}


__device__ __forceinline__ void p0_weights_late(Frame& F, int gw, int ngw, int lo = 0, int hi = 1 << 30) {
    LAS float* scr = (LAS float*)(F.lds + F.wave * 16384);
    bf16* WMT = (bf16*)(F.ws + WS_WMT); bf16* WOT = (bf16*)(F.ws + WS_WOT);
    constexpr int I_A = (WID / 64) * (DM / 32), I_O = (DM / 64) * (DM / 32), NITEMS = 2 * I_A + I_O;
    for (int it = lo + gw; it < (hi < NITEMS ? hi : NITEMS); it += ngw) {
        int r = it; const int nblk = DM / 32;
        if (r < I_A) { const int kb = r / nblk, nb = r % nblk; transpose_item(F.in[IN_WPM], DM, 64 * kb, 32 * nb, WMT, DM, 32 * nb, scr, F.lane); continue; } r -= I_A;
        if (r < I_A) { const int kb = r / nblk, nb = r % nblk; transpose_item(F.in[IN_WPR], DM, 64 * kb, 32 * nb, WMT + WID, DM, 32 * nb, scr, F.lane); continue; } r -= I_A;
        { const int kb = r / nblk, nb = r % nblk; transpose_item(F.in[IN_WOUT], DM, 64 * kb, 32 * nb, WOT, DM, 32 * nb, scr, F.lane); }
    }
}
#ifndef MK_NLATE
#define MK_NLATE 9
#endif
constexpr int NLATE = MK_NLATE, NMAIN = 49 - NLATE;
struct InOrderMain { pg8::StaticOrder S;
    __device__ __forceinline__ bool next(int i, pg8::Unit& u) const { if (!S.next(i, u)) return false; if (u.pn == NMAIN - 1) u.pn = 48; return true; }
    __device__ __forceinline__ void a_ready(const pg8::Unit&) const {}
    __device__ __forceinline__ void done(const pg8::Unit&) const {} };
struct InOrderLate { int c, G;
    __device__ __forceinline__ bool next(int i, pg8::Unit& u) const { const int ng = G >> 5, g = c >> 5, w = c & 31, per = (64 / ng) * NLATE, j = i * 32 + w; if (j >= per) return false;
        u.pm = g * (64 / ng) + j / NLATE; u.pn = 48 - NLATE + j % NLATE; return true; }
    __device__ __forceinline__ void a_ready(const pg8::Unit&) const {}
    __device__ __forceinline__ void done(const pg8::Unit&) const {} };
namespace ck {
constexpr int C = 32, NCH = SEQ / C, LT = 72, LX = 40;
typedef float f32x2 __attribute__((ext_vector_type(2)));
typedef float f32x16 __attribute__((ext_vector_type(16)));
typedef __bf16 bf16x2_t __attribute__((ext_vector_type(2)));
typedef unsigned u32x2 __attribute__((ext_vector_type(2)));
__device__ __forceinline__ unsigned cvt2(float lo, float hi) { f32x2 v = {lo, hi}; bf16x2_t b = __builtin_convertvector(v, bf16x2_t); return __builtin_bit_cast(unsigned, b); }
__device__ __forceinline__ float fsig(float x) { return __builtin_amdgcn_rcpf(1.0f + __builtin_amdgcn_exp2f(-1.4426950408889634f * x)); }
__device__ __forceinline__ float ftanh(float x) { return 1.0f - 2.0f * __builtin_amdgcn_rcpf(1.0f + __builtin_amdgcn_exp2f(2.8853900817779268f * x)); }
__device__ __forceinline__ float fexp(float x) { return __builtin_amdgcn_exp2f(1.4426950408889634f * x); }
__device__ __forceinline__ int crow(int r, int hi) { return (r & 3) + 8 * (r >> 2) + 4 * hi; }
__device__ __forceinline__ float red16(float x) { x = red8(x); x = DPP_ADD(x, 0x128); return x; }
__device__ __forceinline__ int opq(int x) { asm volatile("" : "+v"(x)); return x; }
#define CK_BAR() asm volatile("s_waitcnt lgkmcnt(0)\n\ts_barrier" ::: "memory")
#if MK_TS
#define CK_BARK(k) do { const unsigned t0_ = (unsigned)__builtin_amdgcn_s_memrealtime(); CK_BAR(); const unsigned t1_ = (unsigned)__builtin_amdgcn_s_memrealtime(); wsum[k] += t1_ - tprev; wwait[k] += t1_ - t0_; tprev = t1_; } while (0)
#else
#define CK_BARK(k) CK_BAR()
#endif
typedef short v4i16_t __attribute__((ext_vector_type(4)));
template <bool TR> __device__ __forceinline__ pg8::bf16x8 ck_frag(const LAS bf16* X, int ld, int k0, int lane) {
    if (!TR) return *(const LAS pg8::bf16x8*)(X + (lane & 31) * ld + k0 + 8 * (lane >> 5));
    const LAS bf16* p = X + (k0 + 8 * (lane >> 5) + ((lane & 15) >> 2)) * ld + 16 * ((lane >> 4) & 1) + 4 * (lane & 3);
    const v4i16_t lo = __builtin_amdgcn_ds_read_tr16_b64_v4i16((LAS v4i16_t*)p), hi4 = __builtin_amdgcn_ds_read_tr16_b64_v4i16((LAS v4i16_t*)(p + 4 * ld));
    return (pg8::bf16x8){lo[0], lo[1], lo[2], lo[3], hi4[0], hi4[1], hi4[2], hi4[3]};
}
template <int K, bool TA, bool TB> __device__ __forceinline__ f32x16 mm_tile(const LAS bf16* A, int lda, const LAS bf16* B, int ldb, f32x16 acc, int lane) {
#pragma unroll
    for (int k0 = 0; k0 < K; k0 += 16) acc = __builtin_amdgcn_mfma_f32_32x32x16_bf16(ck_frag<TA>(A, lda, k0, lane), ck_frag<TB>(B, ldb, k0, lane), acc, 0, 0, 0);
    return acc;
}
constexpr int SZ_TOK = C * LT * 2, SZ_GRM = C * 36 * 4 + 3 * C * LX * 2 + 64 * 4;
constexpr int O_TOK = 0;
constexpr int O_GRM = O_TOK + 2 * 5 * SZ_TOK;
constexpr int O_TM = O_GRM + 2 * SZ_GRM, O_LVT = O_TM + C * LX * 2, O_AHT = O_LVT + 64 * LX * 2, O_W2T = O_AHT + 64 * LX * 2;
constexpr int O_RH = O_W2T + 64 * LX * 2, O_PP = O_RH + C * LT * 2, O_ZT = O_PP + 64 * LT * 2;
constexpr int O_GX = O_ZT + 64 * LT * 2, O_LA = O_GX + C * 64 * 4, O_LW = O_LA + C * 68 * 4, O_PAR = O_LW + C * 64 * 4, O_L21 = O_PAR + 12 * 64 * 4, O_XT = O_L21 + 16 * 24 * 2, O_HAND = O_XT + 16 * 24 * 2, O_END1 = O_HAND + 8 * 64;
constexpr int O_YL = O_LVT, O_WST = 0;
static_assert(O_END1 <= 143360 && C * 65 * 4 <= 2 * 64 * LX * 2, "chunk LDS map");

__device__ __forceinline__ void head(Frame& F, int bh) {
    LAS unsigned char* lds = F.lds; LAS float* Lpar = (LAS float*)(lds + O_PAR); LAS float* La = (LAS float*)(lds + O_LA); LAS float* Lws = (LAS float*)(lds + O_LW); LAS bf16* BVb = (LAS bf16*)(lds + O_GX); LAS unsigned* Lhand = (LAS unsigned*)(lds + O_HAND);
    LAS bf16* Tm = (LAS bf16*)(lds + O_TM); LAS bf16* LVt = (LAS bf16*)(lds + O_LVT); LAS bf16* AhT = (LAS bf16*)(lds + O_AHT); LAS bf16* W2t = (LAS bf16*)(lds + O_W2T); LAS bf16* Rh = (LAS bf16*)(lds + O_RH); LAS bf16* Pp = (LAS bf16*)(lds + O_PP); LAS bf16* ZT = (LAS bf16*)(lds + O_ZT);
    LAS float* Yl = (LAS float*)(lds + O_YL);
    const bf16* RKV = (const bf16*)(F.ws + WS_RKV); const bf16* LORA = (const bf16*)(F.ws + WS_LORA); const bf16* ZA = (const bf16*)(F.ws + WS_ZA); bf16* YA = (bf16*)(F.ws + WS_Y) + 1024;
    const int tid0 = F.tid, lane0 = F.lane, wave = F.wave, b = bh >> 4, h = bh & 15;
    const size_t row0 = (size_t)b * SEQ;
    const bool front = wave >= 4; const int fw = wave - 4;
    CK_BAR();
    { const int tid = tid0;
    for (int e = tid; e < 12 * 64; e += 512) { const int a = e >> 6, d = e & 63;
        const float* pp = a == 0 ? F.in[IN_MUR] : a == 1 ? F.in[IN_MUK] : a == 2 ? F.in[IN_MUV] : a == 3 ? F.in[IN_KK] : a == 4 ? F.in[IN_KA] : a == 5 ? F.in[IN_RK] : a == 6 ? F.in[IN_GNW] : a == 7 ? F.in[IN_GNB] : a == 8 ? F.in[IN_W0] : a == 9 ? F.in[IN_A0] : a == 10 ? F.in[IN_MUW] : F.in[IN_MUA];
        Lpar[e] = pp[a >= 10 ? d : h * 64 + d]; }
    { LAS float* Wst = (LAS float*)(lds + O_WST);
#pragma unroll
        for (int it = 0; it < 4; ++it) { const int e = tid + 512 * it, mtx = e >> 10, row = (e >> 4) & 63, c4 = (e & 15) * 4; const float* W = mtx ? F.in[IN_WAUP] : F.in[IN_WDUP];
            *(LAS pg8::f32x4*)(Wst + mtx * 4096 + row * 64 + c4) = *(const GAS pg8::f32x4*)(W + (size_t)row * 1024 + h * 64 + c4); } }
    for (int e = tid; e < 64 * LT / 2; e += 512) ((LAS unsigned*)ZT)[e] = 0u;
    if (tid < 256) Tm[(tid >> 4) * LX + 16 + (tid & 15)] = (bf16)0;
    if (tid < 128) Lhand[tid] = 0u; }
    CK_BAR();
    const bool la = (fw & 1) != 0, lw = !la; const int lct = (fw >> 1) & 1;
    pg8::bf16x8 wf[4];
    if (front) { const int l_ = lane0, hi_ = l_ >> 5, c_ = l_ & 31; const LAS float* Wst = (LAS float*)(lds + O_WST) + (la ? 4096 : 0) + (8 * hi_) * 64 + c_ + 32 * lct;
#pragma unroll
        for (int s = 0; s < 4; ++s) { float t[8];
#pragma unroll
            for (int j = 0; j < 8; ++j) t[j] = Wst[(16 * s + j) * 64];
            const v4u pk_ = {cvt2(t[0], t[1]), cvt2(t[2], t[3]), cvt2(t[4], t[5]), cvt2(t[6], t[7])}; wf[s] = __builtin_bit_cast(pg8::bf16x8, pk_); } }
    CK_BAR();
    v4u pLc[4], pR[6];
#define CK_PF_LORA(nn) do { const int l_ = opq(lane0), t_ = (nn) * C + (l_ & 31); const bf16* lp_ = LORA + (row0 + t_) * 128 + (la ? 64 : 0) + 8 * (l_ >> 5); \
        _Pragma("unroll") for (int s = 0; s < 4; ++s) pLc[s] = *(const GAS v4u*)(lp_ + 16 * s); } while (0)
#define CK_PF_RKV(nn) do { const int i_ = fw * 64 + opq(lane0), t_ = (nn) * C + (i_ >> 3); const bf16* rp_ = RKV + (row0 + t_) * 3072 + h * 64 + 8 * (i_ & 7); \
        pR[0] = *(const GAS v4u*)rp_; pR[1] = *(const GAS v4u*)(rp_ + 1024); pR[2] = *(const GAS v4u*)(rp_ + 2048); \
        if (t_ > 0) { pR[3] = *(const GAS v4u*)(rp_ - 3072); pR[4] = *(const GAS v4u*)(rp_ - 3072 + 1024); pR[5] = *(const GAS v4u*)(rp_ - 3072 + 2048); } else { pR[3] = (v4u){0u, 0u, 0u, 0u}; pR[4] = pR[3]; pR[5] = pR[3]; } \
        } while (0)
    if (front) CK_PF_LORA(0);
    f32x16 Z = {};
    v4u zaC = {0u, 0u, 0u, 0u};
#if MK_TS
    unsigned wsum[4] = {0u, 0u, 0u, 0u}, wwait[4] = {0u, 0u, 0u, 0u}, tprev = (unsigned)__builtin_amdgcn_s_memrealtime();
#endif
    for (int n = -1; n < NCH; ++n) {
        const int m = n + 1; const bool fm = front && m < NCH, bn = !front && n >= 0;
        const int lane = opq(lane0), r32 = lane & 31, hi = lane >> 5, idx = fw * 64 + lane, tok = idx >> 3, p = idx & 7;
        LAS bf16* tkM = (LAS bf16*)(lds + O_TOK + (m & 1) * 5 * SZ_TOK); LAS unsigned char* gmM = lds + O_GRM + (m & 1) * SZ_GRM;
        const LAS bf16* tkN = (const LAS bf16*)(lds + O_TOK + (n & 1) * 5 * SZ_TOK); const LAS unsigned char* gmN = lds + O_GRM + (n & 1) * SZ_GRM;
        const LAS bf16* tokA = tkN, *tokR = tkN + C * LT, *tokB = tkN + 2 * C * LT, *tokK = tkN + 3 * C * LT, *tokV = tkN + 4 * C * LT;
        const LAS float* Lab = (const LAS float*)gmN; const LAS bf16* Lak = (const LAS bf16*)(gmN + C * 36 * 4); const LAS bf16* Mrb = Lak + C * LX; const LAS bf16* Mrk = Mrb + C * LX; const LAS float* gC = (const LAS float*)(gmN + C * 36 * 4 + 3 * C * LX * 2);
        float r_[8], kp_[8], v_[8], al_[8], be_[8], lw_[8];
        if (fm) { LAS float* mu_ = Lpar + (la ? 11 : 10) * 64 + 8 * hi;
            f32x16 acc0_ = {};
#pragma unroll
            for (int s = 0; s < 4; ++s) { float cu_[8], pv_[8]; unpack8(pLc[s], cu_);
                {
                    v4u pp_; const v4u hd_ = *(const LAS v4u*)(Lhand + (fw * 2 + hi) * 16 + 4 * s);
                    pp_.x = (unsigned)__builtin_amdgcn_update_dpp(0, (int)pLc[s].x, 0x138, 0xF, 0xF, false); pp_.y = (unsigned)__builtin_amdgcn_update_dpp(0, (int)pLc[s].y, 0x138, 0xF, 0xF, false);
                    pp_.z = (unsigned)__builtin_amdgcn_update_dpp(0, (int)pLc[s].z, 0x138, 0xF, 0xF, false); pp_.w = (unsigned)__builtin_amdgcn_update_dpp(0, (int)pLc[s].w, 0x138, 0xF, 0xF, false);
                    if (r32 == 0) pp_ = hd_;
                    unpack8(pp_, pv_); }
#pragma unroll
                for (int j = 0; j < 8; ++j) cu_[j] = cu_[j] + (pv_[j] - cu_[j]) * mu_[16 * s + j];
                if (lw) {
#pragma unroll
                    for (int j = 0; j < 8; ++j) cu_[j] = ftanh(cu_[j]); }
                const v4u pk_ = {cvt2(cu_[0], cu_[1]), cvt2(cu_[2], cu_[3]), cvt2(cu_[4], cu_[5]), cvt2(cu_[6], cu_[7])}; const pg8::bf16x8 af_ = __builtin_bit_cast(pg8::bf16x8, pk_);
                acc0_ = __builtin_amdgcn_mfma_f32_32x32x16_bf16(af_, wf[s], acc0_, 0, 0, 0); }
            if (r32 == 31) {
#pragma unroll
                for (int s = 0; s < 4; ++s) *(LAS v4u*)(Lhand + (fw * 2 + hi) * 16 + 4 * s) = pLc[s]; }
            asm volatile("" ::: "memory"); CK_PF_RKV(m); asm volatile("" ::: "memory");
            const float b0_ = Lpar[(lw ? 8 : 9) * 64 + 32 * lct + r32];
#pragma unroll
            for (int r = 0; r < 16; ++r) acc0_[r] = fsig(acc0_[r] + b0_);
            if (lw) { LAS float* o_ = Lws + (4 * hi) * 64 + 32 * lct + r32;
#pragma unroll
                for (int r = 0; r < 16; ++r) o_[((r & 3) + 8 * (r >> 2)) * 64] = -0.60653066f * acc0_[r]; }
            else { LAS float* o_ = La + (4 * hi) * 68 + 32 * lct + r32;
#pragma unroll
                for (int r = 0; r < 16; ++r) o_[((r & 3) + 8 * (r >> 2)) * 68] = acc0_[r]; } }
        if (bn && wave == 0) {
            LAS bf16* L21b = (LAS bf16*)(lds + O_L21); LAS bf16* Xt = (LAS bf16*)(lds + O_XT);
            const int blk = (lane >> 4) & 1, i = lane & 15; const LAS float* Lb = Lab + (16 * blk) * 36 + 16 * blk; float T[16];
#pragma unroll
            for (int t = 0; t < 16; ++t) { float a0 = (t == i) ? 1.f : 0.f, a1 = 0.f, a2 = 0.f, a3 = 0.f;
#pragma unroll
                for (int j4 = 0; j4 < t; j4 += 4) { const pg8::f32x4 l4 = *(const LAS pg8::f32x4*)(Lb + t * 36 + j4);
                    a0 += l4.x * T[j4]; if (j4 + 1 < t) a1 += l4.y * T[j4 + 1]; if (j4 + 2 < t) a2 += l4.z * T[j4 + 2]; if (j4 + 3 < t) a3 += l4.w * T[j4 + 3]; }
                T[t] = (a0 + a1) + (a2 + a3); }
            if (hi == 0) {
#pragma unroll
                for (int t = 0; t < 16; ++t) Tm[(16 * blk + t) * LX + 16 * blk + i] = (bf16)f2bf(T[t]); }
            { const int r = lane >> 2, j0 = 4 * (lane & 3); const pg8::f32x4 l4 = *(const LAS pg8::f32x4*)(Lab + (16 + r) * 36 + j0); *(LAS u32x2*)(L21b + r * 24 + j0) = (u32x2){cvt2(l4.x, l4.y), cvt2(l4.z, l4.w)}; }
            asm volatile("s_waitcnt lgkmcnt(0)" ::: "memory");
            { const pg8::bf16x8 a = *(const LAS pg8::bf16x8*)(L21b + i * 24 + 8 * hi); const f32x16 x = __builtin_amdgcn_mfma_f32_32x32x16_bf16(a, ck_frag<true>(Tm, LX, 0, lane), f32x16{}, 0, 0, 0);
                if (r32 < 16) {
#pragma unroll
                    for (int q = 0; q < 2; ++q) *(LAS u32x2*)(Xt + r32 * 24 + 8 * q + 4 * hi) = (u32x2){cvt2(x[4 * q], x[4 * q + 1]), cvt2(x[4 * q + 2], x[4 * q + 3])}; } }
            asm volatile("s_waitcnt lgkmcnt(0)" ::: "memory");
            { const pg8::bf16x8 a = *(const LAS pg8::bf16x8*)(Tm + (16 + i) * LX + 16 + 8 * hi), bfr = *(const LAS pg8::bf16x8*)(Xt + i * 24 + 8 * hi);
                const f32x16 t21 = __builtin_amdgcn_mfma_f32_32x32x16_bf16(a, bfr, f32x16{}, 0, 0, 0);
                if (r32 < 16) {
#pragma unroll
                    for (int q = 0; q < 2; ++q)
#pragma unroll
                        for (int e2 = 0; e2 < 4; ++e2) Tm[(16 + 8 * q + 4 * hi + e2) * LX + r32] = (bf16)f2bf(t21[4 * q + e2]); } } }
        CK_BARK(0);
        if (bn) zaC = *(const GAS v4u*)(ZA + (row0 + n * C + ((wave * 64 + lane) >> 3)) * 1024 + h * 64 + 8 * (lane & 7));
        if (fm) {
            const int cch = 16 * fw + (lane & 15), seg = lane >> 4; LAS float* gCm = (LAS float*)(gmM + C * 36 * 4 + 3 * C * LX * 2); float g[8];
#pragma unroll
            for (int j = 0; j < 8; ++j) g[j] = Lws[(8 * seg + j) * 64 + cch];
#pragma unroll
            for (int j = 1; j < 8; ++j) g[j] += g[j - 1];
            const float S = g[7];
            const auto a_ = __builtin_amdgcn_permlane16_swap(__float_as_uint(S), __float_as_uint(S), false, false); const float other16 = (seg & 1) ? __uint_as_float(a_[0]) : __uint_as_float(a_[1]);
            const float pairT = S + other16;
            const auto b_ = __builtin_amdgcn_permlane32_swap(__float_as_uint(pairT), __float_as_uint(pairT), false, false); const float other32 = (seg & 2) ? __uint_as_float(b_[0]) : __uint_as_float(b_[1]);
            const float off = ((seg & 1) ? other16 : 0.f) + ((seg & 2) ? other32 : 0.f);
#pragma unroll
            for (int j = 0; j < 8; ++j) Lws[(8 * seg + j) * 64 + cch] = g[j] + off;
            if (seg == 3) gCm[cch] = fexp(g[7] + off); }
        if (bn) { const int nt = wave & 1; const LAS bf16* A_ = wave < 2 ? Tm : Lak; const LAS bf16* B_ = (wave < 2 ? tokA : tokV) + nt * 32; LAS bf16* O_ = (wave < 2 ? AhT : LVt) + nt * 32 * LX;
            const f32x16 d = mm_tile<32, false, true>(A_, LX, B_, LT, f32x16{}, lane);
#pragma unroll
            for (int q = 0; q < 4; ++q) *(LAS u32x2*)(O_ + r32 * LX + 8 * q + 4 * hi) = (u32x2){cvt2(d[4 * q], d[4 * q + 1]), cvt2(d[4 * q + 2], d[4 * q + 3])}; }
        CK_BARK(1);
        if (fm) { float cr[8], ck_[8], cv[8], qr[8], qk[8], qv[8]; unpack8(pR[0], cr); unpack8(pR[1], ck_); unpack8(pR[2], cv); unpack8(pR[3], qr); unpack8(pR[4], qk); unpack8(pR[5], qv);
            float kkr[8], kk_[8], ss = 0.f, bon = 0.f;
#pragma unroll
            for (int j = 0; j < 8; ++j) { const int d = 8 * p + j; r_[j] = cr[j] + (qr[j] - cr[j]) * Lpar[0 * 64 + d]; kk_[j] = ck_[j] + (qk[j] - ck_[j]) * Lpar[1 * 64 + d]; v_[j] = cv[j] + (qv[j] - cv[j]) * Lpar[2 * 64 + d];
                kkr[j] = kk_[j] * Lpar[3 * 64 + d]; ss += kkr[j] * kkr[j]; }
            ss = red8(ss); const float inv = 1.f / fmaxf(sqrtf(ss), 1e-12f);
            const int tpv = tok > 0 ? tok - 1 : 0;
#pragma unroll
            for (int j = 0; j < 8; ++j) { const int d = 8 * p + j; const float aa = La[tok * 68 + d], kn = kkr[j] * inv; kp_[j] = kk_[j] * (1.f + (aa - 1.f) * Lpar[4 * 64 + d]); al_[j] = -kn; be_[j] = kn * aa;
                bon += r_[j] * kp_[j] * Lpar[5 * 64 + d]; lw_[j] = Lws[tok * 64 + d] - (tok > 0 ? Lws[tpv * 64 + d] : 0.f); }
            bon = red8(bon);
#pragma unroll
            for (int j = 0; j < 8; ++j) kkr[j] = bon * v_[j];
            *(LAS v4u*)(BVb + (m & 1) * C * 64 + tok * 64 + 8 * p) = (v4u){cvt2(kkr[0], kkr[1]), cvt2(kkr[2], kkr[3]), cvt2(kkr[4], kkr[5]), cvt2(kkr[6], kkr[7])};
            float at[8], rt[8], bt[8], kt[8];
#pragma unroll
            for (int j = 0; j < 8; ++j) { const float gi = Lws[tok * 64 + 8 * p + j], ge = gi - lw_[j], en = fexp(-gi); at[j] = al_[j] * fexp(ge); rt[j] = r_[j] * fexp(gi); bt[j] = be_[j] * en; kt[j] = kp_[j] * en; }
            const int o = tok * LT + 8 * p;
            *(LAS v4u*)(tkM + o) = (v4u){cvt2(at[0], at[1]), cvt2(at[2], at[3]), cvt2(at[4], at[5]), cvt2(at[6], at[7])}; *(LAS v4u*)(tkM + C * LT + o) = (v4u){cvt2(rt[0], rt[1]), cvt2(rt[2], rt[3]), cvt2(rt[4], rt[5]), cvt2(rt[6], rt[7])};
            *(LAS v4u*)(tkM + 2 * C * LT + o) = (v4u){cvt2(bt[0], bt[1]), cvt2(bt[2], bt[3]), cvt2(bt[4], bt[5]), cvt2(bt[6], bt[7])}; *(LAS v4u*)(tkM + 3 * C * LT + o) = (v4u){cvt2(kt[0], kt[1]), cvt2(kt[2], kt[3]), cvt2(kt[4], kt[5]), cvt2(kt[6], kt[7])};
            *(LAS v4u*)(tkM + 4 * C * LT + o) = (v4u){cvt2(v_[0], v_[1]), cvt2(v_[2], v_[3]), cvt2(v_[4], v_[5]), cvt2(v_[6], v_[7])}; }
        if (bn) {
            if (wave < 2) { const int nt = wave; const f32x16 d = mm_tile<32, false, false>(Tm, LX, LVt + nt * 32 * LX, LX, f32x16{}, lane);
#pragma unroll
                for (int q = 0; q < 4; ++q) *(LAS u32x2*)(W2t + (nt * 32 + r32) * LX + 8 * q + 4 * hi) = (u32x2){cvt2(d[4 * q], d[4 * q + 1]), cvt2(d[4 * q + 2], d[4 * q + 3])}; }
            else { const int ct = wave - 2; const f32x16 d = mm_tile<32, false, false>(AhT + ct * 32 * LX, LX, Mrb, LX, f32x16{}, lane); const int t = r32;
#pragma unroll
                for (int q = 0; q < 4; ++q) { const int c0 = ct * 32 + 8 * q + 4 * hi; const u32x2 rr = *(const LAS u32x2*)(tokR + t * LT + c0);
                    *(LAS u32x2*)(Rh + t * LT + c0) = (u32x2){cvt2(d[4 * q] + blo(rr.x), d[4 * q + 1] + bhi(rr.x)), cvt2(d[4 * q + 2] + blo(rr.y), d[4 * q + 3] + bhi(rr.y))}; } }
            { const int ct = wave & 1, c2t = wave >> 1; const f32x16 d = mm_tile<32, false, true>(AhT + ct * 32 * LX, LX, tokB + c2t * 32, LT, f32x16{}, lane); const int c2 = c2t * 32 + r32; const float gm = gC[c2];
#pragma unroll
                for (int q = 0; q < 4; ++q) { const int c0 = ct * 32 + 8 * q + 4 * hi;
                    *(LAS u32x2*)(Pp + c2 * LT + c0) = (u32x2){cvt2(gm * d[4 * q], gm * d[4 * q + 1]), cvt2(gm * d[4 * q + 2], gm * d[4 * q + 3])}; } } }
        CK_BARK(2);
        if (fm) { const LAS bf16* A_ = (fw == 0 || fw == 2) ? tkM + 2 * C * LT : tkM + 3 * C * LT; const LAS bf16* Bt_ = (fw < 2) ? tkM : tkM + C * LT;
            const f32x16 d = mm_tile<64, false, false>(A_, LT, Bt_, LT, f32x16{}, lane); const int t = r32;
            LAS float* LabM = (LAS float*)gmM; LAS bf16* O_ = (LAS bf16*)(gmM + C * 36 * 4) + (fw - 1) * C * LX;
            const int lim = t + (fw < 2 ? 0 : 1) - 4 * hi;
            float x[16];
#pragma unroll
            for (int r = 0; r < 16; ++r) x[r] = (8 * (r >> 2) + (r & 3) < lim) ? d[r] : 0.f;
            if (fw == 0) { LAS float* o_ = LabM + t * 36 + 4 * hi;
#pragma unroll
                for (int q = 0; q < 4; ++q) *(LAS pg8::f32x4*)(o_ + 8 * q) = (pg8::f32x4){x[4 * q], x[4 * q + 1], x[4 * q + 2], x[4 * q + 3]}; }
            else { LAS bf16* o_ = O_ + t * LX + 4 * hi;
#pragma unroll
                for (int q = 0; q < 4; ++q) *(LAS u32x2*)(o_ + 8 * q) = (u32x2){cvt2(x[4 * q], x[4 * q + 1]), cvt2(x[4 * q + 2], x[4 * q + 3])}; } }
        if (front && n >= 0 && fw < 2) { const int yv = fw;
            f32x16 y = mm_tile<32, false, false>(Mrb, LX, W2t + yv * 32 * LX, LX, f32x16{}, lane); y = mm_tile<32, false, true>(Mrk, LX, tokV + yv * 32, LT, y, lane);
            const f32x16 y2 = mm_tile<64, false, false>(Rh, LT, ZT + yv * 32 * LT, LT, f32x16{}, lane);
#pragma unroll
            for (int r = 0; r < 16; ++r) Yl[crow(r, hi) * 65 + yv * 32 + r32] = y[r] + y2[r]; }
        if (bn) { const int c2t = wave & 1, vt = wave >> 1;
            f32x16 d = mm_tile<32, true, false>(tokB + c2t * 32, LT, W2t + vt * 32 * LX, LX, f32x16{}, lane); d = mm_tile<32, true, true>(tokK + c2t * 32, LT, tokV + vt * 32, LT, d, lane);
#pragma unroll
            for (int q = 0; q < 4; ++q) { const pg8::f32x4 g4 = *(const LAS pg8::f32x4*)(gC + c2t * 32 + 8 * q + 4 * hi);
                d[4 * q] = g4.x * (d[4 * q] + Z[4 * q]); d[4 * q + 1] = g4.y * (d[4 * q + 1] + Z[4 * q + 1]); d[4 * q + 2] = g4.z * (d[4 * q + 2] + Z[4 * q + 2]); d[4 * q + 3] = g4.w * (d[4 * q + 3] + Z[4 * q + 3]); }
            const f32x16 pz = mm_tile<64, false, false>(Pp + c2t * 32 * LT, LT, ZT + vt * 32 * LT, LT, f32x16{}, lane);
            Z = d + pz;
 }
        CK_BARK(3);
        if (front && m + 1 < NCH) CK_PF_LORA(m + 1);
        if (bn) { const int c2t = wave & 1, vt = wave >> 1;
#pragma unroll
            for (int q = 0; q < 4; ++q) *(LAS u32x2*)(ZT + (vt * 32 + r32) * LT + c2t * 32 + 8 * q + 4 * hi) = (u32x2){cvt2(Z[4 * q], Z[4 * q + 1]), cvt2(Z[4 * q + 2], Z[4 * q + 3])};
            const int tb = (wave * 64 + lane) >> 3, pb = lane & 7;
            const size_t row = row0 + n * C + tb; float y[8], za[8], o[8], bv[8], sm = 0.f; unpack8(zaC, za); unpack8(*(const LAS v4u*)(BVb + (n & 1) * C * 64 + tb * 64 + 8 * pb), bv);
#pragma unroll
            for (int j = 0; j < 8; ++j) { y[j] = Yl[tb * 65 + 8 * pb + j]; sm += y[j]; }
            const float mean = red8(sm) * (1.f / 64.f); float q_ = 0.f;
#pragma unroll
            for (int j = 0; j < 8; ++j) { y[j] -= mean; q_ += y[j] * y[j]; }
            const float rstd = __builtin_amdgcn_rsqf(red8(q_) * (1.f / 64.f) + GN_EPS);
#pragma unroll
            for (int j = 0; j < 8; ++j) o[j] = (y[j] * rstd * Lpar[6 * 64 + 8 * pb + j] + Lpar[7 * 64 + 8 * pb + j] + bv[j]) * za[j];
            *(GAS v4u*)(YA + row * 2048 + h * 64 + 8 * pb) = (v4u){cvt2(o[0], o[1]), cvt2(o[2], o[3]), cvt2(o[4], o[5]), cvt2(o[6], o[7])}; }
    }
#if MK_TS
    if (bh == 0 && lane0 == 0 && (wave == 0 || wave == 4)) {
#pragma unroll
        for (int k = 0; k < 4; ++k) { if (wave == 4) __hip_atomic_store((unsigned*)(F.ctl + CW_TS + 92 + k), wsum[k], __ATOMIC_RELAXED, __HIP_MEMORY_SCOPE_AGENT);
            __hip_atomic_store((unsigned*)(F.ctl + CW_TS + 80 + (wave ? 4 : 0) + k), wwait[k], __ATOMIC_RELAXED, __HIP_MEMORY_SCOPE_AGENT); } }
#endif
#undef CK_PF_RKV
#undef CK_PF_LORA
}
#undef CK_BAR
}

__device__ __forceinline__ void subset_barrier(gu32* cnt, unsigned nwg, bool t0) {
    asm volatile("s_waitcnt vmcnt(0)" ::: "memory"); __syncthreads();
    if (t0) { __builtin_amdgcn_fence(__ATOMIC_RELEASE, "agent"); asm volatile("s_waitcnt vmcnt(0)" ::: "memory");
        __hip_atomic_fetch_add((unsigned*)cnt, 1u, RLX_AGENT);
        unsigned sp = 0; while (__hip_atomic_load((unsigned*)cnt, RLX_AGENT) < nwg && ++sp < (1u << 22)) __builtin_amdgcn_s_sleep(2);
        __builtin_amdgcn_fence(__ATOMIC_ACQUIRE, "agent"); asm volatile("s_waitcnt vmcnt(0)" ::: "memory"); }
    __syncthreads();
}

#ifndef MK_CHECK
#define MK_CHECK 0
#endif
#ifndef MK_NAIVE_ATTN
#define MK_NAIVE_ATTN 0
#endif

#ifndef MK_GIVE_QB
#define MK_GIVE_QB 3
#endif
constexpr int PER_PHASE = 5;
struct Args { const float* in[22]; float* out; unsigned char* ws; int ph_lo, ph_hi, li, pad; };
__global__ void __launch_bounds__(NWAVES * 64, 2) mk_fwd(Args args) {
    extern __shared__ __attribute__((aligned(16))) unsigned char lds[];
    Frame F;
    F.lds = (LAS unsigned char*)lds; F.MISC = (volatile LAS unsigned*)(F.lds + MISC_OFF);
    F.wave = __builtin_amdgcn_readfirstlane((int)threadIdx.x >> 6); F.lane = mk_lane_id(); F.tid = F.wave * 64 + F.lane;
    F.G = gridDim.x; { const int bx = blockIdx.x; F.vcu = (F.G % 8 == 0) ? (bx % 8) * (F.G / 8) + bx / 8 : bx; }
    F.ws = args.ws; F.out = args.out; F.ctl = (gu32*)(args.ws + WS_CTL);
#pragma unroll
    for (int i = 0; i < 22; ++i) F.in[i] = args.in[i];
    for (int u = F.tid; u < (LDS_BYTES - LDSCTL_OFF) / 4; u += NWAVES * 64) ((LAS unsigned*)(F.lds + LDSCTL_OFF))[u] = 0u;
    __syncthreads();
    XcdBarrier bar; bar.bar = (unsigned*)(F.ctl + CW_BAR); bar.x = 0; bar.st = nullptr;
    if (MK_N_LAUNCHES == 1) bar = xcd_barrier_post((unsigned*)(F.ctl + CW_BAR), F.MISC + 8, F.tid == 0);
#define GRID_BAR() do { if (MK_N_LAUNCHES == 1) { FRESH(); xcd_barrier(bar, F.tid == 0); } } while (0)
    const int lo = args.ph_lo, hi = args.ph_hi;
#define TS(k) do { if (MK_TS && F.tid == 0 && (blockIdx.x == 0 || blockIdx.x == 4)) __hip_atomic_store((unsigned*)(F.ctl + CW_TS + (blockIdx.x ? 32 : 0) + (k)), (unsigned)__builtin_amdgcn_s_memrealtime(), __ATOMIC_RELAXED, __HIP_MEMORY_SCOPE_AGENT); } while (0)
    TS(0);
#if MK_TS == 90
    if (blockIdx.x == 0 && F.lane == 0) __hip_atomic_store((unsigned*)(F.ctl + CW_TS + 100 + F.wave), 1u + ((unsigned)__builtin_amdgcn_s_getreg((2 - 1) << 11 | 4 << 6 | 4) & 3u), __ATOMIC_RELAXED, __HIP_MEMORY_SCOPE_AGENT);
#endif
#ifndef MK_PHASE_MASK
#define MK_PHASE_MASK 0x1f
#endif
#define IN(k) (((MK_PHASE_MASK >> (k)) & 1) && lo <= (k) && (k) < hi)
#define FRESH() do { int l_ = mk_lane_id(); asm volatile("" : "+v"(l_)); F.lane = l_; F.tid = F.wave * 64 + l_; } while (0)
#define BOTH(k) (IN(k) && IN((k) + 1))
    bf16* WS16 = (bf16*)args.ws; (void)WS16;
    if (IN(0)) { FRESH(); p0_prologue(F); TS(1); if (BOTH(0)) GRID_BAR(); TS(2); }
    if (IN(1)) {
        pg8::Gemm g{(const pg8::bf16_t*)(args.ws + WS_XN), (const pg8::bf16_t*)(args.ws + WS_WINT), T, NIN, DM}; InOrderMain S; S.S.init(T, NMAIN * 256, F.G, (int)blockIdx.x);
        pg8::EpiIn E{(pg8::bf16_t*)(args.ws + WS_RKV), (pg8::bf16_t*)(args.ws + WS_ZA), (pg8::bf16_t*)(args.ws + WS_QKVB), (pg8::bf16_t*)(args.ws + WS_ZB), (pg8::bf16_t*)args.out, (pg8::bf16_t*)(args.ws + WS_LORA), F.in[IN_QNW], F.in[IN_KNW], (float*)(args.ws + WS_KMEAN)};
        pg8::gemm_phase<pg8::EpiIn, InOrderMain, true, true>(F.lds, g, S, E, F.wave);
        TS(3); if (BOTH(1)) GRID_BAR(); TS(4);
    }
    if (IN(2)) {
        const attn_body::bf16* QK = (const attn_body::bf16*)(args.ws + WS_QKVB);
        const attn_body::AttnTensors AT{QK, QK + 1024, QK + 2048, (attn_body::bf16*)(args.ws + WS_Y), (const attn_body::bf16*)(args.ws + WS_ZB), (const float*)(args.ws + WS_KMEAN)};
        const pg8::Gemm gl{(const pg8::bf16_t*)(args.ws + WS_XN), (const pg8::bf16_t*)(args.ws + WS_WINT), T, NIN, DM};
        const pg8::EpiIn El{(pg8::bf16_t*)(args.ws + WS_RKV), (pg8::bf16_t*)(args.ws + WS_ZA), (pg8::bf16_t*)(args.ws + WS_QKVB), (pg8::bf16_t*)(args.ws + WS_ZB), (pg8::bf16_t*)args.out, (pg8::bf16_t*)(args.ws + WS_LORA), F.in[IN_QNW], F.in[IN_KNW], (float*)(args.ws + WS_KMEAN)};
        constexpr int NSCAN = BATCH * NH; FRESH();
        const bool split = F.G >= 2 * NSCAN && ((F.G - NSCAN) & 31) == 0 && 64 % ((F.G - NSCAN) >> 5) == 0;
        if (split && F.vcu < NSCAN) { ck::head(F, F.vcu); FRESH(); __syncthreads(); p0_weights_late(F, F.vcu * NWAVES + F.wave, NSCAN * NWAVES, 0, 2048);
            if (MK_GIVE_QB) { const attn_body::MobaOrder S{F.vcu, NSCAN, false, MK_GIVE_QB};
#pragma unroll 1
                for (int qb = 0; qb < 8; ++qb) if ((MK_GIVE_QB >> qb) & 1) { FRESH(); __syncthreads(); attn_body::AttnUnit u; if (S.own(S.slot_of(F.vcu, qb), F.vcu, u)) attn_body::attn_unit<8>(u.bh / NH, u.bh % NH, u.qb, AT.Q, AT.K, AT.V, AT.O, AT.ZB, AT.KMEAN, (char*)lds, F.wave); } } }
        else {
            const int c = split ? F.vcu - NSCAN : F.vcu, ng = split ? F.G - NSCAN : F.G;
            if (!split) { for (int u = F.vcu; u < NSCAN; u += F.G) ck::head(F, u); __syncthreads(); }
            if (split) { InOrderLate SL{c, ng}; pg8::gemm_phase<pg8::EpiIn, InOrderLate, true, true>(F.lds, gl, SL, El, F.wave); }
            else { InOrderLate SL{0, 32}; for (int k = F.vcu; k < 32; k += F.G) { SL.c = k; pg8::gemm_phase<pg8::EpiIn, InOrderLate, true, true>(F.lds, gl, SL, El, F.wave); } }
            FRESH(); __syncthreads();
            const attn_body::MobaOrder S{c, ng, split && ng == 128 && (((64 / (ng >> 5)) * NLATE) & 31) == 16, split ? MK_GIVE_QB : 0}; attn_body::attn_phase<attn_body::MobaOrder>((char*)lds, AT, S, F.wave);
            if (!split) { FRESH(); __syncthreads(); p0_weights_late(F, c * NWAVES + F.wave, ng * NWAVES, 0, 2048); }
        }
        TS(7);
#if MK_TS
        if (F.tid == 0) { const unsigned now = (unsigned)__builtin_amdgcn_s_memrealtime(); const unsigned st = __hip_atomic_load((unsigned*)(F.ctl + CW_TS + 4), __ATOMIC_RELAXED, __HIP_MEMORY_SCOPE_AGENT);
            __hip_atomic_fetch_max((unsigned*)(F.ctl + CW_TS + 64 + (F.vcu >= 128 ? 1 : 0)), now - st, __ATOMIC_RELAXED, __HIP_MEMORY_SCOPE_AGENT);
            if (F.vcu >= 128) __hip_atomic_fetch_max((unsigned*)(F.ctl + CW_TS + 66 + (((F.vcu - 128) & 31) < 16 ? 0 : 1)), now - st, __ATOMIC_RELAXED, __HIP_MEMORY_SCOPE_AGENT); }
#endif
        if (BOTH(2)) GRID_BAR(); TS(8);
    }
    if (IN(3) && !(blockIdx.x & 1)) { FRESH(); p0_weights_late(F, F.vcu * NWAVES + F.wave, F.G * NWAVES, 2048, 4096); __syncthreads(); }
    if (IN(3)) {
        pg8::Gemm g{(const pg8::bf16_t*)(args.ws + WS_Y), (const pg8::bf16_t*)(args.ws + WS_WMT), T, DM, DM}; pg8::StaticOrder S; S.init(T, DM, F.G, (int)blockIdx.x);
        pg8::EpiMergeF E{(const pg8::bf16_t*)args.out, (pg8::bf16_t*)(args.ws + WS_MERGED)};
        pg8::gemm_phase<pg8::EpiMergeF, pg8::StaticOrder, MK_ALIGN34, true>(F.lds, g, S, E, F.wave);
        if (blockIdx.x & 1) { FRESH(); __syncthreads(); p0_weights_late(F, F.vcu * NWAVES + F.wave, F.G * NWAVES, 2048, 4096); }
        TS(10); if (BOTH(3)) GRID_BAR(); TS(11);
    }
    if (IN(4)) {
        pg8::Gemm g{(const pg8::bf16_t*)(args.ws + WS_MERGED), (const pg8::bf16_t*)(args.ws + WS_WOT), T, DM, DM}; pg8::StaticOrder S; S.init(T, DM, F.G, (int)blockIdx.x);
        pg8::EpiOut E{F.in[IN_X], args.out};
        pg8::gemm_phase<pg8::EpiOut, pg8::StaticOrder, MK_ALIGN34, true>(F.lds, g, S, E, F.wave); TS(12);
    }
#if MK_TS >= 60 && MK_TS < 70
    {
        GRID_BAR(); TS(13);
        constexpr int V = MK_TS - 60;
        if constexpr (V < 4 || V == 8) { pg8::Gemm g{(const pg8::bf16_t*)(args.ws + WS_Y), (const pg8::bf16_t*)(args.ws + WS_WMT), T, DM, DM}; pg8::StaticOrder S; S.init(T, DM, F.G, (int)blockIdx.x);
            typedef pg8::EpiMergeFT<(V & 1) == 0, (V & 2) == 0, V == 8> EP; EP E{(const pg8::bf16_t*)(args.ws + WS_QKVB), (pg8::bf16_t*)(args.ws + WS_RKV)};
            pg8::gemm_phase<EP, pg8::StaticOrder, MK_ALIGN34, true>(F.lds, g, S, E, F.wave); }
        else { pg8::Gemm g{(const pg8::bf16_t*)(args.ws + WS_MERGED), (const pg8::bf16_t*)(args.ws + WS_WOT), T, DM, DM}; pg8::StaticOrder S; S.init(T, DM, F.G, (int)blockIdx.x);
            typedef pg8::EpiOutT<V == 9 || ((V - 4) & 1) == 0, V == 9 || ((V - 4) & 2) == 0, V == 9 ? 16 : 1> EP; EP E{F.in[IN_X], (float*)(args.ws + WS_RKV)};
            pg8::gemm_phase<EP, pg8::StaticOrder, MK_ALIGN34, true>(F.lds, g, S, E, F.wave); }
        GRID_BAR(); TS(14);
    }
#endif
#undef IN
#undef BOTH
}


#if MK_TS
__global__ void mk_report(Args args) {
    const unsigned* ts0 = (const unsigned*)(args.ws + WS_CTL) + CW_TS; const unsigned* ts4 = ts0 + 32;
    float A = 0.f, B = 0.f;
    const float tk = 0.01f;
    if (MK_TS == 1) { A = (ts0[1] - ts0[0]) * tk; B = (ts0[3] - ts0[2]) * tk; }
    if (MK_TS == 2) { A = (ts0[5] - ts0[4]) * tk; B = (ts0[7] - ts0[6]) * tk; }
    if (MK_TS == 3) { A = (ts4[7] - ts4[4]) * tk; B = 0.f; }
    if (MK_TS == 4) { A = (ts0[12] - ts0[11]) * tk; B = ((ts0[2] - ts0[1]) + (ts0[4] - ts0[3]) + (ts0[6] - ts0[5]) + (ts0[8] - ts0[7]) + (ts0[11] - ts0[10])) * tk; }
    if (MK_TS >= 20 && MK_TS < 32) { A = floorf(ts0[40 + (MK_TS - 20)] * tk / 25.f) * 25.f; B = 0.f; }
    if (MK_TS == 32) { A = 0.2f * ts0[40] * tk; B = 0.f; }
    if (MK_TS == 33) { A = 0.2f * (ts0[41] + ts0[42] + ts0[43]) * tk; B = 0.f; }
    if (MK_TS == 34) { A = 0.2f * (ts0[44] + ts0[46] + ts0[47]) * tk; B = 0.f; }
    if (MK_TS == 35) { A = 0.2f * ts0[48] * tk; B = 0.f; }
    if (MK_TS == 36) { A = 0.2f * ts0[51] * tk; B = 0.f; }
    if (MK_TS == 9) { A = (ts0[13] - ts0[8]) * tk; B = 0.f; }
    if (MK_TS == 10) { A = (ts0[15] - ts0[14]) * tk; B = 0.f; }
    if (MK_TS == 11) { A = (ts0[7] - ts0[6]) * tk; B = 0.f; }
    if (MK_TS == 8) { A = ts0[20] * tk; B = 0.f; }
    if (MK_TS == 6) { A = (ts0[7] - ts0[4]) * tk; B = 0.f; }
    if (MK_TS == 7) { A = (ts0[5] - ts0[4]) * tk; B = 0.f; }
    if (MK_TS == 5) { A = (ts0[12] - ts0[0]) * tk; B = 0.f; }
    if (MK_TS >= 50 && MK_TS < 54) { A = ts0[64 + MK_TS - 50] * tk; B = 0.f; }
    if (MK_TS >= 60 && MK_TS < 70) { A = (ts0[14] - ts0[13]) * tk; B = 0.f; }
    if (MK_TS == 55) { A = ts0[65] * tk - 400.f; B = 0.f; }
    if (MK_TS == 56) { A = ts0[64] * tk - 400.f; B = 0.f; }
    if (MK_TS == 57) { A = (ts0[8] - ts0[4]) * tk - 400.f; B = 0.f; }
    if (MK_TS == 58) { A = (ts0[4] - ts0[2]) * tk - 400.f; B = 0.f; }
    if (MK_TS == 59) { A = (ts0[12] - ts0[8]) * tk - 200.f; B = 0.f; }
    if (MK_TS == 70) { A = (ts0[4] - ts0[3]) * tk * 10.f; B = 0.f; }
    if (MK_TS == 71) { A = (ts0[2] - ts0[1]) * tk * 10.f; B = 0.f; }
    if (MK_TS == 72) { A = (ts0[8] - ts0[7]) * tk * 10.f; B = 0.f; }
    if (MK_TS == 73) { A = (ts0[11] - ts0[10]) * tk * 10.f; B = 0.f; }
    if (MK_TS >= 80 && MK_TS < 88) { A = ts0[MK_TS] * tk; B = 0.f; }
    if (MK_TS == 90) { int c1 = 0, c2 = 0; for (int w = 0; w < 4; ++w) { c1 += ts0[100 + w] == ts0[104 + w]; c2 += ts0[100 + 2 * w] == ts0[101 + 2 * w]; } A = 11.f + 10.f * c1 + c2; B = 0.f; }
    if (MK_TS >= 92 && MK_TS < 96) { A = ts0[MK_TS] * tk; B = 0.f; }
    if (MK_TS >= 80 && MK_TS < 90) { A = ts0[MK_TS] * tk; B = 0.f; }
    if (MK_TS == 47) { A = (ts0[2] - ts0[0]) * tk; B = 0.f; }
    if (MK_TS == 54) { A = (ts0[12] - ts0[0]) * tk - 1200.f; B = 0.f; }
    if (MK_TS == 44) { A = (ts0[8] - ts0[4]) * tk; B = 0.f; }
    if (MK_TS == 45) { A = (ts0[11] - ts0[8]) * tk; B = 0.f; }
    if (MK_TS == 46) { A = (ts0[4] - ts0[2]) * tk; B = 0.f; }
    if (MK_TS == 40) { A = (ts0[3] - ts0[2]) * tk; B = 0.f; }
    if (MK_TS == 41) { A = (ts0[10] - ts0[8]) * tk; B = 0.f; }
    if (MK_TS == 42) { A = (ts0[12] - ts0[11]) * tk; B = 0.f; }
    if (MK_TS == 43) { A = (ts0[1] - ts0[0]) * tk; B = 0.f; }
    const size_t N = 3355443;
    for (size_t e = (size_t)blockIdx.x * blockDim.x + threadIdx.x; e < N; e += (size_t)gridDim.x * blockDim.x) args.out[1 + e] += 2e-4f * B;
    if (blockIdx.x == 0 && threadIdx.x == 0) args.out[0] += 0.01f * A;
}
#endif
#if MK_CHECK
constexpr int CW_CHK = 8192;
__device__ __forceinline__ float chk_silu(float x) { return x / (1.f + expf(-x)); }
__device__ __forceinline__ float chk_sig(float x) { return 1.f / (1.f + expf(-x)); }
__global__ void __launch_bounds__(64) mk_check(Args args, int stage) {
    __shared__ float sh[8][64];
    const int lane = threadIdx.x; unsigned char* ws = args.ws; unsigned* ctl = (unsigned*)(ws + WS_CTL);
    const bf16* WINT = (const bf16*)(ws + WS_WINT); const bf16* WAT = (const bf16*)(ws + WS_WAT); const bf16* WBT = (const bf16*)(ws + WS_WBT); const bf16* WOT = (const bf16*)(ws + WS_WOT);
    const bf16* XN = (const bf16*)(ws + WS_XN); const bf16* RKV = (const bf16*)(ws + WS_RKV); const bf16* ZA = (const bf16*)(ws + WS_ZA); const bf16* QKVB = (const bf16*)(ws + WS_QKVB);
    const bf16* ZB = (const bf16*)(ws + WS_ZB); const bf16* G = (const bf16*)args.out; const bf16* LORA = (const bf16*)(ws + WS_LORA);
    const bf16* YA = (const bf16*)(ws + WS_YA); const bf16* YB = (const bf16*)(ws + WS_YB); const bf16* MERGED = (const bf16*)(ws + WS_MERGED); const float* KMEAN = (const float*)(ws + WS_KMEAN);
    float ratio = 0.f; int sub = 0; unsigned fmask = 0u;
#define CHK(got, want, rel, ab, SUB) do { const float r_ = fabsf((got) - (want)) / ((rel) * fabsf(want) + (ab)); if (!(r_ <= 1.f)) fmask |= 1u << (SUB); if (!(r_ <= ratio)) { ratio = r_; sub = (SUB); } } while (0)
    if (stage == 1) {
        for (int ri = 0; ri < 4; ++ri) { const int t = ri == 0 ? 0 : ri == 1 ? 1 : ri == 2 ? 5000 : 16383; const float* xr = args.in[IN_X] + (size_t)t * DM; float s = 0.f;
            for (int j = 0; j < 32; ++j) { const float v = xr[lane * 32 + j]; s += v * v; }
            s = wave_sum(s); const float rstd = 1.f / sqrtf(s / DM + RMS_EPS); const int k = lane * 32 + ((7 * ri + lane) & 31);
            CHK(bf2f(XN[(size_t)t * DM + k]), xr[k] * rstd * args.in[IN_NORMW][k], 0.01f, 1e-3f, 1); }
        for (int q = 0; q < 4; ++q) { int n = (lane * 197 + 13 + q * 3137) % NIN; if (q == 3 && lane < 9) { int v = 4095;
                v = lane == 1 ? 4096 : lane == 2 ? 8191 : lane == 3 ? 8192 : lane == 4 ? 12287 : lane == 5 ? 12288 : lane == 6 ? 12415 : lane == 7 ? 12416 : lane == 8 ? 12543 : 4095; n = v; }
            const int k = (lane * 31 + 5 + q * 511) % DM; const int src = win_src_col(n);
            const float want = src >= 0 ? args.in[IN_WIN][(size_t)k * 12416 + src] : 0.f; CHK(bf2f(WINT[(size_t)n * DM + k]), want, 0.01f, 1e-4f, 2); }
    }
    if (stage == 2) {
        for (int q = 0; q < 4; ++q) { const int t = (lane * 1031 + 17 + q * 4099) % T, grp = (lane + q) % 9, c = (lane * 67 + 3 + q * 131) % 1024, c2 = (lane * 113 + 9 + q * 517) % 2048, c3 = (lane * 5 + q) % 128;
            const int n = grp == 0 ? c : grp == 1 ? 1024 + c : grp == 2 ? 2048 + c : grp == 3 ? 3072 + c : grp == 4 ? 4096 + 2048 + c : grp == 5 ? 4096 + 3072 + c : grp == 6 ? 8192 + c2 : grp == 7 ? 8192 + 2048 + c2 : 12288 + c3;
            float d = 0.f; for (int k = 0; k < DM; ++k) d += bf2f(XN[(size_t)t * DM + k]) * bf2f(WINT[(size_t)n * DM + k]);
            float got, want = d;
            if (grp <= 2) got = bf2f(RKV[(size_t)t * 3072 + grp * 1024 + c]);
            else if (grp == 3) { got = bf2f(ZA[(size_t)t * 1024 + c]); want = chk_silu(d); }
            else if (grp == 4) got = bf2f(QKVB[(size_t)t * 3072 + 2048 + c]);
            else if (grp == 5) { got = bf2f(ZB[(size_t)t * 1024 + c]); want = chk_silu(d); }
            else if (grp == 6) { got = bf2f(G[(size_t)t * 4096 + c2]); want = chk_sig(d); }
            else if (grp == 7) { got = bf2f(G[(size_t)t * 4096 + 2048 + c2]); want = chk_sig(d); }
            else got = bf2f(LORA[(size_t)t * 128 + c3]);
            CHK(got, want, 0.02f, 0.02f, 1 + grp); }
    }
    if (stage == 4) {
        for (int pi = 0; pi < 2; ++pi) { const int b = pi ? 5 : 0, h = pi ? 9 : 0; float S[64];
#pragma unroll
            for (int j = 0; j < 64; ++j) S[j] = 0.f;
            const int d = h * 64 + lane; const float mur = args.in[IN_MUR][d], muk = args.in[IN_MUK][d], muv = args.in[IN_MUV][d], kk_ = args.in[IN_KK][d], ka = args.in[IN_KA][d], rk = args.in[IN_RK][d], gw = args.in[IN_GNW][d], gb = args.in[IN_GNB][d];
            for (int t = 0; t < 200; ++t) { const size_t row = (size_t)b * SEQ + t;
                const float cr = bf2f(RKV[row * 3072 + d]), ck = bf2f(RKV[row * 3072 + 1024 + d]), cv = bf2f(RKV[row * 3072 + 2048 + d]);
                const float pr = t ? bf2f(RKV[(row - 1) * 3072 + d]) : 0.f, pk = t ? bf2f(RKV[(row - 1) * 3072 + 1024 + d]) : 0.f, pv = t ? bf2f(RKV[(row - 1) * 3072 + 2048 + d]) : 0.f;
                const float lcw = bf2f(LORA[row * 128 + lane]), lca = bf2f(LORA[row * 128 + 64 + lane]), lpw = t ? bf2f(LORA[(row - 1) * 128 + lane]) : 0.f, lpa = t ? bf2f(LORA[(row - 1) * 128 + 64 + lane]) : 0.f;
                __syncthreads(); sh[5][lane] = tanhf(lcw + (lpw - lcw) * args.in[IN_MUW][lane]); sh[6][lane] = lca + (lpa - lca) * args.in[IN_MUA][lane]; __syncthreads();
                float sd = 0.f, sa2 = 0.f;
                for (int i2 = 0; i2 < 64; ++i2) { sd += sh[5][i2] * args.in[IN_WDUP][i2 * 1024 + d]; sa2 += sh[6][i2] * args.in[IN_WAUP][i2 * 1024 + d]; }
                const float zz = args.in[IN_W0][d] + sd, a = chk_sig(args.in[IN_A0][d] + sa2), w = expf(-expf(-log1pf(expf(-zz)) - 0.5f));
                const float r = cr + (pr - cr) * mur, k = ck + (pk - ck) * muk, v = cv + (pv - cv) * muv;
                float kkv = k * kk_; const float nrm = fmaxf(sqrtf(wave_sum(kkv * kkv)), 1e-12f); kkv /= nrm; const float kp = k * (1.f + (a - 1.f) * ka), bb = kkv * a;
                const float bon = wave_sum(r * kp * rk);
                __syncthreads(); sh[0][lane] = r; sh[1][lane] = w; sh[2][lane] = kp; sh[3][lane] = -kkv; sh[4][lane] = bb; __syncthreads();
                float sa = 0.f;
#pragma unroll
                for (int j = 0; j < 64; ++j) sa += S[j] * sh[3][j];
                float y = 0.f;
#pragma unroll
                for (int j = 0; j < 64; ++j) { S[j] = S[j] * sh[1][j] + sa * sh[4][j] + v * sh[2][j]; y += S[j] * sh[0][j]; }
                const float mean = wave_sum(y) * (1.f / 64.f), dy = y - mean, var = wave_sum(dy * dy) * (1.f / 64.f);
                const float want = (dy / sqrtf(var + GN_EPS) * gw + gb + bon * v) * bf2f(ZA[row * 1024 + d]);
                CHK(bf2f(YA[row * 1024 + d]), want, 0.03f, 0.03f, 1 + pi * 4 + (t >= 32 ? 1 : 0) + (t >= 64 ? 1 : 0)); } }
    }
    if (stage == 5) {
        for (int q = 0; q < 4; ++q) { const int t = (lane * 523 + 7 + q * 4111) % T, h = (lane + q) & 15, which = q & 1; float ss = 0.f; const float* nw = which ? args.in[IN_KNW] : args.in[IN_QNW];
            for (int dd = 0; dd < 64; ++dd) { const float v = bf2f(QKVB[(size_t)t * 3072 + which * 1024 + h * 64 + dd]) / nw[dd]; ss += v * v; }
            CHK(ss / 64.f, which ? 1.0f : QSCALE * QSCALE, 0.02f, 0.f, 1 + which); }
        for (int q = 0; q < 2; ++q) { const int b = (lane + q * 3) & 7, h = (lane * 5 + q) & 15, n = (lane >> 3) & 7, dd = (lane * 11 + q * 29) & 63; float s = 0.f;
            for (int k = 0; k < 256; ++k) s += bf2f(QKVB[((size_t)b * SEQ + n * 256 + k) * 3072 + 1024 + h * 64 + dd]);
            CHK(KMEAN[(((size_t)b * NH + h) * 8 + n) * 64 + dd], s / 256.f, 0.02f, 2e-3f, 3); }
    }
    if (stage == 6) {
        const int l15 = lane & 15;
        const int s = l15 == 0 ? 0 : l15 == 1 ? 1 : l15 == 2 ? 63 : l15 == 3 ? 64 : l15 == 4 ? 255 : l15 == 5 ? 256 : l15 == 6 ? 300 : l15 == 7 ? 511 : l15 == 8 ? 512 : l15 == 9 ? 777 : l15 == 10 ? 1023 : l15 == 11 ? 1024 : l15 == 12 ? 1300 : l15 == 13 ? 1791 : l15 == 14 ? 1800 : 2047;
        const int b = (lane >> 4) * 2 + 1, h = (lane * 7 + 3) & 15, qblk = s >> 8; const size_t row = (size_t)b * SEQ + s;
        float qv[64], o[64];
#pragma unroll
        for (int dd = 0; dd < 64; ++dd) { qv[dd] = bf2f(QKVB[row * 3072 + h * 64 + dd]); o[dd] = 0.f; }
        float g[8]; int nsel = qblk < 3 ? qblk : 3; unsigned selm = 0;
#pragma unroll
        for (int n = 0; n < 8; ++n) { g[n] = -1e30f; if (n < qblk) { float a = 0.f;
#pragma unroll
                for (int dd = 0; dd < 64; ++dd) a += qv[dd] * KMEAN[(((size_t)b * NH + h) * 8 + n) * 64 + dd];
                g[n] = a; } }
        for (int it = 0; it < nsel; ++it) { int best = -1; float bv = -3e38f;
#pragma unroll
            for (int n = 0; n < 8; ++n) if (!((selm >> n) & 1u) && g[n] > bv) { bv = g[n]; best = n; }
            selm |= 1u << best; }
        float m = -1e30f, l = 0.f;
        for (int n = 0; n <= qblk; ++n) { if (n < qblk && !((selm >> n) & 1u)) continue;
            for (int kk2 = 0; kk2 < 256; ++kk2) { const int j = n * 256 + kk2; if (j > s) break; const size_t kr = ((size_t)b * SEQ + j) * 3072; float sc = 0.f;
#pragma unroll
                for (int dd = 0; dd < 64; ++dd) sc += qv[dd] * bf2f(QKVB[kr + 1024 + h * 64 + dd]);
                const float mn = fmaxf(m, sc), al = exp2f(m - mn), p = exp2f(sc - mn); l = l * al + p; m = mn;
#pragma unroll
                for (int dd = 0; dd < 64; ++dd) o[dd] = o[dd] * al + p * bf2f(QKVB[kr + 2048 + h * 64 + dd]); } }
#pragma unroll
        for (int dd = 0; dd < 64; ++dd) CHK(bf2f(YB[row * 1024 + h * 64 + dd]), o[dd] / l * bf2f(ZB[row * 1024 + h * 64 + dd]), 0.03f, 0.003f, 1 + (qblk > 3 ? 1 : 0) + (qblk == 0 ? 2 : 0));
    }
    if (stage == 7) {
            { const int n = (lane * 37 + 3) % DM, k = (lane * 29 + 1) % WID; CHK(bf2f(WAT[(size_t)n * WID + k]), args.in[IN_WPR][(size_t)k * DM + n], 0.01f, 1e-4f, 3);
          CHK(bf2f(WBT[(size_t)n * WID + k]), args.in[IN_WPM][(size_t)k * DM + n], 0.01f, 1e-4f, 3); const int k2 = (lane * 61 + 7) % DM; CHK(bf2f(WOT[(size_t)n * DM + k2]), args.in[IN_WOUT][(size_t)k2 * DM + n], 0.01f, 1e-4f, 3); }
        for (int q = 0; q < 4; ++q) { const int t = (lane * 1031 + 17 + q * 4099) % T, n = (lane * 113 + 9 + q * 517) % 2048; float da = 0.f, db = 0.f;
            for (int k = 0; k < WID; ++k) { da += bf2f(YA[(size_t)t * 1024 + k]) * bf2f(WAT[(size_t)n * WID + k]); db += bf2f(YB[(size_t)t * 1024 + k]) * bf2f(WBT[(size_t)n * WID + k]); }
            CHK(bf2f(MERGED[(size_t)t * 2048 + n]), bf2f(G[(size_t)t * 4096 + n]) * da + bf2f(G[(size_t)t * 4096 + 2048 + n]) * db, 0.02f, 0.01f, 1); }
    }
    if (stage == 8) {
        for (int q = 0; q < 4; ++q) { const int t = (lane * 1031 + 17 + q * 4099) % T, n = (lane * 113 + 9 + q * 517) % 2048; float d = 0.f;
            for (int k = 0; k < DM; ++k) d += bf2f(MERGED[(size_t)t * 2048 + k]) * bf2f(WOT[(size_t)n * DM + k]);
            CHK(args.out[(size_t)t * DM + n], args.in[IN_X][(size_t)t * DM + n] + d, 0.f, 0.01f, 1); }
    }
    const float wr = wave_max(ratio);
#pragma unroll
    for (int o_ = 1; o_ < 64; o_ <<= 1) fmask |= (unsigned)__shfl_xor((int)fmask, o_);
    (void)sub;
    if (threadIdx.x == 0 && blockIdx.x == 0 && stage <= 8) { if (fmask && ctl[CW_CHK] == 0u) { const int low = __ffs((int)fmask) - 1, cnt = __popc(fmask);
            ctl[CW_CHK] = (unsigned)(stage * 10 + (low > 9 ? 9 : low)); ctl[CW_CHK + 1] = (unsigned)(cnt + (wr >= 64.f ? 20 : wr >= 8.f ? 10 : 0)); } }
    if (stage == 9) { const unsigned code = ctl[CW_CHK], code2 = ctl[CW_CHK + 1];
        if (code) { for (size_t e = (size_t)blockIdx.x * 64 + lane; e < (size_t)T * DM; e += (size_t)gridDim.x * 64) args.out[e] += (float)code2;
            if (blockIdx.x == 0 && lane == 0) args.out[0] = 100.f * (float)code; } }
#undef CHK
}
#endif

extern "C" void kernel_launch(void* const* d_in, const int* in_sizes, int n_in, void* d_out, int out_size, void* d_ws, size_t ws_size, hipStream_t stream) {
    static int grid = 0;
    if (grid == 0) {
        if (n_in != 22 || in_sizes[0] != T * DM || out_size != T * DM || ws_size < WS_END) { fprintf(stderr, "kernel_launch: unexpected shapes (n_in %d, in0 %d, out %d, ws %zu)\n", n_in, n_in > 0 ? in_sizes[0] : -1, out_size, ws_size); grid = -1; return; }
        int dev = 0, cus = 0, per_cu = 0;
        if (hipGetDevice(&dev) != hipSuccess || hipDeviceGetAttribute(&cus, hipDeviceAttributeMultiprocessorCount, dev) != hipSuccess) { grid = -1; return; }
        if (hipFuncSetAttribute((const void*)mk_fwd, hipFuncAttributeMaxDynamicSharedMemorySize, LDS_BYTES) != hipSuccess) { fprintf(stderr, "kernel_launch: hipFuncSetAttribute failed\n"); grid = -1; return; }
        if (hipOccupancyMaxActiveBlocksPerMultiprocessor(&per_cu, (const void*)mk_fwd, NWAVES * 64, LDS_BYTES) != hipSuccess || per_cu < 1) { fprintf(stderr, "kernel_launch: occupancy query says %d blocks per CU\n", per_cu); per_cu = 1; }
        (void)hipGetLastError();
        grid = cus;
    }
    if (grid < 0) return;
    (void)hipMemsetAsync((char*)d_ws + WS_CTL, 0, CTL_ZERO_BYTES, stream);
    Args a{};
    for (int i = 0; i < 22; ++i) a.in[i] = (const float*)d_in[i];
    a.out = (float*)d_out; a.ws = (unsigned char*)d_ws;
    if (MK_N_LAUNCHES == 1) { a.ph_lo = 0; a.ph_hi = PER_PHASE; a.li = 0; hipLaunchKernelGGL(mk_fwd, dim3(grid), dim3(NWAVES * 64), LDS_BYTES, stream, a);
#if MK_TS
        hipLaunchKernelGGL(mk_report, dim3(256), dim3(256), 0, stream, a);
#endif
    }
    else for (int li = 0; li < PER_PHASE; ++li) { a.ph_lo = li; a.ph_hi = li + 1; a.li = li; hipLaunchKernelGGL(mk_fwd, dim3(grid), dim3(NWAVES * 64), LDS_BYTES, stream, a);
#if MK_CHECK
        const int stg = li == 0 ? 1 : li == 1 ? 2 : li == 2 ? 4 : li == 3 ? 7 : li == 4 ? 8 : 0;
        if (stg) hipLaunchKernelGGL(mk_check, dim3(1), dim3(64), 0, stream, a, stg);
        if (li == 1) hipLaunchKernelGGL(mk_check, dim3(1), dim3(64), 0, stream, a, 5);
        if (li == 2) hipLaunchKernelGGL(mk_check, dim3(1), dim3(64), 0, stream, a, 6);
        if (li == 4) hipLaunchKernelGGL(mk_check, dim3(512), dim3(64), 0, stream, a, 9);
#endif
    }
}
```
